# Optimizing an MI355X kernel written in HIP

```python
import math, functools
import jax, jax.numpy as jnp
from jax import lax
import numpy as np

D_MODEL = 1024
BATCH = 2
SEQ = 8192
DEPTH = 1

GRID_W = 64
D_MIX = D_MODEL
HEAD_DIM = 64
N_Q_HEADS = 8
N_KV_HEADS = 2
GQA_GROUP = N_Q_HEADS // N_KV_HEADS
ATTN_W = N_Q_HEADS * HEAD_DIM
KV_W = N_KV_HEADS * HEAD_DIM
LRU_W = D_MIX - ATTN_W
LRU_BLOCKS = 8
LRU_BW = LRU_W // LRU_BLOCKS
LRU_C = 8.0
CONV_W = 4
CONV_PAD_L = 2
ROPE_THETA = 10000.0
ROPE_HALF = HEAD_DIM // 2
Q_BLOCK = 128
N_EXPERTS = 32
TOP_K = 4
D_FF = D_MODEL
SWIGLU_ALPHA = 1.702
SWIGLU_LIMIT = 7.0
MOE_BLOCK = 256
NORM_EPS = 1e-5
IN_W = ATTN_W + 2 * KV_W + 2 * LRU_W

kernel_name = 'hybrid_attn_rglru_moe_encoder'


def rms_norm(x, g, eps=NORM_EPS):
    xf = x.astype(jnp.float32)
    y = xf * lax.rsqrt(jnp.mean(xf * xf, axis=-1, keepdims=True) + eps)
    return (y * g.astype(jnp.float32)).astype(x.dtype)


def rope_1d(x, pos):
    m = x.shape[-1] // 2
    inv_freq = ROPE_THETA ** (-jnp.arange(m, dtype=jnp.float32) / m)
    ang = pos.astype(jnp.float32)[:, None] * inv_freq[None, :]
    cos = jnp.cos(ang)[None, :, None, :]
    sin = jnp.sin(ang)[None, :, None, :]
    xf = x.astype(jnp.float32)
    x1, x2 = xf[..., :m], xf[..., m:]
    out = jnp.concatenate([x1 * cos - x2 * sin, x2 * cos + x1 * sin], axis=-1)
    return out.astype(x.dtype)


def rope_axial_2d(x, rows, cols):
    return jnp.concatenate([rope_1d(x[..., :ROPE_HALF], rows),
                            rope_1d(x[..., ROPE_HALF:], cols)], axis=-1)


def block_attention(q, k, v):
    B, S = q.shape[0], q.shape[1]
    nblk = S // Q_BLOCK
    qb = q.reshape(B, nblk, Q_BLOCK, N_KV_HEADS, GQA_GROUP, HEAD_DIM)
    qb = jnp.moveaxis(qb, 1, 0)
    scale = HEAD_DIM ** -0.5

    def one_block(qi):
        s = jnp.einsum('bqkgd,bskd->bkgqs', qi, k).astype(jnp.float32) * scale
        p = jax.nn.softmax(s, axis=-1).astype(v.dtype)
        return jnp.einsum('bkgqs,bskd->bqkgd', p, v)

    o = lax.map(one_block, qb)
    return jnp.moveaxis(o, 0, 1).reshape(B, S, ATTN_W)


def centred_depthwise_conv(u, w, b):
    S = u.shape[1]
    up = jnp.pad(u, ((0, 0), (CONV_PAD_L, CONV_W - 1 - CONV_PAD_L), (0, 0)))
    acc = b
    for j in range(CONV_W):
        acc = acc + up[:, j:j + S, :] * w[j]
    return acc


def _lin_combine(c1, c2):
    a1, b1 = c1
    a2, b2 = c2
    return a1 * a2, a2 * b1 + b2


def rglru_direction(xc, wa, ba, wi, bi, lam, reverse):
    B, S, _ = xc.shape
    xb = xc.reshape(B, S, LRU_BLOCKS, LRU_BW)
    r = jax.nn.sigmoid((jnp.einsum('bsni,nij->bsnj', xb, wa).reshape(B, S, LRU_W) + ba).astype(jnp.float32))
    i = jax.nn.sigmoid((jnp.einsum('bsni,nij->bsnj', xb, wi).reshape(B, S, LRU_W) + bi).astype(jnp.float32))
    log_a = -LRU_C * r * jax.nn.softplus(-lam.astype(jnp.float32))
    a = jnp.exp(log_a)
    mult = jnp.sqrt(-jnp.expm1(2.0 * log_a))
    bterm = mult * i * xc.astype(jnp.float32)
    _, h = lax.associative_scan(_lin_combine, (a, bterm), reverse=reverse, axis=1)
    return h


def moe_ffn(xn, w_router, b_router, w_gate, b_gate, w_up, b_up, w_down, b_down):
    B, S, D = xn.shape
    T = B * S
    xf = xn.reshape(T, D)
    logits = (xf @ w_router + b_router).astype(jnp.float32)
    top_v, top_i = lax.top_k(logits, TOP_K)
    gates = jax.nn.softmax(top_v, axis=-1).astype(xn.dtype)

    TK = T * TOP_K
    flat_e = top_i.reshape(TK).astype(jnp.int32)
    flat_tok = jnp.arange(TK, dtype=jnp.int32) // TOP_K
    flat_g = gates.reshape(TK)
    order = jnp.argsort(flat_e, stable=True)
    sorted_e = flat_e[order]
    counts = jnp.bincount(flat_e, length=N_EXPERTS)
    padded = ((counts + MOE_BLOCK - 1) // MOE_BLOCK) * MOE_BLOCK
    start = jnp.cumsum(counts) - counts
    pend = jnp.cumsum(padded)
    pstart = pend - padded
    dest = pstart[sorted_e] + (jnp.arange(TK, dtype=jnp.int32) - start[sorted_e])

    n_rows = TK + N_EXPERTS * MOE_BLOCK
    n_blocks = n_rows // MOE_BLOCK
    row_tok = jnp.full((n_rows,), T, dtype=jnp.int32).at[dest].set(flat_tok[order])
    row_gate = jnp.zeros((n_rows,), dtype=xn.dtype).at[dest].set(flat_g[order])
    block_e = jnp.searchsorted(pend, jnp.arange(n_blocks) * MOE_BLOCK, side='right')
    block_e = jnp.minimum(block_e, N_EXPERTS - 1).astype(jnp.int32)

    xpad = jnp.concatenate([xf, jnp.zeros((1, D), xf.dtype)], axis=0)
    x_rows = xpad[row_tok].reshape(n_blocks, MOE_BLOCK, D)

    def expert_block(args):
        xb, e = args
        g = xb @ w_gate[e] + b_gate[e]
        u = xb @ w_up[e] + b_up[e]
        g = jnp.minimum(g, SWIGLU_LIMIT)
        u = jnp.clip(u, -SWIGLU_LIMIT, SWIGLU_LIMIT)
        glu = g * jax.nn.sigmoid(SWIGLU_ALPHA * g)
        return ((u + 1.0) * glu) @ w_down[e] + b_down[e]

    y_rows = lax.map(expert_block, (x_rows, block_e)).reshape(n_rows, D)
    y_rows = y_rows * row_gate[:, None]
    out = jax.ops.segment_sum(y_rows, row_tok, num_segments=T + 1)[:T]
    return out.reshape(B, S, D)


def setup_inputs(seed: int = 0) -> dict:
    key = jax.random.key(seed)
    ks = jax.random.split(key, 32)
    f32 = jnp.float32
    L = DEPTH

    def nrm(k, shape, fan_in):
        return jax.random.normal(k, shape, f32) * (fan_in ** -0.5)

    def gain(k, shape):
        return 1.0 + 0.05 * jax.random.normal(k, shape, f32)

    def bias(k, shape, s=0.01):
        return s * jax.random.normal(k, shape, f32)

    u = jax.random.uniform(ks[10], (L, 2, LRU_W), f32, minval=0.9, maxval=0.999)
    sgm = u ** (1.0 / LRU_C)
    lru_lam = jnp.log(sgm) - jnp.log1p(-sgm)

    return {
        'x': jax.random.normal(ks[0], (BATCH, SEQ, D_MODEL), f32),
        'norm1_g': gain(ks[1], (L, D_MODEL)),
        'w_in': nrm(ks[2], (L, D_MODEL, IN_W), D_MODEL),
        'q_norm_g': gain(ks[3], (L, HEAD_DIM)),
        'k_norm_g': gain(ks[4], (L, HEAD_DIM)),
        'conv_w': nrm(ks[5], (L, CONV_W, LRU_W), CONV_W),
        'conv_b': bias(ks[6], (L, LRU_W)),
        'lru_wa': nrm(ks[7], (L, 2, LRU_BLOCKS, LRU_BW, LRU_BW), LRU_BW),
        'lru_ba': bias(ks[8], (L, 2, LRU_W), 0.1),
        'lru_wi': nrm(ks[9], (L, 2, LRU_BLOCKS, LRU_BW, LRU_BW), LRU_BW),
        'lru_bi': bias(ks[11], (L, 2, LRU_W), 0.1),
        'lru_lam': lru_lam,
        'attn_out_g': gain(ks[12], (L, ATTN_W)),
        'lru_out_g': gain(ks[13], (L, LRU_W)),
        'w_out': nrm(ks[14], (L, D_MIX, D_MODEL), D_MIX),
        'norm2_g': gain(ks[15], (L, D_MODEL)),
        'w_router': nrm(ks[16], (L, D_MODEL, N_EXPERTS), D_MODEL),
        'b_router': bias(ks[17], (L, N_EXPERTS)),
        'w_gate': nrm(ks[18], (L, N_EXPERTS, D_MODEL, D_FF), D_MODEL),
        'b_gate': bias(ks[19], (L, N_EXPERTS, D_FF)),
        'w_up': nrm(ks[20], (L, N_EXPERTS, D_MODEL, D_FF), D_MODEL),
        'b_up': bias(ks[21], (L, N_EXPERTS, D_FF)),
        'w_down': nrm(ks[22], (L, N_EXPERTS, D_FF, D_MODEL), D_FF),
        'b_down': bias(ks[23], (L, N_EXPERTS, D_MODEL)),
        'final_g': gain(ks[24], (D_MODEL,)),
    }


def reference(x, norm1_g, w_in, q_norm_g, k_norm_g, conv_w, conv_b, lru_wa, lru_ba,
              lru_wi, lru_bi, lru_lam, attn_out_g, lru_out_g, w_out, norm2_g,
              w_router, b_router, w_gate, b_gate, w_up, b_up, w_down, b_down, final_g):
    B, S, _ = x.shape
    n_rows_grid = S // GRID_W
    rows = jnp.broadcast_to(jnp.arange(n_rows_grid)[:, None], (n_rows_grid, GRID_W)).reshape(S)
    cols = jnp.broadcast_to(jnp.arange(GRID_W)[None, :], (n_rows_grid, GRID_W)).reshape(S)

    for l in range(DEPTH):
        xn = rms_norm(x, norm1_g[l])
        h_in = xn @ w_in[l]
        o0, o1, o2, o3 = ATTN_W, ATTN_W + KV_W, ATTN_W + 2 * KV_W, ATTN_W + 2 * KV_W + LRU_W
        q = h_in[..., :o0].reshape(B, S, N_Q_HEADS, HEAD_DIM)
        k = h_in[..., o0:o1].reshape(B, S, N_KV_HEADS, HEAD_DIM)
        v = h_in[..., o1:o2].reshape(B, S, N_KV_HEADS, HEAD_DIM)
        lru_x = h_in[..., o2:o3]
        lru_gate = h_in[..., o3:]

        q = rope_axial_2d(rms_norm(q, q_norm_g[l], 1e-6), rows, cols)
        k = rope_axial_2d(rms_norm(k, k_norm_g[l], 1e-6), rows, cols)
        attn = block_attention(q, k, v)

        xc = centred_depthwise_conv(lru_x, conv_w[l], conv_b[l])
        h_f = rglru_direction(xc, lru_wa[l, 0], lru_ba[l, 0], lru_wi[l, 0], lru_bi[l, 0],
                              lru_lam[l, 0], False)
        h_b = rglru_direction(xc, lru_wa[l, 1], lru_ba[l, 1], lru_wi[l, 1], lru_bi[l, 1],
                              lru_lam[l, 1], True)
        lru = ((h_f + h_b).astype(x.dtype)) * jax.nn.gelu(lru_gate)

        mixed = jnp.concatenate([rms_norm(attn, attn_out_g[l]),
                                 rms_norm(lru, lru_out_g[l])], axis=-1)
        x = x + mixed @ w_out[l]

        x = x + moe_ffn(rms_norm(x, norm2_g[l]), w_router[l], b_router[l], w_gate[l],
                        b_gate[l], w_up[l], b_up[l], w_down[l], b_down[l])

    return rms_norm(x, final_g)
```

```cpp
#define ONE_LAUNCH 1
#include <hip/hip_runtime.h>
#include <hip/hip_bf16.h>
#include <stdint.h>
#include <math.h>
#include <cstdio>

#ifndef MOE_MERGE
#define MOE_MERGE 0
#endif
namespace mk {
constexpr int NB = 2, S = 8192, T = NB * S, D = 1024, INW = 1792, NE = 32, LW = 512;
constexpr float C2 = 0.125f * 1.4426950408889634f;
constexpr int LC = 64, NCH = S / LC;
constexpr size_t MiB = 1u << 20;
constexpr size_t WS_CTL = 0, CTL_ZERO_BYTES = MOE_MERGE ? 1 * MiB : 32 * 1024;
constexpr size_t WS_ROPE = 1 * MiB;
constexpr size_t WS_WL = 1 * MiB + 64 * 1024;
constexpr size_t WS_RTR = 1 * MiB + 512 * 1024;
constexpr size_t WS_SUMS = 2 * MiB;
constexpr size_t WS_SSQ = 4 * MiB;
constexpr size_t WS_RSTD = 4 * MiB + 512 * 1024;
constexpr size_t WS_GATEV = 4 * MiB + 768 * 1024;
constexpr size_t WS_LIST = 5 * MiB;
constexpr size_t WS_WIN = 8 * MiB, WS_WOUT = 12 * MiB, WS_BT1 = 14 * MiB, WS_BT2 = 142 * MiB, WS_XN = 206 * MiB, WS_X1 = 238 * MiB;
constexpr size_t WS_Q = 302 * MiB, WS_K = 318 * MiB, WS_V = 322 * MiB, WS_LX = 326 * MiB, WS_LG = 342 * MiB, WS_MIX = 358 * MiB;
constexpr size_t WS_H = 302 * MiB, WS_Y = 14 * MiB, WS_X1B = 206 * MiB, WS_END = 446 * MiB;
constexpr size_t WS_LISTR = 2 * MiB;
constexpr size_t WS_LISTG = 224 * MiB;
constexpr size_t WS_SCR = 390 * MiB;
constexpr int CW_READY = 65536;
constexpr int CW_TMO = 0, CW_CODE = 1, CW_CNT = 64, CNT_STRIDE = 64, CW_BAR = 4096;

typedef unsigned short bf16_t;
__host__ __device__ __forceinline__ unsigned f2bf(float f) { unsigned u = __builtin_bit_cast(unsigned, f); return (u + 0x7fffu + ((u >> 16) & 1u)) >> 16; }
__host__ __device__ __forceinline__ float bf2f(unsigned h) { return __builtin_bit_cast(float, (h & 0xffffu) << 16); }
__host__ __device__ __forceinline__ unsigned pk2(float lo, float hi) { return f2bf(lo) | (f2bf(hi) << 16); }

typedef unsigned u32x4_t __attribute__((ext_vector_type(4)));
#ifndef WT_STORES
#define WT_STORES 1
#endif
template <int ON = 1> __device__ __forceinline__ void st16_wt(void* p, u32x4_t v) {
  if constexpr (ON) {
#if WT_STORES
    asm volatile("global_store_dwordx4 %0, %1, off sc1\n\ts_nop 1" :: "v"(p), "v"(v) : "memory");
#else
    *(u32x4_t*)p = v;
#endif
  } else *(u32x4_t*)p = v;
}
#ifndef WT_P0
#define WT_P0 0
#endif
#ifndef WT_EPI
#define WT_EPI 0
#endif
__host__ __device__ __forceinline__ int perm_cl(int o) { const int fq = o >> 3, n = (o >> 2) & 1, e = o & 3; return 16 * n + 4 * fq + e; }
__host__ __device__ __forceinline__ int perm256_dst(int c) { const int pn = c >> 8, cp = c & 255, bj = cp >> 7, wc = (cp >> 5) & 3; return 256 * pn + 128 * bj + 32 * wc + perm_cl(cp & 31); }
__host__ __device__ __forceinline__ int win_dst(int c) {
    if (c < 768) { const int pn = c >> 8, cp = c & 255, wc = cp >> 6, bj = (cp >> 5) & 1, j = cp & 31; return 256 * pn + 128 * bj + 32 * wc + j; }
    return perm256_dst(c);
}
__host__ __device__ __forceinline__ int down_dst(int c) { const int pn = c >> 8, cp = c & 255, wc = cp >> 6, fq = (cp >> 4) & 3, bj = (cp >> 3) & 1, n = (cp >> 2) & 1, e = cp & 3; return 256 * pn + 128 * bj + 32 * wc + 16 * n + 4 * fq + e; }
__host__ __device__ __forceinline__ int gu_dst(int hc, int half) { const int j = hc >> 7, wc = (hc >> 5) & 3; return 256 * j + 128 * half + 32 * wc + perm_cl(hc & 31); }
}
namespace nv {
using namespace mk;
__device__ __forceinline__ void tbl_rope(int idx, float* rope) {
    const int pos = idx >> 4, i = idx & 15; const float ang = (float)pos * powf(10000.0f, -(float)i / 16.0f);
    rope[idx] = cosf(ang); rope[2048 + idx] = sinf(ang);
}
__device__ __forceinline__ void tbl_wl(int idx, const float* wa, const float* wi, bf16_t* WL) {
    const int j = idx & 7, lane = (idx >> 3) & 63, ks = (idx >> 9) & 3, nh = (idx >> 11) & 1, mat = (idx >> 12) & 3, n = idx >> 14;
    const int r32 = lane & 31, hi = lane >> 5, i = 16 * ks + 8 * hi + j, jc = 32 * nh + r32, dir = mat >> 1;
    const float* W = (mat & 1) ? wi : wa;
    WL[idx] = (bf16_t)f2bf(W[((size_t)(dir * 8 + n) * 64 + i) * 64 + jc]);
}
__device__ __forceinline__ void tbl_rtr(int idx, const float* wr, const float* n2g, bf16_t* RT) {
    const int j = idx & 7, lane = (idx >> 3) & 63, ks = idx >> 9; const int e = lane & 31, hi = lane >> 5, k = 16 * ks + 8 * hi + j;
    const float w = n2g[k] * wr[(size_t)k * NE + e]; const unsigned h = f2bf(w);
    RT[idx] = (bf16_t)h; RT[32768 + idx] = (bf16_t)f2bf(w - bf2f(h));
}
}
namespace pg8 {
using mk::bf16_t;
#define PG8_LAS __attribute__((address_space(3)))
typedef short bf16x8 __attribute__((ext_vector_type(8)));
typedef float f32x4 __attribute__((ext_vector_type(4)));
typedef unsigned u32x4 __attribute__((ext_vector_type(4)));
typedef unsigned u32x2 __attribute__((ext_vector_type(2)));
typedef int v8i __attribute__((ext_vector_type(8)));
typedef int v4i __attribute__((ext_vector_type(4)));
constexpr int BM = 256, BK = 64, HALF = 128, HTB = HALF * BK * 2, STAGE_BYTES = 8 * HTB, NXCD = 8, WGM = 8, KD = 1024;

__host__ __device__ __forceinline__ int lds_byte(int r, int c) { const int st = (r >> 4) * 2 + (c >> 5), rr = r & 15, cc = c & 31, ob = rr * 64 + cc * 2; return st * 1024 + (ob ^ (((ob >> 9) & 1) << 5)); }
__host__ __device__ __forceinline__ void stage_rc(int b, int& R, int& C) { const int st = b / 1024, sb = b % 1024, swz = sb ^ (((sb >> 9) & 1) << 5); R = (st >> 1) * 16 + swz / 64; C = (st & 1) * 32 + (swz % 64) / 2; }

struct GUnit { int pm, pn, e, lt, kind; };

struct StaticSched {
    const char* Bt; int nM, nN, nwg, G, c;
    __device__ void init(const void* Bt_, int M, int N, int G_, int c_) { Bt = (const char*)Bt_; nM = M / BM; nN = N / BM; nwg = nM * nN; G = G_; c = c_; }
    __device__ __forceinline__ bool next(int i, GUnit& u) const {
        const long L = (long)i * G + c; if (L >= nwg) return false;
        int wgid = (int)L; { const int q = nwg / NXCD, r = nwg % NXCD, xcd = wgid % NXCD, off = wgid / NXCD; wgid = (xcd < r ? xcd * (q + 1) : r * (q + 1) + (xcd - r) * q) + off; }
        const int nig = WGM * nN, gid = wgid / nig, fm = gid * WGM, gsz = (nM - fm) < WGM ? (nM - fm) : WGM;
        u.pm = fm + ((wgid % nig) % gsz); u.pn = (wgid % nig) / gsz; u.e = 0; u.lt = 0; u.kind = 0; return true;
    }
    __device__ __forceinline__ void aoffs_issue(const GUnit& u, int tid, unsigned (&raw)[2][2]) const {
#pragma unroll
        for (int i = 0; i < 2; ++i) { int R, C; stage_rc(tid * 16 + i * 8192, R, C);
#pragma unroll
            for (int h = 0; h < 2; ++h) raw[h][i] = (unsigned)((u.pm * BM + h * HALF + R) * KD + C) * 2u; }
    }
    __device__ __forceinline__ void aoffs_finish(const GUnit&, int, const unsigned (&raw)[2][2], unsigned (&ao)[2][2]) const {
#pragma unroll
        for (int h = 0; h < 2; ++h)
#pragma unroll
            for (int i = 0; i < 2; ++i) ao[h][i] = raw[h][i];
    }
    __device__ __forceinline__ const char* bbase(const GUnit& u) const { return Bt + (size_t)u.pn * BM * KD * 2; }
    static constexpr int A_AUX = 0;
    __device__ __forceinline__ void wait_ready(const GUnit&, int) const {}
    __device__ __forceinline__ void publish(const GUnit&, int) const {}
};

template <class Epi, class Sched, bool F8 = false>
__device__ __forceinline__ void gemm_phase(PG8_LAS unsigned char* lds, const char* Abase, const Sched& S, const Epi& E) {
    int tid_ = threadIdx.x; asm volatile("" : "+v"(tid_));
    const int tid = tid_, wid = __builtin_amdgcn_readfirstlane(tid >> 6), lane = tid & 63, wr = wid >> 2, wc = wid & 3, fr = lane & 15, fq = lane >> 4;
    constexpr int K = KD, nt = F8 ? K / 128 : K / BK; constexpr unsigned ROWB = F8 ? 1024u : 2048u;
    unsigned voffB[2];
#pragma unroll
    for (int i = 0; i < 2; ++i) { int R, C; stage_rc(tid * 16 + i * 8192, R, C); voffB[i] = (unsigned)R * ROWB + 2u * (unsigned)C; }
    PG8_LAS u32x4* aon = (PG8_LAS u32x4*)(lds + STAGE_BYTES) + tid;
    constexpr unsigned kstep = BK * 2;
    constexpr size_t hstep = (size_t)HALF * ROWB;
    const unsigned ldsw = (unsigned)wid * 1024u;
    const int aoff = lds_byte(wr * 64 + fr, fq * 8), boff = lds_byte(wc * 32 + fr, fq * 8);
#define PG8_SA(b, h) (((b) * 2 + (h)) * HTB)
#define PG8_SB(b, h) ((4 + (b) * 2 + (h)) * HTB)
#define PG8_STAGE_B(bufoff, gbase) do { _Pragma("unroll") for (int _i = 0; _i < 2; ++_i) \
        __builtin_amdgcn_global_load_lds((const unsigned*)((const char*)(gbase) + voffB[_i]), (PG8_LAS unsigned*)(lds + (bufoff) + ldsw + _i * 8192), 16, 0, 0); } while (0)
#define PG8_STAGE_A(bufoff, o0, o1) do { \
        __builtin_amdgcn_global_load_lds((const unsigned*)(Abase + (o0)), (PG8_LAS unsigned*)(lds + (bufoff) + ldsw), 16, 0, Sched::A_AUX); \
        __builtin_amdgcn_global_load_lds((const unsigned*)(Abase + (o1)), (PG8_LAS unsigned*)(lds + (bufoff) + ldsw + 8192), 16, 0, Sched::A_AUX); } while (0)
#define PG8_LD2(p) __builtin_shufflevector(*(const PG8_LAS v4i*)(p), *(const PG8_LAS v4i*)((p) + 1024), 0, 1, 2, 3, 4, 5, 6, 7)
#define PG8_LDA(dst, b, h) do { _Pragma("unroll") for (int m = 0; m < 4; ++m) dst[m] = PG8_LD2(lds + PG8_SA(b, h) + aoff + m * 2048); } while (0)
#define PG8_LDB(dst, b, h) do { _Pragma("unroll") for (int n = 0; n < 2; ++n) dst[n] = PG8_LD2(lds + PG8_SB(b, h) + boff + n * 2048); } while (0)
#define PG8_HALF(v, k) __builtin_bit_cast(bf16x8, (v4i){(v)[4 * (k)], (v)[4 * (k) + 1], (v)[4 * (k) + 2], (v)[4 * (k) + 3]})
#define PG8_MMA(ai, bj, At, Bt) do { __builtin_amdgcn_s_setprio(1); \
        if constexpr (F8) { _Pragma("unroll") for (int m = 0; m < 4; ++m) _Pragma("unroll") for (int n = 0; n < 2; ++n) \
            asm volatile("v_mfma_scale_f32_16x16x128_f8f6f4 %0, %1, %2, %0, %3, %4 op_sel_hi:[0,0,0]" : "+v"(acc[ai][bj][m][n]) : "v"(Bt[n]), "v"(At[m]), "v"(scw), "v"(sca)); } \
        else { _Pragma("unroll") for (int m = 0; m < 4; ++m) _Pragma("unroll") for (int n = 0; n < 2; ++n) _Pragma("unroll") for (int k = 0; k < 2; ++k) \
            acc[ai][bj][m][n] = __builtin_amdgcn_mfma_f32_16x16x32_bf16(PG8_HALF(Bt[n], k), PG8_HALF(At[m], k), acc[ai][bj][m][n], 0, 0, 0); } \
        __builtin_amdgcn_s_setprio(0); } while (0)
#define PG8_WAIT_V(n) asm volatile("s_waitcnt vmcnt(" #n ")" ::: "memory")
#define PG8_WAIT_L(n) asm volatile("s_waitcnt lgkmcnt(" #n ")" ::: "memory")
#define PG8_BAR __builtin_amdgcn_s_barrier()
#define PG8_SCHED __builtin_amdgcn_sched_barrier(0)
    GUnit cur, nxt, nn; int ui = 0;
    if (!S.next(0, cur)) return;
    f32x4 acc[2][2][4][2];
#pragma unroll
    for (int a = 0; a < 2; ++a)
#pragma unroll
        for (int b = 0; b < 2; ++b)
#pragma unroll
            for (int m = 0; m < 4; ++m)
#pragma unroll
                for (int n = 0; n < 2; ++n) acc[a][b][m][n] = (f32x4){0.f, 0.f, 0.f, 0.f};
    v8i At[4], B0[2], B1[2];
    int scw = Epi::SC_W, sca = E.sc_a(cur); if constexpr (F8) asm volatile("" : "+v"(scw), "+v"(sca));
    unsigned aoC[2][2], rawN[2][2];
    S.wait_ready(cur, lane);
    { unsigned raw0[2][2]; S.aoffs_issue(cur, tid, raw0); S.aoffs_finish(cur, tid, raw0, aoC); }
    GUnit prv = cur; bool have_prv = false;
    bool has_next = S.next(1, nxt);
    if (has_next) S.aoffs_issue(nxt, tid, rawN);
    const char* cB = S.bbase(cur);
    PG8_STAGE_B(PG8_SB(0, 0), cB); PG8_STAGE_B(PG8_SB(0, 1), cB + hstep); PG8_STAGE_A(PG8_SA(0, 0), aoC[0][0], aoC[0][1]); PG8_STAGE_A(PG8_SA(0, 1), aoC[1][0], aoC[1][1]);
    if (wr == 1) PG8_BAR;
    PG8_WAIT_V(2); PG8_BAR;
    PG8_STAGE_B(PG8_SB(1, 0), cB + kstep); PG8_STAGE_A(PG8_SA(1, 0), aoC[0][0] + kstep, aoC[0][1] + kstep); PG8_STAGE_B(PG8_SB(1, 1), cB + hstep + kstep);
    PG8_WAIT_V(6); PG8_BAR;
    for (;;) {
        const bool has_nn = has_next && S.next(ui + 2, nn);
        if (has_next && nxt.kind && have_prv) { PG8_WAIT_V(0); S.publish(prv, lane); have_prv = false; }
        if (has_next) S.wait_ready(nxt, lane);
        const char* nB = cB;
        { unsigned aoN[2][2];
          if (has_next) { S.aoffs_finish(nxt, tid, rawN, aoN); nB = S.bbase(nxt); }
          else {
#pragma unroll
            for (int h = 0; h < 2; ++h)
#pragma unroll
                for (int i = 0; i < 2; ++i) aoN[h][i] = aoC[h][i];
          }
          *aon = (u32x4){aoN[0][0], aoN[0][1], aoN[1][0], aoN[1][1]}; }
        if (has_nn) S.aoffs_issue(nn, tid, rawN);
#pragma unroll 1
        for (int t = 0; t < nt; t += 2) {
            const bool last = (t == nt - 2);
            if constexpr (Epi::MID) { if (t == nt / 2) E.mid(acc, cur, wr, fr); }
            if (t == 2 && have_prv) { S.publish(prv, lane); have_prv = false; }
            if (last) E.prefetch(lds, cur, wid, lane);
            const unsigned k1 = (unsigned)(t + 1) * kstep;
            unsigned a2_00 = aoC[0][0] + (unsigned)(t + 2) * kstep, a2_01 = aoC[0][1] + (unsigned)(t + 2) * kstep, a2_10 = aoC[1][0] + (unsigned)(t + 2) * kstep, a2_11 = aoC[1][1] + (unsigned)(t + 2) * kstep;
            if (last) { const u32x4 v = *aon; a2_00 = v.x; a2_01 = v.y; a2_10 = v.z; a2_11 = v.w; }
            const char* b2 = last ? nB : cB + (size_t)(t + 2) * kstep; const char* b3 = b2 + kstep;
            PG8_LDB(B0, 0, 0); PG8_LDB(B1, 0, 1); PG8_SCHED; PG8_LDA(At, 0, 0); PG8_STAGE_A(PG8_SA(1, 1), aoC[1][0] + k1, aoC[1][1] + k1);
            PG8_WAIT_V(8); PG8_WAIT_L(0); PG8_BAR; PG8_MMA(0, 0, At, B0); PG8_MMA(0, 1, At, B1); PG8_BAR; PG8_SCHED;
            PG8_LDA(At, 0, 1); PG8_STAGE_B(PG8_SB(0, 0), b2); PG8_STAGE_B(PG8_SB(0, 1), b2 + hstep); PG8_STAGE_A(PG8_SA(0, 0), a2_00, a2_01);
            PG8_WAIT_V(8); PG8_WAIT_L(0); PG8_BAR; PG8_MMA(1, 0, At, B0); PG8_MMA(1, 1, At, B1); PG8_BAR; PG8_SCHED;
            PG8_LDB(B0, 1, 0); PG8_LDB(B1, 1, 1); PG8_SCHED; PG8_LDA(At, 1, 0); PG8_STAGE_A(PG8_SA(0, 1), a2_10, a2_11);
            PG8_WAIT_V(8); PG8_WAIT_L(0); PG8_BAR; PG8_MMA(0, 0, At, B0); PG8_MMA(0, 1, At, B1); PG8_BAR; PG8_SCHED;
            PG8_LDA(At, 1, 1); PG8_STAGE_B(PG8_SB(1, 0), b3); PG8_STAGE_B(PG8_SB(1, 1), b3 + hstep); PG8_STAGE_A(PG8_SA(1, 0), a2_00 + kstep, a2_01 + kstep);
            PG8_WAIT_V(8); PG8_WAIT_L(0); PG8_BAR; PG8_MMA(1, 0, At, B0); PG8_MMA(1, 1, At, B1); PG8_BAR; PG8_SCHED;
        }
        if constexpr (F8) asm volatile("s_nop 15\n\ts_nop 15" ::: "memory");
        if (wr == 0) PG8_BAR;
        E(acc, cur, lds, wr, wc, fr, fq);
        prv = cur; have_prv = true;
        if (!has_next) break;
#pragma unroll
        for (int a = 0; a < 2; ++a)
#pragma unroll
            for (int b = 0; b < 2; ++b)
#pragma unroll
                for (int m = 0; m < 4; ++m)
#pragma unroll
                    for (int n = 0; n < 2; ++n) acc[a][b][m][n] = (f32x4){0.f, 0.f, 0.f, 0.f};
        cur = nxt; nxt = nn; has_next = has_nn; cB = nB; ++ui;
        if constexpr (F8) { sca = E.sc_a(cur); asm volatile("" : "+v"(sca)); }
        { const u32x4 v = *aon; aoC[0][0] = v.x; aoC[0][1] = v.y; aoC[1][0] = v.z; aoC[1][1] = v.w; }
        if (wr == 1) PG8_BAR;
    }
    PG8_WAIT_V(0);
    if (have_prv) S.publish(prv, lane);
    PG8_BAR;
#undef PG8_SA
#undef PG8_SB
#undef PG8_STAGE_A
#undef PG8_STAGE_B
#undef PG8_LDA
#undef PG8_LDB
#undef PG8_MMA
#undef PG8_LD2
#undef PG8_HALF
#undef PG8_WAIT_V
#undef PG8_WAIT_L
#undef PG8_BAR
#undef PG8_SCHED
}
}
namespace pg8 {
using namespace mk;
__device__ __forceinline__ unsigned cvt_pk_bf16(float lo, float hi) { unsigned r; asm volatile("v_cvt_pk_bf16_f32 %0, %1, %2" : "=v"(r) : "v"(lo), "v"(hi)); return r; }

struct EpiInProj {
    static constexpr bool MID = false; static constexpr int SC_W = 0x7F7F7F7F, SC_A = 0x7F7F7F7F;
    __device__ __forceinline__ void prefetch(PG8_LAS unsigned char*, const GUnit&, int, int) const {}
    __device__ __forceinline__ int sc_a(const GUnit&) const { return SC_A; }
    bf16_t *Q, *Kb, *V, *LX, *LG; const float *qg, *kg, *rope;
    __device__ __forceinline__ void operator()(const f32x4 (&acc)[2][2][4][2], const GUnit& u, PG8_LAS unsigned char* lds, int wr, int wc, int fr_, int fq_) const {
        int fr = fr_, fq = fq_; asm volatile("" : "+v"(fr), "+v"(fq));
        const int row0 = u.pm * BM + wr * 64 + fr;
        if (u.pn >= 3) {
            bf16_t* base = (u.pn < 5) ? LX : LG; const int col0 = ((u.pn - 3) & 1) * 256 + wc * 32 + 8 * fq;
#pragma unroll
            for (int ai = 0; ai < 2; ++ai)
#pragma unroll
                for (int m = 0; m < 4; ++m) { bf16_t* rowp = base + (size_t)(row0 + ai * HALF + m * 16) * 512 + col0;
#pragma unroll
                    for (int bj = 0; bj < 2; ++bj) { const f32x4 v0 = acc[ai][bj][m][0], v1 = acc[ai][bj][m][1];
                        u32x4 w; w.x = cvt_pk_bf16(v0[0], v0[1]); w.y = cvt_pk_bf16(v0[2], v0[3]); w.z = cvt_pk_bf16(v1[0], v1[1]); w.w = cvt_pk_bf16(v1[2], v1[3]);
                        st16_wt<WT_EPI>(rowp + bj * HALF, w); } }
            return;
        }
        if (u.pn == 2 && wc >= 2) {
#pragma unroll
            for (int ai = 0; ai < 2; ++ai)
#pragma unroll
                for (int m = 0; m < 4; ++m) { bf16_t* rowp = V + (size_t)(row0 + ai * HALF + m * 16) * 128 + 64 * (wc - 2) + 4 * fq;
#pragma unroll
                    for (int bj = 0; bj < 2; ++bj)
#pragma unroll
                        for (int n = 0; n < 2; ++n) { const f32x4 v = acc[ai][bj][m][n]; u32x2 w; w.x = cvt_pk_bf16(v[0], v[1]); w.y = cvt_pk_bf16(v[2], v[3]); *(u32x2*)(rowp + 32 * bj + 16 * n) = w; } }
            return;
        }
        const bool isq = u.pn < 2; const float* gp = (isq ? qg : kg) + 4 * fq; const float osc = isq ? C2 : 1.0f;
#pragma unroll
        for (int ai = 0; ai < 2; ++ai)
#pragma unroll
            for (int m = 0; m < 4; ++m) {
                const int t = row0 + ai * HALF + m * 16;
                float ss = 0.f;
#pragma unroll
                for (int bj = 0; bj < 2; ++bj)
#pragma unroll
                    for (int n = 0; n < 2; ++n) { const f32x4 v = acc[ai][bj][m][n]; ss += (v[0] * v[0] + v[1] * v[1]) + (v[2] * v[2] + v[3] * v[3]); }
                ss += __shfl_xor(ss, 16); ss += __shfl_xor(ss, 32);
                const float rs = osc / sqrtf(ss * (1.0f / 64.0f) + 1e-6f);
                const int s = t & (S - 1), posr = s >> 6, posc = s & 63;
                bf16_t* rowp = isq ? Q + (size_t)t * 512 + 64 * (4 * u.pn + wc) + 4 * fq : Kb + (size_t)t * 128 + 64 * wc + 4 * fq;
#pragma unroll
                for (int bj = 0; bj < 2; ++bj) {
                    const int pos = bj ? posc : posr;
                    const f32x4 c4 = *(const f32x4*)(rope + pos * 16 + 4 * fq), s4 = *(const f32x4*)(rope + 2048 + pos * 16 + 4 * fq);
                    const f32x4 g0 = *(const f32x4*)(gp + 32 * bj), g1 = *(const f32x4*)(gp + 32 * bj + 16);
                    const f32x4 x1 = acc[ai][bj][m][0] * g0 * rs, x2 = acc[ai][bj][m][1] * g1 * rs;
                    const f32x4 o1 = x1 * c4 - x2 * s4, o2 = x2 * c4 + x1 * s4;
                    u32x2 w1, w2; w1.x = cvt_pk_bf16(o1[0], o1[1]); w1.y = cvt_pk_bf16(o1[2], o1[3]); w2.x = cvt_pk_bf16(o2[0], o2[1]); w2.y = cvt_pk_bf16(o2[2], o2[3]);
                    *(u32x2*)(rowp + 32 * bj) = w1; *(u32x2*)(rowp + 32 * bj + 16) = w2;
                }
                asm volatile("" ::: "memory");
            }
    }
};

struct EpiOut {
    static constexpr bool MID = true; static constexpr int SC_W = 0x7F7F7F7F, SC_A = 0x7F7F7F7F;
    __device__ __forceinline__ void prefetch(PG8_LAS unsigned char*, const GUnit&, int, int) const {}
    __device__ __forceinline__ int sc_a(const GUnit&) const { return SC_A; }
    const float* x; const float* SSQ; float* X1; unsigned char* X1F8;
    __device__ __forceinline__ void mid(f32x4 (&acc)[2][2][4][2], const GUnit& u, int wr, int fr_) const {
        int fr = fr_; asm volatile("" : "+v"(fr));
#pragma unroll
        for (int ai = 0; ai < 2; ++ai)
#pragma unroll
            for (int m = 0; m < 4; ++m) {
                const float* p = SSQ + (size_t)(u.pm * BM + ai * HALF + wr * 64 + m * 16 + fr) * 8;
                const f32x4 a = *(const f32x4*)p, b = *(const f32x4*)(p + 4);
                const float s = ((a[0] + a[1]) + (a[2] + a[3])) + ((b[0] + b[1]) + (b[2] + b[3]));
                const float sa = 1.0f / sqrtf(s * (1.0f / 512.0f) + 1e-5f);
#pragma unroll
                for (int bj = 0; bj < 2; ++bj)
#pragma unroll
                    for (int n = 0; n < 2; ++n) acc[ai][bj][m][n] *= sa;
            }
    }
    __device__ __forceinline__ void operator()(const f32x4 (&acc)[2][2][4][2], const GUnit& u, PG8_LAS unsigned char* lds, int wr, int wc, int fr_, int fq_) const {
        int fr = fr_, fq = fq_; asm volatile("" : "+v"(fr), "+v"(fq));
        const int row0 = u.pm * BM + wr * 64 + fr, col0 = u.pn * BM + wc * 32 + 8 * fq;
#pragma unroll
        for (int ai = 0; ai < 2; ++ai)
#pragma unroll
            for (int m = 0; m < 4; ++m) { const size_t off = (size_t)(row0 + ai * HALF + m * 16) * D + col0;
#pragma unroll
                for (int bj = 0; bj < 2; ++bj) {
                    const f32x4 v0 = __builtin_nontemporal_load((const f32x4*)(x + off + bj * HALF)) + acc[ai][bj][m][0], v1 = __builtin_nontemporal_load((const f32x4*)(x + off + bj * HALF + 4)) + acc[ai][bj][m][1];
                    st16_wt<WT_EPI>(X1 + off + bj * HALF, __builtin_bit_cast(u32x4, v0)); st16_wt<WT_EPI>(X1 + off + bj * HALF + 4, __builtin_bit_cast(u32x4, v1));
                    int w0 = 0, w1 = 0; w0 = __builtin_amdgcn_cvt_pk_fp8_f32(v0[0], v0[1], w0, false); w0 = __builtin_amdgcn_cvt_pk_fp8_f32(v0[2], v0[3], w0, true);
                    w1 = __builtin_amdgcn_cvt_pk_fp8_f32(v1[0], v1[1], w1, false); w1 = __builtin_amdgcn_cvt_pk_fp8_f32(v1[2], v1[3], w1, true);
                    *(u32x2*)(X1F8 + off + bj * HALF) = (u32x2){(unsigned)w0, (unsigned)w1}; }
                if (m & 1) asm volatile("" ::: "memory"); }
    }
};

struct MoeSched {
    const PG8_LAS unsigned* P;
    const PG8_LAS unsigned* cntl;
    const PG8_LAS unsigned char* te;
    const int* list; const char* Bt; size_t estride; int ntn, G, vcu; bool gather;
    __device__ __forceinline__ bool next(int i, GUnit& u) const {
        const unsigned L = (unsigned)i * (unsigned)G + (unsigned)vcu; const unsigned mt = L / (unsigned)ntn;
        const unsigned tot = (unsigned)__builtin_amdgcn_readfirstlane((int)P[NE]);
        if (mt >= tot) return false;
        const int e = __builtin_amdgcn_readfirstlane((int)te[mt]);
        u.kind = 0; u.pm = (int)mt; u.pn = (int)(L % (unsigned)ntn); u.e = e; u.lt = (int)(mt - (unsigned)__builtin_amdgcn_readfirstlane((int)P[e])); return true;
    }
    __device__ __forceinline__ void aoffs_issue(const GUnit& u, int tid, unsigned (&raw)[2][2]) const {
        const int n = (int)cntl[u.e] - u.lt * BM;
#pragma unroll
        for (int i = 0; i < 2; ++i) { int R, C; stage_rc(tid * 16 + i * 8192, R, C);
#pragma unroll
            for (int h = 0; h < 2; ++h) {
                const int rr = h * HALF + R;
                if (gather) { raw[h][i] = 0u; if (rr < n) raw[h][i] = (unsigned)list[(size_t)u.e * T + u.lt * BM + rr]; }
                else raw[h][i] = (unsigned)(u.pm * BM + rr);
            } }
    }
    __device__ __forceinline__ void aoffs_finish(const GUnit&, int tid, const unsigned (&raw)[2][2], unsigned (&ao)[2][2]) const {
#pragma unroll
        for (int i = 0; i < 2; ++i) { int R, C; stage_rc(tid * 16 + i * 8192, R, C);
#pragma unroll
            for (int h = 0; h < 2; ++h) ao[h][i] = (gather ? (raw[h][i] >> 2) : raw[h][i]) * 1024u + 2u * (unsigned)C; }
    }
    __device__ __forceinline__ const char* bbase(const GUnit& u) const { return Bt + (size_t)u.e * estride + (size_t)u.pn * BM * 1024; }
    static constexpr int A_AUX = 0;
    __device__ __forceinline__ void wait_ready(const GUnit&, int) const {}
    __device__ __forceinline__ void publish(const GUnit&, int) const {}
};

struct EpiMoe1 {
    static constexpr bool MID = false; static constexpr int SC_W = 0x7A7A7A7A, SC_A = 0x7F7F7F7F;
    const PG8_LAS unsigned* cntl; const float* listr; const float* bg; const float* bu; unsigned char* H;
    __device__ __forceinline__ int sc_a(const GUnit&) const { return SC_A; }
    static constexpr int PRE_OFF = STAGE_BYTES + 8192;
    __device__ __forceinline__ void prefetch(PG8_LAS unsigned char* lds, const GUnit& u, int wid, int lane) const {
        if (wid < 4) { const int nvalid = (int)cntl[u.e] - u.lt * BM; int r = wid * 64 + lane; r = r < nvalid ? r : 0;
            __builtin_amdgcn_global_load_lds((const unsigned*)(listr + (size_t)u.e * T + u.lt * BM + r), (PG8_LAS unsigned*)(lds + PRE_OFF + wid * 256), 4, 0, 0); }
    }
    __device__ __forceinline__ void operator()(const f32x4 (&acc)[2][2][4][2], const GUnit& u, PG8_LAS unsigned char* lds, int wr, int wc, int fr_, int fq_) const {
        int fr = fr_, fq = fq_; asm volatile("" : "+v"(fr), "+v"(fq));
        const int nvalid = (int)cntl[u.e] - u.lt * BM; const int hc0 = u.pn * HALF + wc * 32 + 8 * fq;
        f32x4 bgv[2], buv[2];
#pragma unroll
        for (int n = 0; n < 2; ++n) { bgv[n] = *(const f32x4*)(bg + u.e * D + hc0 + 4 * n); buv[n] = *(const f32x4*)(bu + u.e * D + hc0 + 4 * n); }
#pragma unroll
        for (int ai = 0; ai < 2; ++ai)
#pragma unroll
            for (int m = 0; m < 4; ++m) {
                const int rl = ai * HALF + wr * 64 + m * 16 + fr;
                if (rl < nvalid) {
                    const float rs = *(const PG8_LAS float*)(lds + PRE_OFF + rl * 4);
                    int w[2] = {0, 0};
#pragma unroll
                    for (int n = 0; n < 2; ++n) {
                        f32x4 g = acc[ai][0][m][n] * rs + bgv[n], uu = acc[ai][1][m][n] * rs + buv[n], hv;
#pragma unroll
                        for (int e = 0; e < 4; ++e) { const float gc = fminf(g[e], 7.0f), uc = fminf(fmaxf(uu[e], -7.0f), 7.0f);
                            const float sg = __builtin_amdgcn_rcpf(1.0f + __builtin_amdgcn_exp2f(-1.702f * 1.4426950408889634f * gc)); hv[e] = (uc + 1.0f) * gc * sg; }
                        w[n] = __builtin_amdgcn_cvt_pk_fp8_f32(4.0f * hv[0], 4.0f * hv[1], w[n], false); w[n] = __builtin_amdgcn_cvt_pk_fp8_f32(4.0f * hv[2], 4.0f * hv[3], w[n], true);
                    }
#if MOE_MERGE
                    __hip_atomic_store((unsigned long long*)(H + (size_t)(u.pm * BM + rl) * 1024 + hc0), (unsigned long long)(unsigned)w[0] | ((unsigned long long)(unsigned)w[1] << 32), __ATOMIC_RELAXED, __HIP_MEMORY_SCOPE_AGENT);
#else
                    *(u32x2*)(H + (size_t)(u.pm * BM + rl) * 1024 + hc0) = (u32x2){(unsigned)w[0], (unsigned)w[1]};
#endif
                }
            }
    }
};
struct EpiMoe2 {
    static constexpr bool MID = false; static constexpr int SC_W = 0x7A7A7A7A, SC_A = 0x7D7D7D7D;
    const PG8_LAS unsigned* cntl; const int* list; const float* listg; const float* bd; unsigned char* Y;
    __device__ __forceinline__ int sc_a(const GUnit&) const { return SC_A; }
    static constexpr int PRE_OFF = STAGE_BYTES + 8192;
    __device__ __forceinline__ void prefetch(PG8_LAS unsigned char* lds, const GUnit& u, int wid, int lane) const {
        const int nvalid = (int)cntl[u.e] - u.lt * BM; int r = (wid & 3) * 64 + lane; r = r < nvalid ? r : 0;
        const size_t pos = (size_t)u.e * T + u.lt * BM + r;
        const unsigned* src = (wid < 4) ? (const unsigned*)(list + pos) : (const unsigned*)(listg + pos);
        __builtin_amdgcn_global_load_lds(src, (PG8_LAS unsigned*)(lds + PRE_OFF + (wid >> 2) * 1024 + (wid & 3) * 256), 4, 0, 0);
    }
    __device__ __forceinline__ void operator()(const f32x4 (&acc)[2][2][4][2], const GUnit& u, PG8_LAS unsigned char* lds, int wr, int wc, int fr_, int fq_) const {
        int fr = fr_, fq = fq_; asm volatile("" : "+v"(fr), "+v"(fq));
        const int nvalid = (int)cntl[u.e] - u.lt * BM; const int c0 = u.pn * BM + wc * 64 + 16 * fq;
        f32x4 bv[2][2];
#pragma unroll
        for (int bj = 0; bj < 2; ++bj)
#pragma unroll
            for (int n = 0; n < 2; ++n) bv[bj][n] = *(const f32x4*)(bd + u.e * D + c0 + 8 * bj + 4 * n);
#pragma unroll
        for (int ai = 0; ai < 2; ++ai)
#pragma unroll
            for (int m = 0; m < 4; ++m) {
                const int rl = ai * HALF + wr * 64 + m * 16 + fr;
                if (rl < nvalid) {
                    const int id = *(const PG8_LAS int*)(lds + PRE_OFF + rl * 4); const float gv = 16.0f * *(const PG8_LAS float*)(lds + PRE_OFF + 1024 + rl * 4);
                    int w[4];
#pragma unroll
                    for (int bj = 0; bj < 2; ++bj)
#pragma unroll
                        for (int n = 0; n < 2; ++n) { const f32x4 v = (acc[ai][bj][m][n] + bv[bj][n]) * gv; int t = 0;
                            t = __builtin_amdgcn_cvt_pk_fp8_f32(v[0], v[1], t, false); t = __builtin_amdgcn_cvt_pk_fp8_f32(v[2], v[3], t, true); w[2 * bj + n] = t; }
                    st16_wt<WT_EPI>(Y + (size_t)id * D + c0, (u32x4){(unsigned)w[0], (unsigned)w[1], (unsigned)w[2], (unsigned)w[3]});
                }
            }
    }
};

struct MoeSchedM {
    const PG8_LAS unsigned* P; const PG8_LAS unsigned* cntl; const PG8_LAS unsigned char* te;
    const int* list; unsigned* ready; unsigned* tmo; unsigned char* ws; int G, vcu;
    static constexpr int A_AUX = 16;
    __device__ __forceinline__ bool next(int i, GUnit& u) const {
        const unsigned L = (unsigned)i * (unsigned)G + (unsigned)vcu; const unsigned tot = (unsigned)__builtin_amdgcn_readfirstlane((int)P[NE]);
        unsigned mt;
        if (L < tot * 8u) { u.kind = 0; mt = L >> 3; u.pn = (int)(L & 7u); }
        else { const unsigned L2 = L - tot * 8u; if (L2 >= tot * 4u) return false; u.kind = 1; mt = L2 >> 2; u.pn = (int)(L2 & 3u); }
        const int e = __builtin_amdgcn_readfirstlane((int)te[mt]);
        u.pm = (int)mt; u.e = e; u.lt = (int)(mt - (unsigned)__builtin_amdgcn_readfirstlane((int)P[e])); return true;
    }
    __device__ __forceinline__ void aoffs_issue(const GUnit& u, int tid, unsigned (&raw)[2][2]) const {
        const int n = (int)cntl[u.e] - u.lt * BM;
#pragma unroll
        for (int i = 0; i < 2; ++i) { int R, C; stage_rc(tid * 16 + i * 8192, R, C);
#pragma unroll
            for (int h = 0; h < 2; ++h) { const int rr = h * HALF + R;
                if (u.kind == 0) { raw[h][i] = 0u; if (rr < n) raw[h][i] = (unsigned)list[(size_t)u.e * T + u.lt * BM + rr]; }
                else raw[h][i] = (unsigned)(u.pm * BM + rr); } }
    }
    __device__ __forceinline__ void aoffs_finish(const GUnit& u, int tid, const unsigned (&raw)[2][2], unsigned (&ao)[2][2]) const {
#pragma unroll
        for (int i = 0; i < 2; ++i) { int R, C; stage_rc(tid * 16 + i * 8192, R, C);
#pragma unroll
            for (int h = 0; h < 2; ++h) ao[h][i] = (u.kind == 0 ? (unsigned)WS_X1B + (raw[h][i] >> 2) * 1024u : (unsigned)WS_H + raw[h][i] * 1024u) + 2u * (unsigned)C; }
    }
    __device__ __forceinline__ const char* bbase(const GUnit& u) const {
        return (const char*)ws + (u.kind == 0 ? WS_BT1 + (size_t)u.e * 2048 * 1024 : WS_BT2 + (size_t)u.e * 1024 * 1024) + (size_t)u.pn * BM * 1024; }
    __device__ __forceinline__ void wait_ready(const GUnit& u, int lane) const {
        if (u.kind == 0) return;
        unsigned* p = ready + 64 * u.pm; unsigned sp = 0;
        while ((unsigned)__builtin_amdgcn_readfirstlane((int)__hip_atomic_load(p, __ATOMIC_RELAXED, __HIP_MEMORY_SCOPE_AGENT)) < 64u) {
            __builtin_amdgcn_s_sleep(2);
            if (++sp > (1u << 20)) { if (lane == 0) __hip_atomic_store(tmo, 0x6000u | (unsigned)u.pm, __ATOMIC_RELAXED, __HIP_MEMORY_SCOPE_AGENT); break; }
        }
    }
    __device__ __forceinline__ void publish(const GUnit& u, int lane) const {
        if (u.kind == 0 && lane == 0) __hip_atomic_fetch_add(ready + 64 * u.pm, 1u, __ATOMIC_RELAXED, __HIP_MEMORY_SCOPE_AGENT);
    }
};
struct EpiMoeM {
    static constexpr bool MID = false; static constexpr int SC_W = 0x7A7A7A7A, SC_A = 0x7F7F7F7F;
    EpiMoe1 e1; EpiMoe2 e2;
    __device__ __forceinline__ int sc_a(const GUnit& u) const { return u.kind ? EpiMoe2::SC_A : EpiMoe1::SC_A; }
    __device__ __forceinline__ void prefetch(PG8_LAS unsigned char* lds, const GUnit& u, int wid, int lane) const { if (u.kind) e2.prefetch(lds, u, wid, lane); else e1.prefetch(lds, u, wid, lane); }
    __device__ __forceinline__ void operator()(const f32x4 (&acc)[2][2][4][2], const GUnit& u, PG8_LAS unsigned char* lds, int wr, int wc, int fr, int fq) const {
        if (u.kind) e2(acc, u, lds, wr, wc, fr, fq); else e1(acc, u, lds, wr, wc, fr, fq);
    }
};
}
namespace attn_body {
using bf16 = __hip_bfloat16;
using bf16x8 = __attribute__((ext_vector_type(8))) short;
using s16x4 = __attribute__((ext_vector_type(4))) short;
using f32x16 = __attribute__((ext_vector_type(16))) float;
using u32x4 = __attribute__((ext_vector_type(4))) unsigned;
constexpr int SEQ = mk::S, D = 64, QP = 512, KP = 128, OP = 1024;
constexpr int NW = 8, QBLK = 32, QB = QBLK * NW, KVBLK = 64, NT = SEQ / KVBLK;
__device__ __forceinline__ int crow(int r, int hi) { return (r & 3) + 8 * (r >> 2) + 4 * hi; }
#define SBAR() __builtin_amdgcn_sched_barrier(0)
constexpr int NSLOT = 3, SLOTB = 8192;
constexpr int LDS_K = 0, LDS_V = NSLOT * SLOTB, LDS_WS = 2 * NSLOT * SLOTB, LDS_OST = LDS_WS + NW * 64 * 4, LDS_BYTES = LDS_OST + NW * 4096;
__device__ __forceinline__ void glds16(const void* gsrc, unsigned lds_dst) { unsigned keep;
    asm volatile("s_mov_b32 %0, m0\n\ts_mov_b32 m0, %2\n\ts_nop 0\n\tglobal_load_lds_dwordx4 %1, off\n\ts_mov_b32 m0, %0" : "=&s"(keep) : "v"(gsrc), "s"(lds_dst) : "memory"); }
__device__ __forceinline__ float max3f(float a, float b, float c) { float r; asm("v_max3_f32 %0, %1, %2, %3" : "=v"(r) : "v"(a), "v"(b), "v"(c)); return r; }
__device__ __forceinline__ float max2f(float a, float b) { float r; asm("v_max_f32_e32 %0, %1, %2" : "=v"(r) : "v"(a), "v"(b)); return r; }
__device__ __forceinline__ float fadd_s(float a, float b) { float r; asm("v_add_f32_e32 %0, %1, %2" : "=v"(r) : "v"(a), "v"(b)); return r; }
__device__ __forceinline__ float fsub_s(float a, float b) { float r; asm("v_sub_f32_e32 %0, %1, %2" : "=v"(r) : "v"(a), "v"(b)); return r; }
typedef float f32x2_t __attribute__((ext_vector_type(2))); typedef __bf16 bf16x2_t __attribute__((ext_vector_type(2)));
__device__ __forceinline__ unsigned cvtpk_s(float lo, float hi) { f32x2_t v = {lo, hi}; bf16x2_t b = __builtin_convertvector(v, bf16x2_t); return __builtin_bit_cast(unsigned, b); }
#define WAIT_BAR(N) asm volatile("s_waitcnt vmcnt(" #N ") lgkmcnt(0)\n\ts_barrier" ::: "memory")

__device__ __forceinline__ void qkt(f32x16& p0, f32x16& p1, const char* Kslot, const bf16x8* qr, const f32x16& negm, int r32, int hi) {
    const char* kb = Kslot + hi * 1024 + r32 * 16;
#pragma unroll
    for (int d0 = 0; d0 < 4; ++d0) {
        const bf16x8 b0 = *reinterpret_cast<const bf16x8*>(kb + d0 * 2048);
        const bf16x8 b1 = *reinterpret_cast<const bf16x8*>(kb + d0 * 2048 + 512);
        if (d0 == 0) { p0 = __builtin_amdgcn_mfma_f32_32x32x16_bf16(b0, qr[0], negm, 0, 0, 0); p1 = __builtin_amdgcn_mfma_f32_32x32x16_bf16(b1, qr[0], negm, 0, 0, 0); }
        else { p0 = __builtin_amdgcn_mfma_f32_32x32x16_bf16(b0, qr[d0], p0, 0, 0, 0); p1 = __builtin_amdgcn_mfma_f32_32x32x16_bf16(b1, qr[d0], p1, 0, 0, 0); } }
}
typedef __attribute__((address_space(3))) const char* lds_cptr;
typedef short v4i16_t __attribute__((ext_vector_type(4)));
__device__ __forceinline__ void kload8(bf16x8* kf, lds_cptr kp) {
    kf[0] = *(const __attribute__((address_space(3))) bf16x8*)(kp);        kf[1] = *(const __attribute__((address_space(3))) bf16x8*)(kp + 512);
    kf[2] = *(const __attribute__((address_space(3))) bf16x8*)(kp + 2048); kf[3] = *(const __attribute__((address_space(3))) bf16x8*)(kp + 2560);
    kf[4] = *(const __attribute__((address_space(3))) bf16x8*)(kp + 4096); kf[5] = *(const __attribute__((address_space(3))) bf16x8*)(kp + 4608);
    kf[6] = *(const __attribute__((address_space(3))) bf16x8*)(kp + 6144); kf[7] = *(const __attribute__((address_space(3))) bf16x8*)(kp + 6656);
}
__device__ __forceinline__ void kload2(bf16x8* kf, lds_cptr kp, int j) { kf[2 * j] = *(const __attribute__((address_space(3))) bf16x8*)(kp + j * 2048); kf[2 * j + 1] = *(const __attribute__((address_space(3))) bf16x8*)(kp + j * 2048 + 512); }
__device__ __forceinline__ s16x4 vtr(lds_cptr p) { return __builtin_bit_cast(s16x4, __builtin_amdgcn_ds_read_tr16_b64_v4i16((__attribute__((address_space(3))) v4i16_t*)p)); }
__device__ __forceinline__ float rowmax(const f32x16& p0, const f32x16& p1) {
    float a = max3f(p0[0], p0[1], p1[0]), b = max3f(p0[2], p0[3], p1[1]); a = max3f(a, p1[2], p1[3]);
#pragma unroll
    for (int r = 4; r < 16; r += 4) { a = max3f(a, p0[r], p0[r + 1]); b = max3f(b, p0[r + 2], p0[r + 3]); a = max3f(a, p1[r], p1[r + 1]); b = max3f(b, p1[r + 2], p1[r + 3]); }
    const float m = max2f(a, b);
    auto rr = __builtin_amdgcn_permlane32_swap(__float_as_uint(m), __float_as_uint(m), false, false);
    return max2f(__uint_as_float(rr[0]), __uint_as_float(rr[1]));
}
__device__ __forceinline__ void pv(f32x16* o, int vb, bf16x8 pa0, bf16x8 pa1, bf16x8 pa2, bf16x8 pa3) {
#pragma unroll
    for (int d0 = 0; d0 < 2; ++d0) { s16x4 lo[4], hi[4];
#pragma unroll
        for (int ks = 0; ks < 4; ++ks) {
            asm volatile("ds_read_b64_tr_b16 %0,%1 offset:%c2" : "=&v"(lo[ks]) : "v"(vb), "i"(d0 * 4096 + ks * 1024) : "memory");
            asm volatile("ds_read_b64_tr_b16 %0,%1 offset:%c2" : "=&v"(hi[ks]) : "v"(vb), "i"(d0 * 4096 + ks * 1024 + 512) : "memory"); }
        asm volatile("s_waitcnt lgkmcnt(0)" ::: "memory"); SBAR();
#define PK(k) (bf16x8){lo[k][0], lo[k][1], lo[k][2], lo[k][3], hi[k][0], hi[k][1], hi[k][2], hi[k][3]}
        o[d0] = __builtin_amdgcn_mfma_f32_32x32x16_bf16(pa0, PK(0), o[d0], 0, 0, 0);
        o[d0] = __builtin_amdgcn_mfma_f32_32x32x16_bf16(pa1, PK(1), o[d0], 0, 0, 0);
        o[d0] = __builtin_amdgcn_mfma_f32_32x32x16_bf16(pa2, PK(2), o[d0], 0, 0, 0);
        o[d0] = __builtin_amdgcn_mfma_f32_32x32x16_bf16(pa3, PK(3), o[d0], 0, 0, 0);
#undef PK
    }
}

template <int THRL, bool FIXREF> __device__ __forceinline__ void attn_unit(int b, int h, int qb, const bf16* Q, const bf16* __restrict__ K, const bf16* __restrict__ V, bf16* O, float* SSQ, char* shm, float mref) {
    int tid_ = threadIdx.x; asm volatile("" : "+v"(tid_));
    const int tid = tid_, lane = tid & 63, r32 = lane & 31, hi = lane >> 5; const int wid = __builtin_amdgcn_readfirstlane(tid >> 6);
    const long rowbase = (long)b * SEQ; const int q0 = qb * QB; const int kvh = h >> 2;
    const bf16* Qw = Q + (rowbase + q0 + wid * QBLK) * QP + h * D;
    const bf16 *Kh = K + rowbase * KP + kvh * D, *Vh = V + rowbase * KP + kvh * D;
    const unsigned lds0 = (unsigned)(uintptr_t)shm;
    float* wsf = (float*)(shm + LDS_WS) + wid * 64;
    const bf16* ksrc = Kh + (long)lane * KP + wid * 8;
    const bf16* vsrc = Vh + (long)(16 * (wid & 3) + (lane >> 2)) * KP + (wid >> 2) * 32 + (lane & 3) * 8;
    const unsigned kdst = lds0 + LDS_K + wid * 1024, vdst = lds0 + LDS_V + wid * 1024;
#define DMA_K(t, slot) glds16(ksrc + (long)(t) * KVBLK * KP, (unsigned)__builtin_amdgcn_readfirstlane(kdst + (slot)))
#define DMA_V(t, slot) glds16(vsrc + (long)(t) * KVBLK * KP, (unsigned)__builtin_amdgcn_readfirstlane(vdst + (slot)))
    const int vb0 = (int)(lds0 + LDS_V) + ((lane >> 4) & 1) * 32 + (lane & 3) * 8 + (4 * hi + ((lane & 15) >> 2)) * 64;
    const char* Kbase = shm + LDS_K; bf16x8 kf[8];
    const lds_cptr shm3 = (lds_cptr)shm; const lds_cptr kp0 = shm3 + LDS_K + hi * 1024 + r32 * 16; const lds_cptr vp0 = shm3 + LDS_V + ((lane >> 4) & 1) * 32 + (lane & 3) * 8 + (4 * hi + ((lane & 15) >> 2)) * 64;
    DMA_K(0, 0); DMA_V(0, 0); DMA_K(1, SLOTB);
    bf16x8 qr[4];
#pragma unroll
    for (int d0 = 0; d0 < 4; ++d0) qr[d0] = __builtin_nontemporal_load(reinterpret_cast<const bf16x8*>(&Qw[(long)r32 * QP + d0 * 16 + hi * 8]));
    float mhat = 0.f, l_reg = 0.f; f32x16 o[2]; o[0] = f32x16{}; o[1] = f32x16{}; f32x16 negm = f32x16{}; asm volatile("" : "+v"(negm));
    bool resc = false;
#define START(P0, P1) do { const float rm = FIXREF ? mref : rowmax(P0, P1); resc = false; \
    { const float dl = rm; mhat = fadd_s(mhat, dl); \
      _Pragma("unroll") for (int r = 0; r < 16; ++r) { P0[r] = fsub_s(P0[r], dl); P1[r] = fsub_s(P1[r], dl); } \
      _Pragma("unroll") for (int r = 0; r < 16; ++r) negm[r] = -mhat; asm volatile("" : "+v"(negm)); } \
    _Pragma("unroll") for (int r = 0; r < 16; ++r) P0[r] = __builtin_amdgcn_exp2f(P0[r]); } while (0)
#define RESC() do { if (!FIXREF && resc) { asm volatile("s_waitcnt lgkmcnt(0)" ::: "memory"); \
      _Pragma("unroll") for (int d_ = 0; d_ < 2; ++d_) _Pragma("unroll") for (int r = 0; r < 16; ++r) o[d_][r] *= wsf[crow(r, hi)]; } } while (0)
    f32x16 pA0, pA1, pB0, pB1;
    int sl_prev = 0, sl_cur = 0, sl_next = SLOTB;
#define ROT() do { sl_prev = sl_cur; sl_cur = sl_next; sl_next = (sl_next == (NSLOT - 1) * SLOTB) ? 0 : sl_next + SLOTB; } while (0)
    DMA_K(2, 2 * SLOTB);
    WAIT_BAR(3);
    qkt(pA0, pA1, Kbase, qr, negm, r32, hi); asm volatile("s_nop 15\n\ts_nop 7" : "+v"(pA0), "+v"(pA1));
    START(pA0, pA1);
    _Pragma("unroll") for (int r = 0; r < 16; ++r) pA1[r] = __builtin_amdgcn_exp2f(pA1[r]);
    WAIT_BAR(0);
    DMA_K(3, 0); DMA_V(1, SLOTB);
    ROT();
    kload8(kf, kp0 + sl_cur);
    WAIT_BAR(2);
    s16x4 vlo[8], vhi[8]; u32x4 pw0, pw1, pw2, pw3;
#define PKW(P, B) cvtpk_s(P[B], P[B + 1])
#define PAF(k) __builtin_bit_cast(bf16x8, pw##k)
#define VFR(i) (bf16x8){vlo[i][0], vlo[i][1], vlo[i][2], vlo[i][3], vhi[i][0], vhi[i][1], vhi[i][2], vhi[i][3]}
#define PIN(x) asm volatile("" : "+v"(x))
#define MX3(a, b, c) __builtin_fmaxf(__builtin_fmaxf((a), (b)), (c))
#define GAPA(MF, A0, A1, A2, A3, W0, W1, PW) do { MF; sacc += A0; sacc += A1; sacc += A2; sacc += A3; PIN(sacc); W0; W1; PIN(PW); SBAR(); } while (0)
#define EX(v) __builtin_amdgcn_exp2f(v)
#define GAPB(MF, X, B) do { MF; X[B] = EX(X[B]); X[B + 1] = EX(X[B + 1]); X[B + 2] = EX(X[B + 2]); X[B + 3] = EX(X[B + 3]); PIN(X); SBAR(); } while (0)
#define VRD(i) do { vlo[i] = vtr(vp_ + (((i) >> 2) * 4096 + ((i) & 3) * 1024)); vhi[i] = vtr(vp_ + (((i) >> 2) * 4096 + ((i) & 3) * 1024 + 512)); } while (0)
#define KRD(G, j) do { if (G) { kload2(kf, kp0 + sl_next, j); SBAR(); } } while (0)
#define STEP(C0, C1, P0, P1, t, GK, GV, GL) do { SBAR(); \
    const lds_cptr vp_ = vp0 + sl_prev; \
    VRD(0); SBAR(); float sacc = (P0[0] + P0[1]); \
    GAPA(C0 = __builtin_amdgcn_mfma_f32_32x32x16_bf16(kf[0], qr[0], negm, 0, 0, 0), P0[2], P0[3], P0[4], P0[5],     pw0[0] = PKW(P0, 0), pw0[1] = PKW(P0, 2), pw0); \
    VRD(4); SBAR(); GAPA(C1 = __builtin_amdgcn_mfma_f32_32x32x16_bf16(kf[1], qr[0], negm, 0, 0, 0), P0[6], P0[7], P0[8], P0[9],     pw0[2] = PKW(P0, 4), pw0[3] = PKW(P0, 6), pw0); \
    VRD(1); SBAR(); GAPA(C0 = __builtin_amdgcn_mfma_f32_32x32x16_bf16(kf[2], qr[1], C0, 0, 0, 0),   P0[10], P0[11], P0[12], P0[13], pw1[0] = PKW(P0, 8), pw1[1] = PKW(P0, 10), pw1); \
    VRD(5); SBAR(); GAPA(C1 = __builtin_amdgcn_mfma_f32_32x32x16_bf16(kf[3], qr[1], C1, 0, 0, 0),   P0[14], P0[15], P1[0], P1[1],   pw1[2] = PKW(P0, 12), pw1[3] = PKW(P0, 14), pw1); \
    VRD(2); SBAR(); GAPA(C0 = __builtin_amdgcn_mfma_f32_32x32x16_bf16(kf[4], qr[2], C0, 0, 0, 0),   P1[2], P1[3], P1[4], P1[5],     pw2[0] = PKW(P1, 0), pw2[1] = PKW(P1, 2), pw2); \
    VRD(6); SBAR(); GAPA(C1 = __builtin_amdgcn_mfma_f32_32x32x16_bf16(kf[5], qr[2], C1, 0, 0, 0),   P1[6], P1[7], P1[8], P1[9],     pw2[2] = PKW(P1, 4), pw2[3] = PKW(P1, 6), pw2); \
    VRD(3); SBAR(); GAPA(C0 = __builtin_amdgcn_mfma_f32_32x32x16_bf16(kf[6], qr[3], C0, 0, 0, 0),   P1[10], P1[11], P1[12], P1[13], pw3[0] = PKW(P1, 8), pw3[1] = PKW(P1, 10), pw3); \
    VRD(7); SBAR(); GAPA(C1 = __builtin_amdgcn_mfma_f32_32x32x16_bf16(kf[7], qr[3], C1, 0, 0, 0),   P1[14], P1[15], 0.f, 0.f,       pw3[2] = PKW(P1, 12), pw3[3] = PKW(P1, 14), pw3); \
    l_reg += sacc; \
    if (GK) { DMA_K((t) + 3, sl_cur); } if (GV) { DMA_V((t) + 1, sl_next); } \
    if constexpr (!FIXREF) { float a = MX3(C0[0], C0[1], C1[0]), b = MX3(C0[2], C0[3], C1[1]); a = MX3(a, C1[2], C1[3]); \
      _Pragma("unroll") for (int r = 4; r < 16; r += 4) { a = MX3(a, C0[r], C0[r + 1]); b = MX3(b, C0[r + 2], C0[r + 3]); a = MX3(a, C1[r], C1[r + 1]); b = MX3(b, C1[r + 2], C1[r + 3]); } \
      float rm = __builtin_fmaxf(a, b); { auto rr = __builtin_amdgcn_permlane32_swap(__float_as_uint(rm), __float_as_uint(rm), false, false); rm = __builtin_fmaxf(__uint_as_float(rr[0]), __uint_as_float(rr[1])); } \
      resc = false; \
      if (__builtin_expect(__any(rm > (float)THRL), 0)) { const float dl = __builtin_fmaxf(rm, 0.f); mhat += dl; \
        _Pragma("unroll") for (int r = 0; r < 16; ++r) { C0[r] -= dl; C1[r] -= dl; } \
        _Pragma("unroll") for (int r = 0; r < 16; ++r) negm[r] = -mhat; asm volatile("" : "+v"(negm)); \
        const float f = __builtin_amdgcn_exp2f(-dl); l_reg *= f; if (hi == 0) wsf[r32] = f; resc = true; } } \
    SBAR(); \
    GAPB(o[0] = __builtin_amdgcn_mfma_f32_32x32x16_bf16(PAF(0), VFR(0), o[0], 0, 0, 0), C0, 0); \
    GAPB(o[1] = __builtin_amdgcn_mfma_f32_32x32x16_bf16(PAF(0), VFR(4), o[1], 0, 0, 0), C0, 4); \
    KRD(GL, 0); GAPB(o[0] = __builtin_amdgcn_mfma_f32_32x32x16_bf16(PAF(1), VFR(1), o[0], 0, 0, 0), C0, 8); \
    KRD(GL, 1); GAPB(o[1] = __builtin_amdgcn_mfma_f32_32x32x16_bf16(PAF(1), VFR(5), o[1], 0, 0, 0), C0, 12); \
    KRD(GL, 2); GAPB(o[0] = __builtin_amdgcn_mfma_f32_32x32x16_bf16(PAF(2), VFR(2), o[0], 0, 0, 0), C1, 0); \
    KRD(GL, 3); GAPB(o[1] = __builtin_amdgcn_mfma_f32_32x32x16_bf16(PAF(2), VFR(6), o[1], 0, 0, 0), C1, 4); \
    GAPB(o[0] = __builtin_amdgcn_mfma_f32_32x32x16_bf16(PAF(3), VFR(3), o[0], 0, 0, 0), C1, 8); \
    GAPB(o[1] = __builtin_amdgcn_mfma_f32_32x32x16_bf16(PAF(3), VFR(7), o[1], 0, 0, 0), C1, 12); \
    } while (0)
    int t = 1;
    for (; t + 5 < NT; t += 2) {
        STEP(pB0, pB1, pA0, pA1, t, true, true, true);     WAIT_BAR(2); RESC(); ROT();
        STEP(pA0, pA1, pB0, pB1, t + 1, true, true, true); WAIT_BAR(2); RESC(); ROT();
    }
#define ENDW(tt) do { if ((tt) + 3 < NT) { WAIT_BAR(2); } else if ((tt) + 2 < NT) { WAIT_BAR(1); } else { WAIT_BAR(0); } } while (0)
    for (; t + 1 < NT; t += 2) {
        STEP(pB0, pB1, pA0, pA1, t, (t + 3 < NT), (t + 1 < NT), (t + 1 < NT));         ENDW(t);     RESC(); ROT();
        STEP(pA0, pA1, pB0, pB1, t + 1, (t + 4 < NT), (t + 2 < NT), (t + 2 < NT));     ENDW(t + 1); RESC(); ROT();
    }
    STEP(pB0, pB1, pA0, pA1, NT - 1, false, false, false); RESC();
    { float sacc = pB0[0] + pB0[1]; _Pragma("unroll") for (int r = 2; r < 16; ++r) sacc += pB0[r]; _Pragma("unroll") for (int r = 0; r < 16; ++r) sacc += pB1[r]; l_reg += sacc;
      pw0 = (u32x4){PKW(pB0, 0), PKW(pB0, 2), PKW(pB0, 4), PKW(pB0, 6)}; pw1 = (u32x4){PKW(pB0, 8), PKW(pB0, 10), PKW(pB0, 12), PKW(pB0, 14)}; pw2 = (u32x4){PKW(pB1, 0), PKW(pB1, 2), PKW(pB1, 4), PKW(pB1, 6)}; pw3 = (u32x4){PKW(pB1, 8), PKW(pB1, 10), PKW(pB1, 12), PKW(pB1, 14)};
      SBAR(); pv(o, vb0 + sl_cur, PAF(0), PAF(1), PAF(2), PAF(3)); }
#undef PKW
#undef PAF
#undef VFR
#undef PIN
#undef MX3
#undef GAPA
#undef GAPB
#undef EX
#undef VRD
#undef KRD
#undef STEP
#undef ENDW
    { auto rr = __builtin_amdgcn_permlane32_swap(__float_as_uint(l_reg), __float_as_uint(l_reg), false, false); l_reg = __uint_as_float(rr[0]) + __uint_as_float(rr[1]); }
    if (hi == 0) wsf[32 + r32] = l_reg; asm volatile("s_waitcnt lgkmcnt(0)" ::: "memory");
    float rli[16];
#pragma unroll
    for (int r = 0; r < 16; ++r) rli[r] = __builtin_amdgcn_rcpf(wsf[32 + crow(r, hi)]);
    const long orow0 = rowbase + q0 + wid * QBLK;
    bf16* Ow = O + orow0 * OP + h * D;
    { bf16* stg = (bf16*)(shm + LDS_OST) + wid * 2048;
#pragma unroll
      for (int r = 0; r < 16; ++r) { const int orow = crow(r, hi);
#pragma unroll
          for (int d0 = 0; d0 < 2; ++d0) stg[orow * 64 + d0 * 32 + r32] = __float2bfloat16(o[d0][r] * rli[r]); }
      asm volatile("s_waitcnt lgkmcnt(0)" ::: "memory");
#pragma unroll
      for (int i = 0; i < 4; ++i) { const int row = i * 8 + (lane >> 3), ch = lane & 7; const u32x4 v = *(const u32x4*)(stg + row * 64 + ch * 8); mk::st16_wt<WT_EPI>(Ow + (long)row * OP + ch * 8, v);
          float ss = 0.f;
#pragma unroll
          for (int k = 0; k < 4; ++k) { const float lo = __uint_as_float(v[k] << 16), hi2 = __uint_as_float(v[k] & 0xffff0000u); ss += lo * lo + hi2 * hi2; }
          ss += __shfl_xor(ss, 1); ss += __shfl_xor(ss, 2); ss += __shfl_xor(ss, 4);
          if (ch == 0) SSQ[(orow0 + row) * 8 + h] = ss; } }
    asm volatile("s_waitcnt lgkmcnt(0)\n\ts_barrier" ::: "memory");
#undef DMA_K
#undef DMA_V
#undef START
#undef RESC
#undef ROT
}
#undef SBAR
#undef WAIT_BAR
}
namespace lru {
using namespace mk;
#define LLAS __attribute__((address_space(3)))
typedef short bf16x8 __attribute__((ext_vector_type(8)));
typedef float f32x16 __attribute__((ext_vector_type(16)));
typedef float f32x4 __attribute__((ext_vector_type(4)));
typedef float f32x2 __attribute__((ext_vector_type(2)));
typedef unsigned u32x4 __attribute__((ext_vector_type(4)));
constexpr int XPITCH = 144, HPITCH = 272;
constexpr int WAVE_BYTES = 64 * HPITCH;
constexpr int CW_OFF = 9728;
constexpr int PART_OFF = 8 * WAVE_BYTES;
constexpr int LDS_NEED = PART_OFF + 2048;
constexpr float LOG2E = 1.4426950408889634f, LN2 = 0.6931471805599453f;

struct Params { const bf16_t* LX; const bf16_t* LG; const float *cw, *cb, *ba, *bi, *lam, *gain; const bf16_t* WL; f32x2* SUMS; bf16_t* MIX; unsigned* AB; };

using mk::st16_wt;
__device__ __forceinline__ unsigned cvtpk(float lo, float hi) { unsigned r; asm volatile("v_cvt_pk_bf16_f32 %0, %1, %2" : "=v"(r) : "v"(lo), "v"(hi)); return r; }

__device__ __forceinline__ void build_xc(const Params& P, LLAS unsigned char* wl, int b, int c, int n, int lane, bf16x8 (&xcA)[2][4]) {
    const bf16_t* LXb = P.LX + (size_t)b * S * LW + 64 * n;
#pragma unroll
    for (int it = 0; it < 9; ++it) {
        const int rr = (lane >> 3) + 8 * it;
        if (rr < 67) { const int s = 64 * c - 2 + rr; u32x4 v = (u32x4){0u, 0u, 0u, 0u};
            if (s >= 0 && s < S) v = __builtin_nontemporal_load((const u32x4*)(LXb + (size_t)s * LW + 8 * (lane & 7)));
            *(LLAS u32x4*)(wl + rr * XPITCH + 16 * (lane & 7)) = v; }
    }
    LLAS float* cwl = (LLAS float*)(wl + CW_OFF);
#pragma unroll
    for (int j = 0; j < 4; ++j) cwl[j * 64 + lane] = P.cw[j * LW + 64 * n + lane];
    cwl[4 * 64 + lane] = P.cb[64 * n + lane];
    const int i = lane & 31, hi = lane >> 5;
#pragma unroll
    for (int ks = 0; ks < 4; ++ks) {
        const int cb0 = 16 * ks + 8 * hi;
        f32x4 w[5][2];
#pragma unroll
        for (int j = 0; j < 5; ++j) { w[j][0] = *(const LLAS f32x4*)(cwl + j * 64 + cb0); w[j][1] = *(const LLAS f32x4*)(cwl + j * 64 + cb0 + 4); }
#pragma unroll
        for (int mt = 0; mt < 2; ++mt) {
            f32x4 a0 = w[4][0], a1 = w[4][1];
#pragma unroll
            for (int j = 0; j < 4; ++j) {
                const u32x4 xv = *(const LLAS u32x4*)(wl + (32 * mt + i + j) * XPITCH + cb0 * 2);
                f32x4 x0, x1;
                x0[0] = __uint_as_float(xv[0] << 16); x0[1] = __uint_as_float(xv[0] & 0xffff0000u); x0[2] = __uint_as_float(xv[1] << 16); x0[3] = __uint_as_float(xv[1] & 0xffff0000u);
                x1[0] = __uint_as_float(xv[2] << 16); x1[1] = __uint_as_float(xv[2] & 0xffff0000u); x1[2] = __uint_as_float(xv[3] << 16); x1[3] = __uint_as_float(xv[3] & 0xffff0000u);
                a0 += x0 * w[j][0]; a1 += x1 * w[j][1];
            }
            u32x4 pk; pk[0] = cvtpk(a0[0], a0[1]); pk[1] = cvtpk(a0[2], a0[3]); pk[2] = cvtpk(a1[0], a1[1]); pk[3] = cvtpk(a1[2], a1[3]);
            xcA[mt][ks] = __builtin_bit_cast(bf16x8, pk);
        }
    }
}
__device__ __forceinline__ bf16x8 ident_frag(int ks, int nh, int r32, int hi) {
    const int jj = 32 * nh + r32 - 16 * ks - 8 * hi; bf16x8 f;
#pragma unroll
    for (int j = 0; j < 8; ++j) f[j] = (j == jj) ? (short)0x3F80 : (short)0;
    return f;
}
__device__ __forceinline__ void gate_ab(f32x16& ra, f32x16& ri, const f32x16& xc, float ba, float bi, float c1, unsigned* ab  ) {
    u32x4 pk4;
    const float nba = -ba * LOG2E, nbi = -bi * LOG2E;
#pragma unroll
    for (int r = 0; r < 16; ++r) {
        const float rg = __builtin_amdgcn_rcpf(1.0f + __builtin_amdgcn_exp2f(fmaf(ra[r], -LOG2E, nba)));
        const float ig = __builtin_amdgcn_rcpf(1.0f + __builtin_amdgcn_exp2f(fmaf(ri[r], -LOG2E, nbi)));
        const unsigned yb = cvtpk(0.0f, c1 * rg);
        const float a = __builtin_amdgcn_exp2f(__uint_as_float(yb));
        const float em = fmaf(-a, a, 1.0f);
        const unsigned bb = cvtpk(__builtin_amdgcn_sqrtf(em) * ig * xc[r], 0.0f);
        pk4[r & 3] = yb | bb; if ((r & 3) == 3) st16_wt(ab + (r >> 2) * 256, pk4);
        ra[r] = a; ri[r] = __uint_as_float(bb << 16);
    }
}
template <bool ST> __device__ __forceinline__ void scan_fwd(const f32x16& a, const f32x16& b, float& h, float& Aprod, LLAS unsigned char* hs  , int hi) {
    float Ag[4], Bg[4], pA[4], pB[4];
#pragma unroll
    for (int g = 0; g < 4; ++g) { float A = a[4 * g], B = b[4 * g];
#pragma unroll
        for (int e = 1; e < 4; ++e) { B = fmaf(a[4 * g + e], B, b[4 * g + e]); A *= a[4 * g + e]; }
        Ag[g] = A; Bg[g] = B; pA[g] = __shfl_xor(A, 32); pB[g] = __shfl_xor(B, 32); }
    float ap = 1.0f;
#pragma unroll
    for (int g = 0; g < 4; ++g) {
        const float A1 = hi ? pA[g] : Ag[g], B1 = hi ? pB[g] : Bg[g], A2 = hi ? Ag[g] : pA[g], B2 = hi ? Bg[g] : pB[g];
        const float h1 = fmaf(A1, h, B1); float x = hi ? h1 : h; h = fmaf(A2, h1, B2); ap *= A1 * A2;
        if constexpr (ST) {
#pragma unroll
            for (int e = 0; e < 4; ++e) { x = fmaf(a[4 * g + e], x, b[4 * g + e]); *(LLAS float*)(hs + (8 * g + 4 * hi + e) * HPITCH) = x; } }
    }
    Aprod = ap;
}
template <bool ST> __device__ __forceinline__ void scan_bwd(const f32x16& a, const f32x16& b, float& h, float& Aprod, LLAS unsigned char* hs, int hi) {
    float Ag[4], Bg[4], pA[4], pB[4];
#pragma unroll
    for (int g = 0; g < 4; ++g) { float A = a[4 * g + 3], B = b[4 * g + 3];
#pragma unroll
        for (int e = 2; e >= 0; --e) { B = fmaf(a[4 * g + e], B, b[4 * g + e]); A *= a[4 * g + e]; }
        Ag[g] = A; Bg[g] = B; pA[g] = __shfl_xor(A, 32); pB[g] = __shfl_xor(B, 32); }
    float ap = 1.0f;
#pragma unroll
    for (int g = 3; g >= 0; --g) {
        const float A1 = hi ? Ag[g] : pA[g], B1 = hi ? Bg[g] : pB[g], A2 = hi ? pA[g] : Ag[g], B2 = hi ? pB[g] : Bg[g];
        const float h1 = fmaf(A1, h, B1); float x = hi ? h : h1; h = fmaf(A2, h1, B2); ap *= A1 * A2;
        if constexpr (ST) {
#pragma unroll
            for (int e = 3; e >= 0; --e) { x = fmaf(a[4 * g + e], x, b[4 * g + e]); LLAS float* p = (LLAS float*)(hs + (8 * g + 4 * hi + e) * HPITCH); *p = *p + x; } }
    }
    Aprod = ap;
}
__device__ __forceinline__ void tile_ab(const bf16x8 (&xcA)[4], const bf16x8 (&Bf)[2][4], int nh, int r32, int hi, float ba, float bi, float c1, f32x16& a, f32x16& b, unsigned* ab) {
    f32x16 ra = f32x16{}, ri = f32x16{}, xc = f32x16{};
#pragma unroll
    for (int ks = 0; ks < 4; ++ks) { ra = __builtin_amdgcn_mfma_f32_32x32x16_bf16(xcA[ks], Bf[0][ks], ra, 0, 0, 0); ri = __builtin_amdgcn_mfma_f32_32x32x16_bf16(xcA[ks], Bf[1][ks], ri, 0, 0, 0); }
    if (nh == 0) { xc = __builtin_amdgcn_mfma_f32_32x32x16_bf16(xcA[0], ident_frag(0, 0, r32, hi), xc, 0, 0, 0); xc = __builtin_amdgcn_mfma_f32_32x32x16_bf16(xcA[1], ident_frag(1, 0, r32, hi), xc, 0, 0, 0); }
    else         { xc = __builtin_amdgcn_mfma_f32_32x32x16_bf16(xcA[2], ident_frag(2, 1, r32, hi), xc, 0, 0, 0); xc = __builtin_amdgcn_mfma_f32_32x32x16_bf16(xcA[3], ident_frag(3, 1, r32, hi), xc, 0, 0, 0); }
    gate_ab(ra, ri, xc, ba, bi, c1, ab);
    a = ra; b = ri;
}
__device__ __forceinline__ void load_bf(const Params& P, int n, int dir, int nh, int lane, bf16x8 (&Bf)[2][4]) {
#pragma unroll
    for (int q = 0; q < 2; ++q)
#pragma unroll
        for (int ks = 0; ks < 4; ++ks) Bf[q][ks] = *(const bf16x8*)(P.WL + ((((size_t)(n * 4 + dir * 2 + q) * 2 + nh) * 4 + ks) * 64 + lane) * 8);
}
__device__ __forceinline__ float softplus_neg(float lam) { const float L = -lam; return (L > 20.f) ? L : log1pf(expf(L)); }

__device__ __forceinline__ void lru_summaries(const Params& P, LLAS unsigned char* lds, int b, int c) {
    int tid_ = threadIdx.x; asm volatile("" : "+v"(tid_));
    const int tid = tid_, lane = tid & 63, r32 = lane & 31, hi = lane >> 5; const int n = __builtin_amdgcn_readfirstlane(tid >> 6);
    LLAS unsigned char* wl = lds + n * WAVE_BYTES;
    bf16x8 xcA[2][4];
    build_xc(P, wl, b, c, n, lane, xcA);
    bf16x8 Bf[2][4]; load_bf(P, n, 0, 0, lane, Bf);
#pragma unroll 1
    for (int it = 0; it < 4; ++it) {
        const int nh = it >> 1, dir = it & 1; const int ch = 64 * n + 32 * nh + r32;
        const float ba = P.ba[dir * LW + ch], bi = P.bi[dir * LW + ch], c1 = -8.0f * LOG2E * softplus_neg(P.lam[dir * LW + ch]);
        unsigned* abp = P.AB + ((((size_t)(b * NCH + c) * 8 + n) * 2 + nh) * 2 + dir) * 2048 + 4 * lane;
        f32x16 a0, b0, a1, b1;
        tile_ab(xcA[0], Bf, nh, r32, hi, ba, bi, c1, a0, b0, abp);
        tile_ab(xcA[1], Bf, nh, r32, hi, ba, bi, c1, a1, b1, abp + 1024);
        if (it < 3) load_bf(P, n, (it + 1) & 1, (it + 1) >> 1, lane, Bf);
        float A0, B0 = 0.f, A1, B1 = 0.f;
        if (dir == 0) { scan_fwd<false>(a0, b0, B0, A0, wl, hi); scan_fwd<false>(a1, b1, B1, A1, wl, hi); }
        else          { scan_bwd<false>(a0, b0, B0, A0, wl, hi); scan_bwd<false>(a1, b1, B1, A1, wl, hi); }
        const float Ac = A0 * A1, Bc = (dir == 0) ? fmaf(A1, B0, B1) : fmaf(A0, B1, B0);
        if (hi == 0) P.SUMS[((size_t)(b * 2 + dir) * NCH + c) * LW + ch] = (f32x2){Ac, Bc};
    }
}
constexpr int CARRY_OFF = 142336;
__device__ __forceinline__ void carries_to_lds(const f32x2* SUMS, LLAS unsigned char* lds, int b, int c, int tid) {
    const f32x2* sf = SUMS + (size_t)(b * 2 + 0) * NCH * LW + tid; const f32x2* sb = SUMS + (size_t)(b * 2 + 1) * NCH * LW + tid;
    float hf = 0.f, hb = 0.f;
    for (int c0 = 0; c0 < c; c0 += 16) { f32x2 v[16];
#pragma unroll
        for (int u = 0; u < 16; ++u) { const int cc = c0 + u; v[u] = sf[(size_t)(cc < c ? cc : c - 1) * LW]; if (cc >= c) v[u] = (f32x2){1.0f, 0.0f}; }
#pragma unroll
        for (int u = 0; u < 16; ++u) hf = fmaf(v[u][0], hf, v[u][1]); }
    for (int c0 = NCH - 1; c0 > c; c0 -= 16) { f32x2 v[16];
#pragma unroll
        for (int u = 0; u < 16; ++u) { const int cc = c0 - u; v[u] = sb[(size_t)(cc > c ? cc : c + 1) * LW]; if (cc <= c) v[u] = (f32x2){1.0f, 0.0f}; }
#pragma unroll
        for (int u = 0; u < 16; ++u) hb = fmaf(v[u][0], hb, v[u][1]); }
    LLAS float* cr = (LLAS float*)(lds + CARRY_OFF);
    cr[tid] = hf; cr[LW + tid] = hb;
}
__device__ __forceinline__ float gelu_tanh(float x) {
    const float u = 0.7978845608028654f * (x + 0.044715f * x * x * x);
    return x * __builtin_amdgcn_rcpf(1.0f + __builtin_amdgcn_exp2f(-2.0f * LOG2E * u));
}
__device__ __forceinline__ void lru_apply(const Params& P, LLAS unsigned char* lds, int b, int c) {
    int tid_ = threadIdx.x; asm volatile("" : "+v"(tid_));
    const int tid = tid_, lane = tid & 63, r32 = lane & 31, hi = lane >> 5; const int n = __builtin_amdgcn_readfirstlane(tid >> 6);
    LLAS unsigned char* wl = lds + n * WAVE_BYTES;
    u32x4 qa[4][4], qb[4][4];
    { const unsigned* abp = P.AB + ((size_t)(b * NCH + c) * 8 + n) * 8192 + 4 * lane;
#pragma unroll
      for (int dt = 0; dt < 4; ++dt)
#pragma unroll
          for (int g = 0; g < 4; ++g) { qa[dt][g] = __builtin_nontemporal_load((const u32x4*)(abp + dt * 1024 + g * 256)); qb[dt][g] = __builtin_nontemporal_load((const u32x4*)(abp + 4096 + dt * 1024 + g * 256)); } }
    carries_to_lds(P.SUMS, lds, b, c, tid);
    __syncthreads();
#pragma unroll
    for (int nh = 0; nh < 2; ++nh) {
        const int ch = 64 * n + 32 * nh + r32;
        LLAS unsigned char* hc0 = wl + (32 * nh + r32) * 4; LLAS unsigned char* hc1 = hc0 + 32 * HPITCH;
        f32x16 a, bb; float Ad;
#define LRU_UNPACK(dt) do { _Pragma("unroll") for (int g = 0; g < 4; ++g) { const u32x4 v = nh ? qb[dt][g] : qa[dt][g]; _Pragma("unroll") for (int e = 0; e < 4; ++e) { \
            a[4 * g + e] = __builtin_amdgcn_exp2f(__uint_as_float(v[e] & 0xffff0000u)); bb[4 * g + e] = __uint_as_float(v[e] << 16); } } } while (0)
        {
            float h = *(const LLAS float*)(lds + CARRY_OFF + ch * 4);
            LRU_UNPACK(0); scan_fwd<true>(a, bb, h, Ad, hc0, hi);
            LRU_UNPACK(1); scan_fwd<true>(a, bb, h, Ad, hc1, hi);
        }
        {
            float h = *(const LLAS float*)(lds + CARRY_OFF + (LW + ch) * 4);
            LRU_UNPACK(3); scan_bwd<true>(a, bb, h, Ad, hc1, hi);
            LRU_UNPACK(2); scan_bwd<true>(a, bb, h, Ad, hc0, hi);
        }
#undef LRU_UNPACK
    }
    const int ch8 = 8 * (lane & 7);
    const size_t t0 = (size_t)b * S + (size_t)c * 64;
    float v[8][8];
    LLAS float* part = (LLAS float*)(lds + PART_OFF);
#pragma unroll
    for (int it = 0; it < 8; ++it) {
        const int row = (lane >> 3) + 8 * it;
        const f32x4 h0 = *(const LLAS f32x4*)(wl + row * HPITCH + ch8 * 4), h1 = *(const LLAS f32x4*)(wl + row * HPITCH + ch8 * 4 + 16);
        const u32x4 gv = __builtin_nontemporal_load((const u32x4*)(P.LG + (t0 + row) * LW + 64 * n + ch8));
        float ss = 0.f;
#pragma unroll
        for (int q = 0; q < 4; ++q) {
            const float g0 = __uint_as_float(gv[q] << 16), g1 = __uint_as_float(gv[q] & 0xffff0000u);
            const float hA = (q < 2) ? h0[2 * q] : h1[2 * q - 4], hB = (q < 2) ? h0[2 * q + 1] : h1[2 * q - 3];
            v[it][2 * q] = hA * gelu_tanh(g0); v[it][2 * q + 1] = hB * gelu_tanh(g1);
            ss += v[it][2 * q] * v[it][2 * q] + v[it][2 * q + 1] * v[it][2 * q + 1];
        }
        ss += __shfl_xor(ss, 1); ss += __shfl_xor(ss, 2); ss += __shfl_xor(ss, 4);
        if ((lane & 7) == 0) part[n * 64 + row] = ss;
    }
    __syncthreads();
    f32x4 g0 = *(const f32x4*)(P.gain + 64 * n + ch8), g1 = *(const f32x4*)(P.gain + 64 * n + ch8 + 4);
#pragma unroll
    for (int it = 0; it < 8; ++it) {
        const int row = (lane >> 3) + 8 * it;
        float tot = 0.f;
#pragma unroll
        for (int w = 0; w < 8; ++w) tot += part[w * 64 + row];
        const float rs = 1.0f / sqrtf(tot * (1.0f / 512.0f) + 1e-5f);
        u32x4 o; o[0] = cvtpk(v[it][0] * rs * g0[0], v[it][1] * rs * g0[1]); o[1] = cvtpk(v[it][2] * rs * g0[2], v[it][3] * rs * g0[3]);
        o[2] = cvtpk(v[it][4] * rs * g1[0], v[it][5] * rs * g1[1]); o[3] = cvtpk(v[it][6] * rs * g1[2], v[it][7] * rs * g1[3]);
        st16_wt<WT_EPI>(P.MIX + (t0 + row) * 1024 + 512 + 64 * n + ch8, o);
    }
    __syncthreads();
}
#undef LLAS
}
namespace mkf {
using namespace mk;
#define GAS __attribute__((address_space(1)))
#define LAS __attribute__((address_space(3)))
typedef unsigned v4u __attribute__((ext_vector_type(4)));
typedef float f32x4 __attribute__((ext_vector_type(4)));
typedef float f32x16 __attribute__((ext_vector_type(16)));
typedef short bf16x8 __attribute__((ext_vector_type(8)));
typedef GAS unsigned gu32;
#define RLX_AGENT __ATOMIC_RELAXED, __HIP_MEMORY_SCOPE_AGENT
#define LDS_WAIT() asm volatile("s_waitcnt lgkmcnt(0)" ::: "memory")
constexpr int NWAVES = 8;
constexpr int RING_OFF = 0, RING_BYTES = 131072;
constexpr int LDSCTL_OFF = 141312, MISC_OFF = LDSCTL_OFF;
constexpr int LDS_BYTES = 147456;
static_assert(lru::LDS_NEED <= LDSCTL_OFF && attn_body::LDS_BYTES <= RING_BYTES && pg8::STAGE_BYTES + 8192 <= LDSCTL_OFF && MISC_OFF + 512 <= lru::CARRY_OFF && lru::CARRY_OFF + 4096 <= LDS_BYTES, "LDS map");

#define XB_TMO      128
#define XB_XCNT(j)  (256  + 64 * (j))
#define XB_XSUB(j)  (1280 + 64 * (j))
#define XB_XGEN(j)  (2304 + 64 * (j))
#define XB_TOP      3328
#define XB_TOPGEN   3392
#define XCD_BAR_WORDS 3456
#define XB_SPIN_CAP (1u << 18)
__device__ __forceinline__ unsigned xb_ld(unsigned* p)              { return __hip_atomic_load(p, __ATOMIC_RELAXED, __HIP_MEMORY_SCOPE_AGENT); }
__device__ __forceinline__ unsigned xb_add(unsigned* p, unsigned v) { return __hip_atomic_fetch_add(p, v, __ATOMIC_RELAXED, __HIP_MEMORY_SCOPE_AGENT); }
__device__ __forceinline__ unsigned xb_xcc_id() { return (unsigned)__builtin_amdgcn_s_getreg((3 << 11) | 20) & 0xFu; }
#define XB_SPIN(cond, bar) do { unsigned _sp = 0; while (cond) { __builtin_amdgcn_s_sleep(1); \
    if ((++_sp & 255u) == 0u) { if (xb_ld(&(bar)[XB_TMO])) break; if (_sp > XB_SPIN_CAP) { atomicAdd(&(bar)[XB_TMO], 1u); break; } } } } while (0)
struct XcdBarrier { unsigned* bar; unsigned x; volatile LAS unsigned* st; };
__device__ __forceinline__ XcdBarrier xcd_barrier_post(unsigned* bar, volatile LAS unsigned* st) {
    XcdBarrier b; b.bar = bar; b.x = xb_xcc_id(); b.st = st;
    if (threadIdx.x == 0) (void)xb_add(&bar[XB_XCNT(b.x)], 1u);
    return b;
}
__device__ __forceinline__ void xcd_barrier_complete(unsigned* bar, unsigned x, unsigned& nloc, unsigned& nx) {
    const unsigned G = gridDim.x * gridDim.y * gridDim.z;
    unsigned sum, cnt, mine, sp = 0u;
    for (;;) {
        sum = 0u; cnt = 0u; mine = 0u;
#pragma unroll
        for (unsigned j = 0; j < 16; ++j) { const unsigned c = xb_ld(&bar[XB_XCNT(j)]); sum += c; cnt += (c > 0u) ? 1u : 0u; mine = (j == x) ? c : mine; }
        if (sum == G) break;
        __builtin_amdgcn_s_sleep(1);
        if ((++sp & 255u) == 0u) { if (xb_ld(&bar[XB_TMO])) break; if (sp > XB_SPIN_CAP) { atomicAdd(&bar[XB_TMO], 1u); break; } }
    }
    nloc = mine > 0u ? mine : 1u; nx = cnt > 0u ? cnt : 1u;
}
__device__ __forceinline__ void xcd_barrier(const XcdBarrier& b) {
    asm volatile("s_waitcnt vmcnt(0)" ::: "memory");
    __syncthreads();
    if (threadIdx.x == 0) {
        unsigned* bar = b.bar;
        __builtin_amdgcn_s_waitcnt(0);
        unsigned nloc = b.st[0], nx = b.st[1];
        if (nloc == 0u) { xcd_barrier_complete(bar, b.x, nloc, nx); b.st[0] = nloc; b.st[1] = nx; }
        const unsigned old = xb_add(&bar[XB_XSUB(b.x)], 1u);
        const unsigned gen = old / nloc;
        if (old + 1u == (gen + 1u) * nloc) {
            __builtin_amdgcn_fence(__ATOMIC_RELEASE, "agent");
            asm volatile("s_waitcnt vmcnt(0)" ::: "memory");
            const unsigned og = xb_add(&bar[XB_TOP], 1u);
            const unsigned tg = og / nx;
            if (og + 1u == (tg + 1u) * nx) xb_add(&bar[XB_TOPGEN], 1u);
            else XB_SPIN(xb_ld(&bar[XB_TOPGEN]) == tg, bar);
            __builtin_amdgcn_fence(__ATOMIC_ACQUIRE, "agent");
            xb_add(&bar[XB_XGEN(b.x)], 1u);
            asm volatile("s_waitcnt vmcnt(0)" ::: "memory");
        } else {
            XB_SPIN(xb_ld(&bar[XB_XGEN(b.x)]) == gen, bar);
            __builtin_amdgcn_fence(__ATOMIC_ACQUIRE, "agent");
            asm volatile("s_waitcnt vmcnt(0)" ::: "memory");
        }
    }
    __syncthreads();
}

struct Args { const float* in[25]; float* out; unsigned char* ws; int ph_lo, ph_hi, flags, li; };
enum { FL_LRU = 1, FL_ATTN = 2 };

__device__ __forceinline__ float wave_sum(float v) {
#pragma unroll
    for (int o = 1; o < 64; o <<= 1) v += __shfl_xor(v, o);
    return v;
}
template <class DST> __device__ __forceinline__ void transpose_item(const float* W, int ldn, const float* gk, bf16_t* WT, const DST& dst, LAS float* scr, int k0, int n0, int lane) {
    f32x4 v[8];
#pragma unroll
    for (int i = 0; i < 8; ++i) v[i] = *(const GAS f32x4*)(W + (size_t)(k0 + 8 * i + (lane >> 3)) * ldn + n0 + 4 * (lane & 7));
#pragma unroll
    for (int i = 0; i < 8; ++i) { const int kk = 8 * i + (lane >> 3); if (gk) v[i] *= gk[k0 + kk]; LAS float* d = scr + kk * 33 + 4 * (lane & 7); d[0] = v[i].x; d[1] = v[i].y; d[2] = v[i].z; d[3] = v[i].w; }
    LDS_WAIT(); asm volatile("" ::: "memory");
    const int c = lane & 7;
#pragma unroll
    for (int j = 0; j < 4; ++j) { const int n = (lane >> 3) + 8 * j; const LAS float* s = scr + (8 * c) * 33 + n;
        v4u o; o.x = pk2(s[0 * 33], s[1 * 33]); o.y = pk2(s[2 * 33], s[3 * 33]); o.z = pk2(s[4 * 33], s[5 * 33]); o.w = pk2(s[6 * 33], s[7 * 33]);
        st16_wt<WT_P0>(WT + (size_t)dst(n0 + n) * D + k0 + 8 * c, o); }
    LDS_WAIT(); asm volatile("" ::: "memory");
}
struct ItemSrc { const float* W; const float* gk; unsigned char* WT; int rowbase, half, kind, k0, n0; };
__device__ __forceinline__ void f8_item_load(const ItemSrc& s, int lane, f32x4 (&v)[8]) {
#pragma unroll
    for (int i = 0; i < 8; ++i) v[i] = __builtin_nontemporal_load((const GAS f32x4*)(s.W + (size_t)(s.k0 + 8 * i + (lane >> 3)) * D + s.n0 + 4 * (lane & 7)));
}
__device__ __forceinline__ void f8_item_store(const ItemSrc& s, int lane, f32x4 (&v)[8], LAS float* scr) {
#pragma unroll
    for (int i = 0; i < 8; ++i) { const int kk = 8 * i + (lane >> 3); float m = 32.0f; if (s.gk) m *= s.gk[s.k0 + kk]; v[i] *= m; LAS float* d = scr + kk * 33 + 4 * (lane & 7); d[0] = v[i].x; d[1] = v[i].y; d[2] = v[i].z; d[3] = v[i].w; }
    LDS_WAIT(); asm volatile("" ::: "memory");
    const int c = lane & 3;
#pragma unroll
    for (int j = 0; j < 2; ++j) { const int n = (lane >> 2) + 16 * j; const LAS float* p = scr + (16 * c) * 33 + n; int o[4];
#pragma unroll
        for (int q = 0; q < 4; ++q) { int w = 0; w = __builtin_amdgcn_cvt_pk_fp8_f32(p[(4 * q) * 33], p[(4 * q + 1) * 33], w, false); w = __builtin_amdgcn_cvt_pk_fp8_f32(p[(4 * q + 2) * 33], p[(4 * q + 3) * 33], w, true); o[q] = w; }
        const int col = s.n0 + n; const int row = s.rowbase + (s.kind == 0 ? gu_dst(col, s.half) : down_dst(col));
        st16_wt<WT_P0>(s.WT + (size_t)row * 1024 + s.k0 + 16 * c, (v4u){(unsigned)o[0], (unsigned)o[1], (unsigned)o[2], (unsigned)o[3]}); }
    LDS_WAIT(); asm volatile("" ::: "memory");
}
struct DstWin { __device__ int operator()(int c) const { return win_dst(c); } };
struct DstNat { __device__ int operator()(int c) const { return c; } };
struct DstPerm { __device__ int operator()(int c) const { return perm256_dst(c); } };
struct DstGU { int base, half; __device__ int operator()(int c) const { return base + gu_dst(c, half); } };
struct DstDown { int base; __device__ int operator()(int c) const { return base + perm256_dst(c); } };

constexpr int EXP_ITEMS = NE * 3 * 16 * 32;
constexpr int EXP_STEAL = 4096;
constexpr int EXP_N1 = EXP_ITEMS - EXP_STEAL;
constexpr int EXP_N0 = EXP_N1 - 64 * 8 * 8;
__device__ __forceinline__ void convert_expert_items(const Args& a, LAS float* scr, int lane, int first, int stride, int lo, int hi) {
    unsigned char* ws = a.ws; const float* n2g = a.in[15]; constexpr int I_E = 16 * 32;
    auto mkitem = [&](int r) { ItemSrc s; int e, q, ii;
        if (r < NE * 2 * I_E) { e = r / (2 * I_E); q = (r / I_E) & 1; ii = r % I_E; } else { const int rd = r - NE * 2 * I_E; e = rd / I_E; q = 2; ii = rd % I_E; }
        s.k0 = 64 * (ii / 32); s.n0 = 32 * (ii % 32); s.half = q & 1; s.kind = (q == 2);
        s.W = a.in[q == 0 ? 18 : (q == 1 ? 20 : 22)] + (size_t)e * D * D; s.gk = (q == 2) ? (const float*)nullptr : n2g; s.WT = ws + (q == 2 ? WS_BT2 : WS_BT1); s.rowbase = (q == 2) ? e * 1024 : e * 2048; return s; };
    int r = lo + first; f32x4 va[8], vb[8]; ItemSrc sa, sb;
    if (r < hi) { sa = mkitem(r); f8_item_load(sa, lane, va); }
    while (r < hi) {
        const int r1 = r + stride; if (r1 < hi) { sb = mkitem(r1); f8_item_load(sb, lane, vb); }
        f8_item_store(sa, lane, va, scr);
        if (r1 >= hi) break;
        const int r2 = r1 + stride; if (r2 < hi) { sa = mkitem(r2); f8_item_load(sa, lane, va); }
        f8_item_store(sb, lane, vb, scr);
        r = r2;
    }
}
__device__ __forceinline__ void p0_prologue(const Args& a, LAS unsigned char* lds, int vcu, int G, int wave, int lane) {
    unsigned char* ws = a.ws;
    LAS float* scr = (LAS float*)(lds + RING_OFF + wave * 16384);
    const int gw = vcu * NWAVES + wave, NGW = G * NWAVES;
    constexpr int I_IN = 16 * 56, I_OUT = 16 * 32, I_E = 16 * 32;
    const float* w_in = a.in[2]; const float* w_out = a.in[14]; const float* aog = a.in[12]; const float* n2g = a.in[15];
    for (int r = gw; r < I_IN + I_OUT; r += NGW) {
        if (r < I_IN) transpose_item(w_in, INW, (const float*)nullptr, (bf16_t*)(ws + WS_WIN), DstWin{}, scr, 64 * (r / 56), 32 * (r % 56), lane);
        else { const int q = r - I_IN, k0 = 64 * (q / 32);
            transpose_item(w_out, D, k0 < 512 ? aog : (const float*)nullptr, (bf16_t*)(ws + WS_WOUT), DstPerm{}, scr, k0, 32 * (q % 32), lane); }
    }
    convert_expert_items(a, scr, lane, gw, NGW, 0, G == 256 ? EXP_N0 : EXP_N1);
    const float* x = a.in[0]; const float* n1g = a.in[1]; bf16_t* XN = (bf16_t*)(ws + WS_XN);
    f32x4 gv[4];
#pragma unroll
    for (int j = 0; j < 4; ++j) gv[j] = *(const f32x4*)(n1g + 4 * lane + 256 * j);
    for (int m0 = 2 * gw; m0 < T; m0 += 2 * NGW) {
        f32x4 v[2][4]; float s[2] = {0.f, 0.f};
#pragma unroll
        for (int r = 0; r < 2; ++r) { const GAS f32x4* xr = (const GAS f32x4*)(x + (size_t)(m0 + r) * D) + lane;
#pragma unroll
            for (int j = 0; j < 4; ++j) v[r][j] = __builtin_nontemporal_load(xr + 64 * j); }
#pragma unroll
        for (int r = 0; r < 2; ++r) {
#pragma unroll
            for (int j = 0; j < 4; ++j) s[r] += (v[r][j].x * v[r][j].x + v[r][j].y * v[r][j].y) + (v[r][j].z * v[r][j].z + v[r][j].w * v[r][j].w);
            const float rs = 1.0f / sqrtf(wave_sum(s[r]) * (1.0f / D) + 1e-5f);
            GAS unsigned long long* o8 = (GAS unsigned long long*)(XN + (size_t)(m0 + r) * D) + lane;
#pragma unroll
            for (int j = 0; j < 4; ++j) o8[64 * j] = (unsigned long long)pk2(v[r][j].x * rs * gv[j].x, v[r][j].y * rs * gv[j].y) | ((unsigned long long)pk2(v[r][j].z * rs * gv[j].z, v[r][j].w * rs * gv[j].w) << 32);
        }
    }
    const int gt = vcu * (NWAVES * 64) + wave * 64 + lane, NGT = G * NWAVES * 64;
    for (int idx = gt; idx < 8 * 4 * 2 * 4 * 64 * 8; idx += NGT) {
        if (idx < 2048) nv::tbl_rope(idx, (float*)(ws + WS_ROPE));
        nv::tbl_wl(idx, a.in[7], a.in[9], (bf16_t*)(ws + WS_WL));
        if (idx < 64 * 64 * 8) nv::tbl_rtr(idx, a.in[16], n2g, (bf16_t*)(ws + WS_RTR));
    }
}
__device__ __forceinline__ void p5_route(const Args& a, LAS unsigned char* lds, int G) {
    unsigned char* ws = a.ws;
    const float* X1 = (const float*)(ws + WS_X1); const bf16_t* RT = (const bf16_t*)(ws + WS_RTR); const float* br = a.in[17];
    float* listr = (float*)(ws + WS_LISTR); float* listg = (float*)(ws + WS_LISTG); int* list = (int*)(ws + WS_LIST); unsigned* cnt = (unsigned*)(ws + WS_CTL) + CW_CNT;
    LAS float* PD = (LAS float*)(lds); LAS float* PS = (LAS float*)(lds + 33792); LAS unsigned* CL = (LAS unsigned*)(lds + 34816); LAS unsigned* BASE = (LAS unsigned*)(lds + 34944);
    int tid_ = threadIdx.x; asm volatile("" : "+v"(tid_));
    const int tid = tid_, lane = tid & 63, i = lane & 31, hi = lane >> 5; const int wid = __builtin_amdgcn_readfirstlane(tid >> 6), tile = wid >> 2, q = wid & 3;
    for (int grp = blockIdx.x; grp < T / 64; grp += G) {
        if (tid < 32) CL[tid] = 0u;
        const int tok0 = grp * 64 + tile * 32;
        f32x16 acc = f32x16{}; float ss = 0.f;
        const float* xp = X1 + (size_t)(tok0 + i) * D + q * 256 + hi * 8;
#pragma unroll 4
        for (int ks = 0; ks < 16; ++ks) {
            const f32x4 x0 = *(const f32x4*)(xp + ks * 16), x1 = *(const f32x4*)(xp + ks * 16 + 4);
            ss += (x0[0] * x0[0] + x0[1] * x0[1]) + (x0[2] * x0[2] + x0[3] * x0[3]) + (x1[0] * x1[0] + x1[1] * x1[1]) + (x1[2] * x1[2] + x1[3] * x1[3]);
            unsigned hh[4], ll[4];
#pragma unroll
            for (int p = 0; p < 2; ++p) { const float e0 = x0[2 * p], e1 = x0[2 * p + 1]; const unsigned h0 = f2bf(e0), h1 = f2bf(e1); hh[p] = h0 | (h1 << 16); ll[p] = pk2(e0 - bf2f(h0), e1 - bf2f(h1)); }
#pragma unroll
            for (int p = 0; p < 2; ++p) { const float e0 = x1[2 * p], e1 = x1[2 * p + 1]; const unsigned h0 = f2bf(e0), h1 = f2bf(e1); hh[2 + p] = h0 | (h1 << 16); ll[2 + p] = pk2(e0 - bf2f(h0), e1 - bf2f(h1)); }
            const bf16x8 ah = __builtin_bit_cast(bf16x8, (v4u){hh[0], hh[1], hh[2], hh[3]}), al = __builtin_bit_cast(bf16x8, (v4u){ll[0], ll[1], ll[2], ll[3]});
            const int ksg = q * 16 + ks;
            const bf16x8 bh = *(const bf16x8*)(RT + ((size_t)ksg * 64 + lane) * 8), bl = *(const bf16x8*)(RT + 32768 + ((size_t)ksg * 64 + lane) * 8);
            acc = __builtin_amdgcn_mfma_f32_32x32x16_bf16(ah, bh, acc, 0, 0, 0);
            acc = __builtin_amdgcn_mfma_f32_32x32x16_bf16(ah, bl, acc, 0, 0, 0);
            acc = __builtin_amdgcn_mfma_f32_32x32x16_bf16(al, bh, acc, 0, 0, 0);
        }
#pragma unroll
        for (int r = 0; r < 16; ++r) PD[((tile * 4 + q) * 32 + ((r & 3) + 8 * (r >> 2) + 4 * hi)) * 33 + i] = acc[r];
        ss += __shfl_xor(ss, 32);
        if (hi == 0) PS[(tile * 4 + q) * 32 + i] = ss;
        __syncthreads();
        int se[4]; unsigned sp[4]; float sg[4]; float rs_tok = 0.f; const bool sel = (q == 0 && hi == 0); const int tok = tok0 + i;
        if (sel) {
            float lg[32];
            const float sq = (PS[(tile * 4 + 0) * 32 + i] + PS[(tile * 4 + 1) * 32 + i]) + (PS[(tile * 4 + 2) * 32 + i] + PS[(tile * 4 + 3) * 32 + i]);
            const float rs = 1.0f / sqrtf(sq * (1.0f / D) + 1e-5f);
#pragma unroll
            for (int e = 0; e < 32; ++e) { const float v = (PD[((tile * 4 + 0) * 32 + i) * 33 + e] + PD[((tile * 4 + 1) * 32 + i) * 33 + e]) + (PD[((tile * 4 + 2) * 32 + i) * 33 + e] + PD[((tile * 4 + 3) * 32 + i) * 33 + e]); lg[e] = v * rs + br[e]; }
            unsigned taken = 0u; float tv[4];
#pragma unroll
            for (int k = 0; k < 4; ++k) { float best = -INFINITY; int bi = 0;
#pragma unroll
                for (int e = 0; e < 32; ++e) { const bool c = (lg[e] > best) && !((taken >> e) & 1u); best = c ? lg[e] : best; bi = c ? e : bi; }
                taken |= 1u << bi; se[k] = bi; tv[k] = best; }
            float sum = 0.f;
#pragma unroll
            for (int k = 0; k < 4; ++k) { sg[k] = __expf(tv[k] - tv[0]); sum += sg[k]; }
            const float inv = 1.0f / sum;
#pragma unroll
            for (int k = 0; k < 4; ++k) { sg[k] *= inv; sp[k] = __hip_atomic_fetch_add(&CL[se[k]], 1u, __ATOMIC_RELAXED, __HIP_MEMORY_SCOPE_WORKGROUP); }
            rs_tok = rs;
        }
        __syncthreads();
        if (tid < 32) BASE[tid] = __hip_atomic_fetch_add(cnt + tid * CNT_STRIDE, CL[tid], RLX_AGENT);
        __syncthreads();
        if (sel) {
#pragma unroll
            for (int k = 0; k < 4; ++k) { const size_t pos = (size_t)se[k] * T + BASE[se[k]] + sp[k]; list[pos] = tok * 4 + k; listr[pos] = rs_tok; listg[pos] = sg[k]; }
        }
        __syncthreads();
    }
}
__device__ __forceinline__ void p8_final(const Args& a, int vcu, int G, int wave, int lane) {
    const float* X1 = (const float*)(a.ws + WS_X1); const unsigned char* Y = a.ws + WS_Y; const float* fg = a.in[24];
    const int gw = vcu * NWAVES + wave, NGW = G * NWAVES;
    f32x4 gv[4];
#pragma unroll
    for (int j = 0; j < 4; ++j) gv[j] = *(const f32x4*)(fg + 4 * lane + 256 * j);
    for (int m0 = 2 * gw; m0 < T; m0 += 2 * NGW) {
        f32x4 v[2][4]; unsigned yq[2][4][4];
#pragma unroll
        for (int r = 0; r < 2; ++r)
#pragma unroll
            for (int j = 0; j < 4; ++j) { v[r][j] = __builtin_nontemporal_load((const GAS f32x4*)(X1 + (size_t)(m0 + r) * D) + lane + 64 * j);
#pragma unroll
                for (int k = 0; k < 4; ++k) yq[r][j][k] = __builtin_nontemporal_load((const GAS unsigned*)(Y + ((size_t)(m0 + r) * 4 + k) * D) + lane + 64 * j); }
#pragma unroll
        for (int r = 0; r < 2; ++r) { float s = 0.f;
#pragma unroll
            for (int j = 0; j < 4; ++j) { f32x4 ys = (f32x4){0.f, 0.f, 0.f, 0.f};
#pragma unroll
                for (int k = 0; k < 4; ++k) { const auto lo = __builtin_amdgcn_cvt_pk_f32_fp8((int)yq[r][j][k], false), hi = __builtin_amdgcn_cvt_pk_f32_fp8((int)yq[r][j][k], true); ys.x += lo[0]; ys.y += lo[1]; ys.z += hi[0]; ys.w += hi[1]; }
                v[r][j] += ys * 0.0625f;
                s += (v[r][j].x * v[r][j].x + v[r][j].y * v[r][j].y) + (v[r][j].z * v[r][j].z + v[r][j].w * v[r][j].w); }
            const float rs = 1.0f / sqrtf(wave_sum(s) * (1.0f / D) + 1e-5f);
#pragma unroll
            for (int j = 0; j < 4; ++j) __builtin_nontemporal_store(v[r][j] * gv[j] * rs, (GAS f32x4*)(a.out + (size_t)(m0 + r) * D) + lane + 64 * j); }
    }
}

__global__ void __launch_bounds__(NWAVES * 64, 2) mk_fwd(Args args) {
    extern __shared__ __attribute__((aligned(16))) unsigned char lds_raw[];
    LAS unsigned char* lds = (LAS unsigned char*)lds_raw;
    volatile LAS unsigned* MISC = (volatile LAS unsigned*)(lds + MISC_OFF);
    const int tid = threadIdx.x, lane = tid & 63, wave = __builtin_amdgcn_readfirstlane(tid >> 6);
    const int G = gridDim.x; const int bx = blockIdx.x; const int vcu = (G % 8 == 0) ? (bx % 8) * (G / 8) + bx / 8 : bx;
    unsigned char* ws = args.ws;
    gu32* ctl = (gu32*)(ws + WS_CTL);
    for (int u = tid; u < 128; u += NWAVES * 64) MISC[u] = 0u;
    __syncthreads();
    XcdBarrier bar = xcd_barrier_post((unsigned*)ctl + CW_BAR + args.li * XCD_BAR_WORDS, MISC);
    const int lo = args.ph_lo, hi = args.ph_hi;
#define IN(k) (lo <= (k) && (k) < hi)
#define SEAM(k) do { if (IN(k) && IN((k) + 1)) xcd_barrier(bar); } while (0)

    if (IN(0)) { p0_prologue(args, lds, vcu, G, wave, lane); SEAM(0); }

    if (IN(1)) {
        pg8::StaticSched Sc; Sc.init(ws + WS_WIN, T, INW, G, bx);
        pg8::EpiInProj E{(bf16_t*)(ws + WS_Q), (bf16_t*)(ws + WS_K), (bf16_t*)(ws + WS_V), (bf16_t*)(ws + WS_LX), (bf16_t*)(ws + WS_LG), args.in[3], args.in[4], (const float*)(ws + WS_ROPE)};
        pg8::gemm_phase<pg8::EpiInProj, pg8::StaticSched>(lds + RING_OFF, (const char*)(ws + WS_XN), Sc, E);
        { pg8::GUnit u2; const int nidle = 2 * G - 448;
          if (G == 256 && !Sc.next(1, u2)) { int j = 0, my = -1; for (int c2 = 0; c2 < G; ++c2) { pg8::StaticSched S2 = Sc; S2.c = c2; pg8::GUnit t2; if (!S2.next(1, t2)) { if (c2 == bx) my = j; ++j; } }
              (void)nidle; if (my >= 0) convert_expert_items(args, (LAS float*)(lds + RING_OFF + wave * 16384), lane, my * NWAVES + wave, j * NWAVES, EXP_N0, EXP_N1); } }
        SEAM(1);
    }
    const lru::Params LP{(const bf16_t*)(ws + WS_LX), (const bf16_t*)(ws + WS_LG), args.in[5], args.in[6], args.in[8], args.in[10], args.in[11], args.in[13], (const bf16_t*)(ws + WS_WL),
                         (lru::f32x2*)(ws + WS_SUMS), (bf16_t*)(ws + WS_MIX), (unsigned*)(ws + WS_X1)};
    if (IN(2)) {
        if (args.flags & FL_LRU) for (int task = bx; task < NB * NCH; task += G) lru::lru_summaries(LP, lds, task / NCH, task % NCH);
        SEAM(2);
    }
    if (IN(3)) {
        if (args.flags & FL_LRU) { __syncthreads(); for (int task = bx; task < NB * NCH; task += G) lru::lru_apply(LP, lds, task / NCH, task % NCH); __syncthreads(); }
        if (args.flags & FL_ATTN) {
            float gq = 0.f, gk = 0.f; { const float a0 = fabsf(args.in[3][lane]), a1 = fabsf(args.in[4][lane]); gq = a0; gk = a1;
#pragma unroll
                for (int o = 1; o < 64; o <<= 1) { gq = fmaxf(gq, __shfl_xor(gq, o)); gk = fmaxf(gk, __shfl_xor(gk, o)); } }
            const float smax = 8.0f * 1.4426950408889634f * gq * gk * 1.01f; const bool fixref = __builtin_amdgcn_readfirstlane(smax < 40.0f ? 1 : 0) != 0;
            for (int L = vcu; L < NB * 8 * (S / 256); L += G) {
                const int per = 64;
                const int grp = L / per, r = L % per;
                const int b = grp >> 2, kvh = (grp >> 1) & 1, hp = grp & 1, hg = 2 * hp + (r >> 5), qb = r & 31;
                if (fixref) attn_body::attn_unit<8, true>(b, kvh * 4 + hg, qb, (const attn_body::bf16*)(ws + WS_Q), (const attn_body::bf16*)(ws + WS_K), (const attn_body::bf16*)(ws + WS_V),
                                        (attn_body::bf16*)(ws + WS_MIX), (float*)(ws + WS_SSQ), (char*)lds_raw + RING_OFF, smax - 20.0f);
                else attn_body::attn_unit<8, false>(b, kvh * 4 + hg, qb, (const attn_body::bf16*)(ws + WS_Q), (const attn_body::bf16*)(ws + WS_K), (const attn_body::bf16*)(ws + WS_V),
                                        (attn_body::bf16*)(ws + WS_MIX), (float*)(ws + WS_SSQ), (char*)lds_raw + RING_OFF, 0.0f);
            }
        }
        SEAM(3);
    }
    if (IN(4)) {
        pg8::StaticSched Sc; Sc.init(ws + WS_WOUT, T, D, G, bx);
        pg8::EpiOut E{args.in[0], (const float*)(ws + WS_SSQ), (float*)(ws + WS_X1), ws + WS_X1B};
        pg8::gemm_phase<pg8::EpiOut, pg8::StaticSched>(lds + RING_OFF, (const char*)(ws + WS_MIX), Sc, E);
        SEAM(4);
    }
    if (IN(5)) { p5_route(args, lds, G); SEAM(5); }
    if (IN(6) || IN(7)) {
        __syncthreads();
        if (tid < 64) { const unsigned c = (tid < NE) ? __hip_atomic_load(ctl + CW_CNT + tid * CNT_STRIDE, RLX_AGENT) : 0u; unsigned tl = (c + 255u) >> 8, s = tl;
#pragma unroll
            for (int o = 1; o < 32; o <<= 1) { const unsigned v = __shfl_up(s, o); if ((tid & 31) >= o) s += v; }
            if (tid < NE) { MISC[16 + tid + 1] = s; MISC[64 + tid] = c; if (tid == 0) MISC[16] = 0u; } }
        __syncthreads();
        if (tid < 320) { int e = 0; for (int k = 1; k < NE; ++k) e += (MISC[16 + k] <= (unsigned)tid) ? 1 : 0; ((volatile LAS unsigned char*)(lds + MISC_OFF + 512))[tid] = (unsigned char)e; }
        __syncthreads();
    }
    const LAS unsigned* Pl = (const LAS unsigned*)(lds + MISC_OFF + 64); const LAS unsigned* Cl = (const LAS unsigned*)(lds + MISC_OFF + 256); const LAS unsigned char* Te = (const LAS unsigned char*)(lds + MISC_OFF + 512);
#if MOE_MERGE
    if (IN(6)) {
        pg8::MoeSchedM Sc{Pl, Cl, Te, (const int*)(ws + WS_LIST), (unsigned*)ctl + CW_READY, (unsigned*)ctl + CW_TMO, ws, G, vcu};
        pg8::EpiMoeM E{pg8::EpiMoe1{Cl, (const float*)(ws + WS_LISTR), args.in[19], args.in[21], ws + WS_H}, pg8::EpiMoe2{Cl, (const int*)(ws + WS_LIST), (const float*)(ws + WS_LISTG), args.in[23], ws + WS_Y}};
        pg8::gemm_phase<pg8::EpiMoeM, pg8::MoeSchedM, true>(lds + RING_OFF, (const char*)ws, Sc, E);
        if (IN(8)) xcd_barrier(bar);
    }
#else
    if (IN(6)) {
        pg8::MoeSched Sc{Pl, Cl, Te, (const int*)(ws + WS_LIST), (const char*)(ws + WS_BT1), (size_t)2048 * 1024, 8, G, vcu, true};
        pg8::EpiMoe1 E{Cl, (const float*)(ws + WS_LISTR), args.in[19], args.in[21], ws + WS_H};
        pg8::gemm_phase<pg8::EpiMoe1, pg8::MoeSched, true>(lds + RING_OFF, (const char*)(ws + WS_X1B), Sc, E);
        for (;;) {
            __syncthreads();
            if (tid == 0) MISC[8] = __hip_atomic_fetch_add(ctl + 3, 8u, RLX_AGENT);
            __syncthreads();
            const unsigned base = MISC[8];
            if (base >= (unsigned)EXP_STEAL) break;
            convert_expert_items(args, (LAS float*)(lds + RING_OFF + wave * 16384), lane, (int)base + wave, EXP_STEAL, EXP_N1, EXP_ITEMS);
        }
        SEAM(6);
    }
    if (IN(7)) {
        pg8::MoeSched Sc{Pl, Cl, Te, (const int*)(ws + WS_LIST), (const char*)(ws + WS_BT2), (size_t)1024 * 1024, 4, G, vcu, false};
        pg8::EpiMoe2 E{Cl, (const int*)(ws + WS_LIST), (const float*)(ws + WS_LISTG), args.in[23], ws + WS_Y};
        pg8::gemm_phase<pg8::EpiMoe2, pg8::MoeSched, true>(lds + RING_OFF, (const char*)(ws + WS_H), Sc, E);
        SEAM(7);
    }
#endif
    if (IN(8)) p8_final(args, vcu, G, wave, lane);
#undef IN
#undef SEAM
}

static int g_grid = 0;
static bool mk_setup() {
    if (g_grid == 0) {
        int dev = 0, cus = 0, per_cu = 0;
        if (hipGetDevice(&dev) != hipSuccess || hipDeviceGetAttribute(&cus, hipDeviceAttributeMultiprocessorCount, dev) != hipSuccess) { g_grid = -1; return false; }
        if (hipFuncSetAttribute((const void*)mk_fwd, hipFuncAttributeMaxDynamicSharedMemorySize, LDS_BYTES) != hipSuccess) { fprintf(stderr, "kernel_launch: hipFuncSetAttribute failed\n"); g_grid = -1; return false; }
        if (hipOccupancyMaxActiveBlocksPerMultiprocessor(&per_cu, (const void*)mk_fwd, NWAVES * 64, LDS_BYTES) != hipSuccess || per_cu < 1) { fprintf(stderr, "kernel_launch: occupancy query says %d blocks per CU\n", per_cu); g_grid = -1; return false; }
        (void)hipGetLastError();
        g_grid = cus;
    }
    return g_grid > 0;
}
static void mk_launch(void* const* d_in, float* out, void* ws, int lo, int hi, int flags, int li, hipStream_t st) {
    if (!mk_setup()) return;
    Args a{};
    for (int i = 0; i < 25; ++i) a.in[i] = (const float*)d_in[i];
    a.out = out; a.ws = (unsigned char*)ws; a.ph_lo = lo; a.ph_hi = hi; a.flags = flags; a.li = li;
    hipLaunchKernelGGL(mk_fwd, dim3(g_grid), dim3(NWAVES * 64), LDS_BYTES, st, a);
}
}
extern "C" void kernel_launch(void* const* d_in, const int* in_sizes, int n_in, void* d_out, int out_size, void* d_ws, size_t ws_size, hipStream_t stream) {
    if (n_in != 25 || ws_size < (size_t)mk::WS_END || out_size != mk::T * mk::D) { fprintf(stderr, "kernel_launch: unexpected n_in %d / ws_size %zu / out_size %d\n", n_in, ws_size, out_size); return; }
    (void)hipMemsetAsync((char*)d_ws + mk::WS_CTL, 0, mk::CTL_ZERO_BYTES, stream);
    mkf::mk_launch(d_in, (float*)d_out, d_ws, 0, 9, mkf::FL_LRU | mkf::FL_ATTN, 0, stream);
}
```

```cpp
#define ONE_LAUNCH 1
#include <hip/hip_runtime.h>
#include <hip/hip_bf16.h>
#include <stdint.h>
#include <math.h>
#include <cstdio>

#ifndef MOE_MERGE
#define MOE_MERGE 0
#endif
namespace mk {
constexpr int NB = 2, S = 8192, T = NB * S, D = 1024, INW = 1792, NE = 32, LW = 512;
constexpr float C2 = 0.125f * 1.4426950408889634f;
constexpr int LC = 64, NCH = S / LC;
constexpr size_t MiB = 1u << 20;
constexpr size_t WS_CTL = 0, CTL_ZERO_BYTES = MOE_MERGE ? 1 * MiB : 32 * 1024;
constexpr size_t WS_ROPE = 1 * MiB;
constexpr size_t WS_WL = 1 * MiB + 64 * 1024;
constexpr size_t WS_RTR = 1 * MiB + 512 * 1024;
constexpr size_t WS_SUMS = 2 * MiB;
constexpr size_t WS_SSQ = 4 * MiB;
constexpr size_t WS_RSTD = 4 * MiB + 512 * 1024;
constexpr size_t WS_GATEV = 4 * MiB + 768 * 1024;
constexpr size_t WS_LIST = 5 * MiB;
constexpr size_t WS_WIN = 8 * MiB, WS_WOUT = 12 * MiB, WS_BT1 = 14 * MiB, WS_BT2 = 142 * MiB, WS_XN = 206 * MiB, WS_X1 = 238 * MiB;
constexpr size_t WS_Q = 302 * MiB, WS_K = 318 * MiB, WS_V = 322 * MiB, WS_LX = 326 * MiB, WS_LG = 342 * MiB, WS_MIX = 358 * MiB;
constexpr size_t WS_H = 302 * MiB, WS_Y = 14 * MiB, WS_X1B = 206 * MiB, WS_END = 446 * MiB;
constexpr size_t WS_LISTR = 2 * MiB;
constexpr size_t WS_LISTG = 224 * MiB;
constexpr size_t WS_SCR = 390 * MiB;
constexpr int CW_READY = 65536;
constexpr int CW_TMO = 0, CW_CODE = 1, CW_CNT = 64, CNT_STRIDE = 64, CW_BAR = 4096;

typedef unsigned short bf16_t;
__host__ __device__ __forceinline__ unsigned f2bf(float f) { unsigned u = __builtin_bit_cast(unsigned, f); return (u + 0x7fffu + ((u >> 16) & 1u)) >> 16; }
__host__ __device__ __forceinline__ float bf2f(unsigned h) { return __builtin_bit_cast(float, (h & 0xffffu) << 16); }
__host__ __device__ __forceinline__ unsigned pk2(float lo, float hi) { return f2bf(lo) | (f2bf(hi) << 16); }

typedef unsigned u32x4_t __attribute__((ext_vector_type(4)));
#ifndef WT_STORES
#define WT_STORES 1
#endif
template <int ON = 1> __device__ __forceinline__ void st16_wt(void* p, u32x4_t v) {
  if constexpr (ON) {
#if WT_STORES
    asm volatile("global_store_dwordx4 %0, %1, off sc1\n\ts_nop 1" :: "v"(p), "v"(v) : "memory");
#else
    *(u32x4_t*)p = v;
#endif
  } else *(u32x4_t*)p = v;
}
#ifndef WT_P0
#define WT_P0 0
#endif
#ifndef WT_EPI
#define WT_EPI 0
#endif
__host__ __device__ __forceinline__ int perm_cl(int o) { const int fq = o >> 3, n = (o >> 2) & 1, e = o & 3; return 16 * n + 4 * fq + e; }
__host__ __device__ __forceinline__ int perm256_dst(int c) { const int pn = c >> 8, cp = c & 255, bj = cp >> 7, wc = (cp >> 5) & 3; return 256 * pn + 128 * bj + 32 * wc + perm_cl(cp & 31); }
__host__ __device__ __forceinline__ int win_dst(int c) {
    if (c < 768) { const int pn = c >> 8, cp = c & 255, wc = cp >> 6, bj = (cp >> 5) & 1, j = cp & 31; return 256 * pn + 128 * bj + 32 * wc + j; }
    return perm256_dst(c);
}
__host__ __device__ __forceinline__ int down_dst(int c) { const int pn = c >> 8, cp = c & 255, wc = cp >> 6, fq = (cp >> 4) & 3, bj = (cp >> 3) & 1, n = (cp >> 2) & 1, e = cp & 3; return 256 * pn + 128 * bj + 32 * wc + 16 * n + 4 * fq + e; }
__host__ __device__ __forceinline__ int gu_dst(int hc, int half) { const int j = hc >> 7, wc = (hc >> 5) & 3; return 256 * j + 128 * half + 32 * wc + perm_cl(hc & 31); }
}
namespace nv {
using namespace mk;
__device__ __forceinline__ void tbl_rope(int idx, float* rope) {
    const int pos = idx >> 4, i = idx & 15; const float ang = (float)pos * powf(10000.0f, -(float)i / 16.0f);
    rope[idx] = cosf(ang); rope[2048 + idx] = sinf(ang);
}
__device__ __forceinline__ void tbl_wl(int idx, const float* wa, const float* wi, bf16_t* WL) {
    const int j = idx & 7, lane = (idx >> 3) & 63, ks = (idx >> 9) & 3, nh = (idx >> 11) & 1, mat = (idx >> 12) & 3, n = idx >> 14;
    const int r32 = lane & 31, hi = lane >> 5, i = 16 * ks + 8 * hi + j, jc = 32 * nh + r32, dir = mat >> 1;
    const float* W = (mat & 1) ? wi : wa;
    WL[idx] = (bf16_t)f2bf(W[((size_t)(dir * 8 + n) * 64 + i) * 64 + jc]);
}
__device__ __forceinline__ void tbl_rtr(int idx, const float* wr, const float* n2g, bf16_t* RT) {
    const int j = idx & 7, lane = (idx >> 3) & 63, ks = idx >> 9; const int e = lane & 31, hi = lane >> 5, k = 16 * ks + 8 * hi + j;
    const float w = n2g[k] * wr[(size_t)k * NE + e]; const unsigned h = f2bf(w);
    RT[idx] = (bf16_t)h; RT[32768 + idx] = (bf16_t)f2bf(w - bf2f(h));
}
}
namespace pg8 {
using mk::bf16_t;
#define PG8_LAS __attribute__((address_space(3)))
typedef short bf16x8 __attribute__((ext_vector_type(8)));
typedef float f32x4 __attribute__((ext_vector_type(4)));
typedef unsigned u32x4 __attribute__((ext_vector_type(4)));
typedef unsigned u32x2 __attribute__((ext_vector_type(2)));
typedef int v8i __attribute__((ext_vector_type(8)));
typedef int v4i __attribute__((ext_vector_type(4)));
constexpr int BM = 256, BK = 64, HALF = 128, HTB = HALF * BK * 2, STAGE_BYTES = 8 * HTB, NXCD = 8, WGM = 8, KD = 1024;

__host__ __device__ __forceinline__ int lds_byte(int r, int c) { const int st = (r >> 4) * 2 + (c >> 5), rr = r & 15, cc = c & 31, ob = rr * 64 + cc * 2; return st * 1024 + (ob ^ (((ob >> 9) & 1) << 5)); }
__host__ __device__ __forceinline__ void stage_rc(int b, int& R, int& C) { const int st = b / 1024, sb = b % 1024, swz = sb ^ (((sb >> 9) & 1) << 5); R = (st >> 1) * 16 + swz / 64; C = (st & 1) * 32 + (swz % 64) / 2; }

struct GUnit { int pm, pn, e, lt, kind; };

struct StaticSched {
    const char* Bt; int nM, nN, nwg, G, c;
    __device__ void init(const void* Bt_, int M, int N, int G_, int c_) { Bt = (const char*)Bt_; nM = M / BM; nN = N / BM; nwg = nM * nN; G = G_; c = c_; }
    __device__ __forceinline__ bool next(int i, GUnit& u) const {
        const long L = (long)i * G + c; if (L >= nwg) return false;
        int wgid = (int)L; { const int q = nwg / NXCD, r = nwg % NXCD, xcd = wgid % NXCD, off = wgid / NXCD; wgid = (xcd < r ? xcd * (q + 1) : r * (q + 1) + (xcd - r) * q) + off; }
        const int nig = WGM * nN, gid = wgid / nig, fm = gid * WGM, gsz = (nM - fm) < WGM ? (nM - fm) : WGM;
        u.pm = fm + ((wgid % nig) % gsz); u.pn = (wgid % nig) / gsz; u.e = 0; u.lt = 0; u.kind = 0; return true;
    }
    __device__ __forceinline__ void aoffs_issue(const GUnit& u, int tid, unsigned (&raw)[2][2]) const {
#pragma unroll
        for (int i = 0; i < 2; ++i) { int R, C; stage_rc(tid * 16 + i * 8192, R, C);
#pragma unroll
            for (int h = 0; h < 2; ++h) raw[h][i] = (unsigned)((u.pm * BM + h * HALF + R) * KD + C) * 2u; }
    }
    __device__ __forceinline__ void aoffs_finish(const GUnit&, int, const unsigned (&raw)[2][2], unsigned (&ao)[2][2]) const {
#pragma unroll
        for (int h = 0; h < 2; ++h)
#pragma unroll
            for (int i = 0; i < 2; ++i) ao[h][i] = raw[h][i];
    }
    __device__ __forceinline__ const char* bbase(const GUnit& u) const { return Bt + (size_t)u.pn * BM * KD * 2; }
    static constexpr int A_AUX = 0;
    __device__ __forceinline__ void wait_ready(const GUnit&, int) const {}
    __device__ __forceinline__ void publish(const GUnit&, int) const {}
};

template <class Epi, class Sched, bool F8 = false>
__device__ __forceinline__ void gemm_phase(PG8_LAS unsigned char* lds, const char* Abase, const Sched& S, const Epi& E) {
    int tid_ = threadIdx.x; asm volatile("" : "+v"(tid_));
    const int tid = tid_, wid = __builtin_amdgcn_readfirstlane(tid >> 6), lane = tid & 63, wr = wid >> 2, wc = wid & 3, fr = lane & 15, fq = lane >> 4;
    constexpr int K = KD, nt = F8 ? K / 128 : K / BK; constexpr unsigned ROWB = F8 ? 1024u : 2048u;
    unsigned voffB[2];
#pragma unroll
    for (int i = 0; i < 2; ++i) { int R, C; stage_rc(tid * 16 + i * 8192, R, C); voffB[i] = (unsigned)R * ROWB + 2u * (unsigned)C; }
    PG8_LAS u32x4* aon = (PG8_LAS u32x4*)(lds + STAGE_BYTES) + tid;
    constexpr unsigned kstep = BK * 2;
    constexpr size_t hstep = (size_t)HALF * ROWB;
    const unsigned ldsw = (unsigned)wid * 1024u;
    const int aoff = lds_byte(wr * 64 + fr, fq * 8), boff = lds_byte(wc * 32 + fr, fq * 8);
#define PG8_SA(b, h) (((b) * 2 + (h)) * HTB)
#define PG8_SB(b, h) ((4 + (b) * 2 + (h)) * HTB)
#define PG8_STAGE_B(bufoff, gbase) do { _Pragma("unroll") for (int _i = 0; _i < 2; ++_i) \
        __builtin_amdgcn_global_load_lds((const unsigned*)((const char*)(gbase) + voffB[_i]), (PG8_LAS unsigned*)(lds + (bufoff) + ldsw + _i * 8192), 16, 0, 0); } while (0)
#define PG8_STAGE_A(bufoff, o0, o1) do { \
        __builtin_amdgcn_global_load_lds((const unsigned*)(Abase + (o0)), (PG8_LAS unsigned*)(lds + (bufoff) + ldsw), 16, 0, Sched::A_AUX); \
        __builtin_amdgcn_global_load_lds((const unsigned*)(Abase + (o1)), (PG8_LAS unsigned*)(lds + (bufoff) + ldsw + 8192), 16, 0, Sched::A_AUX); } while (0)
#define PG8_LD2(p) __builtin_shufflevector(*(const PG8_LAS v4i*)(p), *(const PG8_LAS v4i*)((p) + 1024), 0, 1, 2, 3, 4, 5, 6, 7)
#define PG8_LDA(dst, b, h) do { _Pragma("unroll") for (int m = 0; m < 4; ++m) dst[m] = PG8_LD2(lds + PG8_SA(b, h) + aoff + m * 2048); } while (0)
#define PG8_LDB(dst, b, h) do { _Pragma("unroll") for (int n = 0; n < 2; ++n) dst[n] = PG8_LD2(lds + PG8_SB(b, h) + boff + n * 2048); } while (0)
#define PG8_HALF(v, k) __builtin_bit_cast(bf16x8, (v4i){(v)[4 * (k)], (v)[4 * (k) + 1], (v)[4 * (k) + 2], (v)[4 * (k) + 3]})
#define PG8_MMA(ai, bj, At, Bt) do { __builtin_amdgcn_s_setprio(1); \
        if constexpr (F8) { _Pragma("unroll") for (int m = 0; m < 4; ++m) _Pragma("unroll") for (int n = 0; n < 2; ++n) \
            asm volatile("v_mfma_scale_f32_16x16x128_f8f6f4 %0, %1, %2, %0, %3, %4 op_sel_hi:[0,0,0]" : "+v"(acc[ai][bj][m][n]) : "v"(Bt[n]), "v"(At[m]), "v"(scw), "v"(sca)); } \
        else { _Pragma("unroll") for (int m = 0; m < 4; ++m) _Pragma("unroll") for (int n = 0; n < 2; ++n) _Pragma("unroll") for (int k = 0; k < 2; ++k) \
            acc[ai][bj][m][n] = __builtin_amdgcn_mfma_f32_16x16x32_bf16(PG8_HALF(Bt[n], k), PG8_HALF(At[m], k), acc[ai][bj][m][n], 0, 0, 0); } \
        __builtin_amdgcn_s_setprio(0); } while (0)
#define PG8_WAIT_V(n) asm volatile("s_waitcnt vmcnt(" #n ")" ::: "memory")
#define PG8_WAIT_L(n) asm volatile("s_waitcnt lgkmcnt(" #n ")" ::: "memory")
#define PG8_BAR __builtin_amdgcn_s_barrier()
#define PG8_SCHED __builtin_amdgcn_sched_barrier(0)
    GUnit cur, nxt, nn; int ui = 0;
    if (!S.next(0, cur)) return;
    f32x4 acc[2][2][4][2];
#pragma unroll
    for (int a = 0; a < 2; ++a)
#pragma unroll
        for (int b = 0; b < 2; ++b)
#pragma unroll
            for (int m = 0; m < 4; ++m)
#pragma unroll
                for (int n = 0; n < 2; ++n) acc[a][b][m][n] = (f32x4){0.f, 0.f, 0.f, 0.f};
    v8i At[4], B0[2], B1[2];
    int scw = Epi::SC_W, sca = E.sc_a(cur); if constexpr (F8) asm volatile("" : "+v"(scw), "+v"(sca));
    unsigned aoC[2][2], rawN[2][2];
    S.wait_ready(cur, lane);
    { unsigned raw0[2][2]; S.aoffs_issue(cur, tid, raw0); S.aoffs_finish(cur, tid, raw0, aoC); }
    GUnit prv = cur; bool have_prv = false;
    bool has_next = S.next(1, nxt);
    if (has_next) S.aoffs_issue(nxt, tid, rawN);
    const char* cB = S.bbase(cur);
    PG8_STAGE_B(PG8_SB(0, 0), cB); PG8_STAGE_B(PG8_SB(0, 1), cB + hstep); PG8_STAGE_A(PG8_SA(0, 0), aoC[0][0], aoC[0][1]); PG8_STAGE_A(PG8_SA(0, 1), aoC[1][0], aoC[1][1]);
    if (wr == 1) PG8_BAR;
    PG8_WAIT_V(2); PG8_BAR;
    PG8_STAGE_B(PG8_SB(1, 0), cB + kstep); PG8_STAGE_A(PG8_SA(1, 0), aoC[0][0] + kstep, aoC[0][1] + kstep); PG8_STAGE_B(PG8_SB(1, 1), cB + hstep + kstep);
    PG8_WAIT_V(6); PG8_BAR;
    for (;;) {
        const bool has_nn = has_next && S.next(ui + 2, nn);
        if (has_next && nxt.kind && have_prv) { PG8_WAIT_V(0); S.publish(prv, lane); have_prv = false; }
        if (has_next) S.wait_ready(nxt, lane);
        const char* nB = cB;
        { unsigned aoN[2][2];
          if (has_next) { S.aoffs_finish(nxt, tid, rawN, aoN); nB = S.bbase(nxt); }
          else {
#pragma unroll
            for (int h = 0; h < 2; ++h)
#pragma unroll
                for (int i = 0; i < 2; ++i) aoN[h][i] = aoC[h][i];
          }
          *aon = (u32x4){aoN[0][0], aoN[0][1], aoN[1][0], aoN[1][1]}; }
        if (has_nn) S.aoffs_issue(nn, tid, rawN);
#pragma unroll 1
        for (int t = 0; t < nt; t += 2) {
            const bool last = (t == nt - 2);
            if constexpr (Epi::MID) { if (t == nt / 2) E.mid(acc, cur, wr, fr); }
            if (t == 2 && have_prv) { S.publish(prv, lane); have_prv = false; }
            if (last) E.prefetch(lds, cur, wid, lane);
            const unsigned k1 = (unsigned)(t + 1) * kstep;
            unsigned a2_00 = aoC[0][0] + (unsigned)(t + 2) * kstep, a2_01 = aoC[0][1] + (unsigned)(t + 2) * kstep, a2_10 = aoC[1][0] + (unsigned)(t + 2) * kstep, a2_11 = aoC[1][1] + (unsigned)(t + 2) * kstep;
            if (last) { const u32x4 v = *aon; a2_00 = v.x; a2_01 = v.y; a2_10 = v.z; a2_11 = v.w; }
            const char* b2 = last ? nB : cB + (size_t)(t + 2) * kstep; const char* b3 = b2 + kstep;
            PG8_LDB(B0, 0, 0); PG8_LDB(B1, 0, 1); PG8_SCHED; PG8_LDA(At, 0, 0); PG8_STAGE_A(PG8_SA(1, 1), aoC[1][0] + k1, aoC[1][1] + k1);
            PG8_WAIT_V(8); PG8_WAIT_L(0); PG8_BAR; PG8_MMA(0, 0, At, B0); PG8_MMA(0, 1, At, B1); PG8_BAR; PG8_SCHED;
            PG8_LDA(At, 0, 1); PG8_STAGE_B(PG8_SB(0, 0), b2); PG8_STAGE_B(PG8_SB(0, 1), b2 + hstep); PG8_STAGE_A(PG8_SA(0, 0), a2_00, a2_01);
            PG8_WAIT_V(8); PG8_WAIT_L(0); PG8_BAR; PG8_MMA(1, 0, At, B0); PG8_MMA(1, 1, At, B1); PG8_BAR; PG8_SCHED;
            PG8_LDB(B0, 1, 0); PG8_LDB(B1, 1, 1); PG8_SCHED; PG8_LDA(At, 1, 0); PG8_STAGE_A(PG8_SA(0, 1), a2_10, a2_11);
            PG8_WAIT_V(8); PG8_WAIT_L(0); PG8_BAR; PG8_MMA(0, 0, At, B0); PG8_MMA(0, 1, At, B1); PG8_BAR; PG8_SCHED;
            PG8_LDA(At, 1, 1); PG8_STAGE_B(PG8_SB(1, 0), b3); PG8_STAGE_B(PG8_SB(1, 1), b3 + hstep); PG8_STAGE_A(PG8_SA(1, 0), a2_00 + kstep, a2_01 + kstep);
            PG8_WAIT_V(8); PG8_WAIT_L(0); PG8_BAR; PG8_MMA(1, 0, At, B0); PG8_MMA(1, 1, At, B1); PG8_BAR; PG8_SCHED;
        }
        if constexpr (F8) asm volatile("s_nop 15\n\ts_nop 15" ::: "memory");
        if (wr == 0) PG8_BAR;
        E(acc, cur, lds, wr, wc, fr, fq);
        prv = cur; have_prv = true;
        if (!has_next) break;
#pragma unroll
        for (int a = 0; a < 2; ++a)
#pragma unroll
            for (int b = 0; b < 2; ++b)
#pragma unroll
                for (int m = 0; m < 4; ++m)
#pragma unroll
                    for (int n = 0; n < 2; ++n) acc[a][b][m][n] = (f32x4){0.f, 0.f, 0.f, 0.f};
        cur = nxt; nxt = nn; has_next = has_nn; cB = nB; ++ui;
        if constexpr (F8) { sca = E.sc_a(cur); asm volatile("" : "+v"(sca)); }
        { const u32x4 v = *aon; aoC[0][0] = v.x; aoC[0][1] = v.y; aoC[1][0] = v.z; aoC[1][1] = v.w; }
        if (wr == 1) PG8_BAR;
    }
    PG8_WAIT_V(0);
    if (have_prv) S.publish(prv, lane);
    PG8_BAR;
#undef PG8_SA
#undef PG8_SB
#undef PG8_STAGE_A
#undef PG8_STAGE_B
#undef PG8_LDA
#undef PG8_LDB
#undef PG8_MMA
#undef PG8_LD2
#undef PG8_HALF
#undef PG8_WAIT_V
#undef PG8_WAIT_L
#undef PG8_BAR
#undef PG8_SCHED
}
}
namespace pg8 {
using namespace mk;
__device__ __forceinline__ unsigned cvt_pk_bf16(float lo, float hi) { unsigned r; asm volatile("v_cvt_pk_bf16_f32 %0, %1, %2" : "=v"(r) : "v"(lo), "v"(hi)); return r; }

struct EpiInProj {
    static constexpr bool MID = false; static constexpr int SC_W = 0x7F7F7F7F, SC_A = 0x7F7F7F7F;
    __device__ __forceinline__ void prefetch(PG8_LAS unsigned char*, const GUnit&, int, int) const {}
    __device__ __forceinline__ int sc_a(const GUnit&) const { return SC_A; }
    bf16_t *Q, *Kb, *V, *LX, *LG; const float *qg, *kg, *rope;
    __device__ __forceinline__ void operator()(const f32x4 (&acc)[2][2][4][2], const GUnit& u, PG8_LAS unsigned char* lds, int wr, int wc, int fr_, int fq_) const {
        int fr = fr_, fq = fq_; asm volatile("" : "+v"(fr), "+v"(fq));
        const int row0 = u.pm * BM + wr * 64 + fr;
        if (u.pn >= 3) {
            bf16_t* base = (u.pn < 5) ? LX : LG; const int col0 = ((u.pn - 3) & 1) * 256 + wc * 32 + 8 * fq;
#pragma unroll
            for (int ai = 0; ai < 2; ++ai)
#pragma unroll
                for (int m = 0; m < 4; ++m) { bf16_t* rowp = base + (size_t)(row0 + ai * HALF + m * 16) * 512 + col0;
#pragma unroll
                    for (int bj = 0; bj < 2; ++bj) { const f32x4 v0 = acc[ai][bj][m][0], v1 = acc[ai][bj][m][1];
                        u32x4 w; w.x = cvt_pk_bf16(v0[0], v0[1]); w.y = cvt_pk_bf16(v0[2], v0[3]); w.z = cvt_pk_bf16(v1[0], v1[1]); w.w = cvt_pk_bf16(v1[2], v1[3]);
                        st16_wt<WT_EPI>(rowp + bj * HALF, w); } }
            return;
        }
        if (u.pn == 2 && wc >= 2) {
#pragma unroll
            for (int ai = 0; ai < 2; ++ai)
#pragma unroll
                for (int m = 0; m < 4; ++m) { bf16_t* rowp = V + (size_t)(row0 + ai * HALF + m * 16) * 128 + 64 * (wc - 2) + 4 * fq;
#pragma unroll
                    for (int bj = 0; bj < 2; ++bj)
#pragma unroll
                        for (int n = 0; n < 2; ++n) { const f32x4 v = acc[ai][bj][m][n]; u32x2 w; w.x = cvt_pk_bf16(v[0], v[1]); w.y = cvt_pk_bf16(v[2], v[3]); *(u32x2*)(rowp + 32 * bj + 16 * n) = w; } }
            return;
        }
        const bool isq = u.pn < 2; const float* gp = (isq ? qg : kg) + 4 * fq; const float osc = isq ? C2 : 1.0f;
#pragma unroll
        for (int ai = 0; ai < 2; ++ai)
#pragma unroll
            for (int m = 0; m < 4; ++m) {
                const int t = row0 + ai * HALF + m * 16;
                float ss = 0.f;
#pragma unroll
                for (int bj = 0; bj < 2; ++bj)
#pragma unroll
                    for (int n = 0; n < 2; ++n) { const f32x4 v = acc[ai][bj][m][n]; ss += (v[0] * v[0] + v[1] * v[1]) + (v[2] * v[2] + v[3] * v[3]); }
                ss += __shfl_xor(ss, 16); ss += __shfl_xor(ss, 32);
                const float rs = osc / sqrtf(ss * (1.0f / 64.0f) + 1e-6f);
                const int s = t & (S - 1), posr = s >> 6, posc = s & 63;
                bf16_t* rowp = isq ? Q + (size_t)t * 512 + 64 * (4 * u.pn + wc) + 4 * fq : Kb + (size_t)t * 128 + 64 * wc + 4 * fq;
#pragma unroll
                for (int bj = 0; bj < 2; ++bj) {
                    const int pos = bj ? posc : posr;
                    const f32x4 c4 = *(const f32x4*)(rope + pos * 16 + 4 * fq), s4 = *(const f32x4*)(rope + 2048 + pos * 16 + 4 * fq);
                    const f32x4 g0 = *(const f32x4*)(gp + 32 * bj), g1 = *(const f32x4*)(gp + 32 * bj + 16);
                    const f32x4 x1 = acc[ai][bj][m][0] * g0 * rs, x2 = acc[ai][bj][m][1] * g1 * rs;
                    const f32x4 o1 = x1 * c4 - x2 * s4, o2 = x2 * c4 + x1 * s4;
                    u32x2 w1, w2; w1.x = cvt_pk_bf16(o1[0], o1[1]); w1.y = cvt_pk_bf16(o1[2], o1[3]); w2.x = cvt_pk_bf16(o2[0], o2[1]); w2.y = cvt_pk_bf16(o2[2], o2[3]);
                    *(u32x2*)(rowp + 32 * bj) = w1; *(u32x2*)(rowp + 32 * bj + 16) = w2;
                }
                asm volatile("" ::: "memory");
            }
    }
};

struct EpiOut {
    static constexpr bool MID = true; static constexpr int SC_W = 0x7F7F7F7F, SC_A = 0x7F7F7F7F;
    __device__ __forceinline__ void prefetch(PG8_LAS unsigned char*, const GUnit&, int, int) const {}
    __device__ __forceinline__ int sc_a(const GUnit&) const { return SC_A; }
    const float* x; const float* SSQ; float* X1; unsigned char* X1F8;
    __device__ __forceinline__ void mid(f32x4 (&acc)[2][2][4][2], const GUnit& u, int wr, int fr_) const {
        int fr = fr_; asm volatile("" : "+v"(fr));
#pragma unroll
        for (int ai = 0; ai < 2; ++ai)
#pragma unroll
            for (int m = 0; m < 4; ++m) {
                const float* p = SSQ + (size_t)(u.pm * BM + ai * HALF + wr * 64 + m * 16 + fr) * 8;
                const f32x4 a = *(const f32x4*)p, b = *(const f32x4*)(p + 4);
                const float s = ((a[0] + a[1]) + (a[2] + a[3])) + ((b[0] + b[1]) + (b[2] + b[3]));
                const float sa = 1.0f / sqrtf(s * (1.0f / 512.0f) + 1e-5f);
#pragma unroll
                for (int bj = 0; bj < 2; ++bj)
#pragma unroll
                    for (int n = 0; n < 2; ++n) acc[ai][bj][m][n] *= sa;
            }
    }
    __device__ __forceinline__ void operator()(const f32x4 (&acc)[2][2][4][2], const GUnit& u, PG8_LAS unsigned char* lds, int wr, int wc, int fr_, int fq_) const {
        int fr = fr_, fq = fq_; asm volatile("" : "+v"(fr), "+v"(fq));
        const int row0 = u.pm * BM + wr * 64 + fr, col0 = u.pn * BM + wc * 32 + 8 * fq;
#pragma unroll
        for (int ai = 0; ai < 2; ++ai)
#pragma unroll
            for (int m = 0; m < 4; ++m) { const size_t off = (size_t)(row0 + ai * HALF + m * 16) * D + col0;
#pragma unroll
                for (int bj = 0; bj < 2; ++bj) {
                    const f32x4 v0 = __builtin_nontemporal_load((const f32x4*)(x + off + bj * HALF)) + acc[ai][bj][m][0], v1 = __builtin_nontemporal_load((const f32x4*)(x + off + bj * HALF + 4)) + acc[ai][bj][m][1];
                    st16_wt<WT_EPI>(X1 + off + bj * HALF, __builtin_bit_cast(u32x4, v0)); st16_wt<WT_EPI>(X1 + off + bj * HALF + 4, __builtin_bit_cast(u32x4, v1));
                    int w0 = 0, w1 = 0; w0 = __builtin_amdgcn_cvt_pk_fp8_f32(v0[0], v0[1], w0, false); w0 = __builtin_amdgcn_cvt_pk_fp8_f32(v0[2], v0[3], w0, true);
                    w1 = __builtin_amdgcn_cvt_pk_fp8_f32(v1[0], v1[1], w1, false); w1 = __builtin_amdgcn_cvt_pk_fp8_f32(v1[2], v1[3], w1, true);
                    *(u32x2*)(X1F8 + off + bj * HALF) = (u32x2){(unsigned)w0, (unsigned)w1}; }
                if (m & 1) asm volatile("" ::: "memory"); }
    }
};

struct MoeSched {
    const PG8_LAS unsigned* P;
    const PG8_LAS unsigned* cntl;
    const PG8_LAS unsigned char* te;
    const int* list; const char* Bt; size_t estride; int ntn, G, vcu; bool gather;
    __device__ __forceinline__ bool next(int i, GUnit& u) const {
        const unsigned L = (unsigned)i * (unsigned)G + (unsigned)vcu; const unsigned mt = L / (unsigned)ntn;
        const unsigned tot = (unsigned)__builtin_amdgcn_readfirstlane((int)P[NE]);
        if (mt >= tot) return false;
        const int e = __builtin_amdgcn_readfirstlane((int)te[mt]);
        u.kind = 0; u.pm = (int)mt; u.pn = (int)(L % (unsigned)ntn); u.e = e; u.lt = (int)(mt - (unsigned)__builtin_amdgcn_readfirstlane((int)P[e])); return true;
    }
    __device__ __forceinline__ void aoffs_issue(const GUnit& u, int tid, unsigned (&raw)[2][2]) const {
        const int n = (int)cntl[u.e] - u.lt * BM;
#pragma unroll
        for (int i = 0; i < 2; ++i) { int R, C; stage_rc(tid * 16 + i * 8192, R, C);
#pragma unroll
            for (int h = 0; h < 2; ++h) {
                const int rr = h * HALF + R;
                if (gather) { raw[h][i] = 0u; if (rr < n) raw[h][i] = (unsigned)list[(size_t)u.e * T + u.lt * BM + rr]; }
                else raw[h][i] = (unsigned)(u.pm * BM + rr);
            } }
    }
    __device__ __forceinline__ void aoffs_finish(const GUnit&, int tid, const unsigned (&raw)[2][2], unsigned (&ao)[2][2]) const {
#pragma unroll
        for (int i = 0; i < 2; ++i) { int R, C; stage_rc(tid * 16 + i * 8192, R, C);
#pragma unroll
            for (int h = 0; h < 2; ++h) ao[h][i] = (gather ? (raw[h][i] >> 2) : raw[h][i]) * 1024u + 2u * (unsigned)C; }
    }
    __device__ __forceinline__ const char* bbase(const GUnit& u) const { return Bt + (size_t)u.e * estride + (size_t)u.pn * BM * 1024; }
    static constexpr int A_AUX = 0;
    __device__ __forceinline__ void wait_ready(const GUnit&, int) const {}
    __device__ __forceinline__ void publish(const GUnit&, int) const {}
};

struct EpiMoe1 {
    static constexpr bool MID = false; static constexpr int SC_W = 0x7A7A7A7A, SC_A = 0x7F7F7F7F;
    const PG8_LAS unsigned* cntl; const float* listr; const float* bg; const float* bu; unsigned char* H;
    __device__ __forceinline__ int sc_a(const GUnit&) const { return SC_A; }
    static constexpr int PRE_OFF = STAGE_BYTES + 8192;
    __device__ __forceinline__ void prefetch(PG8_LAS unsigned char* lds, const GUnit& u, int wid, int lane) const {
        if (wid < 4) { const int nvalid = (int)cntl[u.e] - u.lt * BM; int r = wid * 64 + lane; r = r < nvalid ? r : 0;
            __builtin_amdgcn_global_load_lds((const unsigned*)(listr + (size_t)u.e * T + u.lt * BM + r), (PG8_LAS unsigned*)(lds + PRE_OFF + wid * 256), 4, 0, 0); }
    }
    __device__ __forceinline__ void operator()(const f32x4 (&acc)[2][2][4][2], const GUnit& u, PG8_LAS unsigned char* lds, int wr, int wc, int fr_, int fq_) const {
        int fr = fr_, fq = fq_; asm volatile("" : "+v"(fr), "+v"(fq));
        const int nvalid = (int)cntl[u.e] - u.lt * BM; const int hc0 = u.pn * HALF + wc * 32 + 8 * fq;
        f32x4 bgv[2], buv[2];
#pragma unroll
        for (int n = 0; n < 2; ++n) { bgv[n] = *(const f32x4*)(bg + u.e * D + hc0 + 4 * n); buv[n] = *(const f32x4*)(bu + u.e * D + hc0 + 4 * n); }
#pragma unroll
        for (int ai = 0; ai < 2; ++ai)
#pragma unroll
            for (int m = 0; m < 4; ++m) {
                const int rl = ai * HALF + wr * 64 + m * 16 + fr;
                if (rl < nvalid) {
                    const float rs = *(const PG8_LAS float*)(lds + PRE_OFF + rl * 4);
                    int w[2] = {0, 0};
#pragma unroll
                    for (int n = 0; n < 2; ++n) {
                        f32x4 g = acc[ai][0][m][n] * rs + bgv[n], uu = acc[ai][1][m][n] * rs + buv[n], hv;
#pragma unroll
                        for (int e = 0; e < 4; ++e) { const float gc = fminf(g[e], 7.0f), uc = fminf(fmaxf(uu[e], -7.0f), 7.0f);
                            const float sg = __builtin_amdgcn_rcpf(1.0f + __builtin_amdgcn_exp2f(-1.702f * 1.4426950408889634f * gc)); hv[e] = (uc + 1.0f) * gc * sg; }
                        w[n] = __builtin_amdgcn_cvt_pk_fp8_f32(4.0f * hv[0], 4.0f * hv[1], w[n], false); w[n] = __builtin_amdgcn_cvt_pk_fp8_f32(4.0f * hv[2], 4.0f * hv[3], w[n], true);
                    }
#if MOE_MERGE
                    __hip_atomic_store((unsigned long long*)(H + (size_t)(u.pm * BM + rl) * 1024 + hc0), (unsigned long long)(unsigned)w[0] | ((unsigned long long)(unsigned)w[1] << 32), __ATOMIC_RELAXED, __HIP_MEMORY_SCOPE_AGENT);
#else
                    *(u32x2*)(H + (size_t)(u.pm * BM + rl) * 1024 + hc0) = (u32x2){(unsigned)w[0], (unsigned)w[1]};
#endif
                }
            }
    }
};
struct EpiMoe2 {
    static constexpr bool MID = false; static constexpr int SC_W = 0x7A7A7A7A, SC_A = 0x7D7D7D7D;
    const PG8_LAS unsigned* cntl; const int* list; const float* listg; const float* bd; unsigned char* Y;
    __device__ __forceinline__ int sc_a(const GUnit&) const { return SC_A; }
    static constexpr int PRE_OFF = STAGE_BYTES + 8192;
    __device__ __forceinline__ void prefetch(PG8_LAS unsigned char* lds, const GUnit& u, int wid, int lane) const {
        const int nvalid = (int)cntl[u.e] - u.lt * BM; int r = (wid & 3) * 64 + lane; r = r < nvalid ? r : 0;
        const size_t pos = (size_t)u.e * T + u.lt * BM + r;
        const unsigned* src = (wid < 4) ? (const unsigned*)(list + pos) : (const unsigned*)(listg + pos);
        __builtin_amdgcn_global_load_lds(src, (PG8_LAS unsigned*)(lds + PRE_OFF + (wid >> 2) * 1024 + (wid & 3) * 256), 4, 0, 0);
    }
    __device__ __forceinline__ void operator()(const f32x4 (&acc)[2][2][4][2], const GUnit& u, PG8_LAS unsigned char* lds, int wr, int wc, int fr_, int fq_) const {
        int fr = fr_, fq = fq_; asm volatile("" : "+v"(fr), "+v"(fq));
        const int nvalid = (int)cntl[u.e] - u.lt * BM; const int c0 = u.pn * BM + wc * 64 + 16 * fq;
        f32x4 bv[2][2];
#pragma unroll
        for (int bj = 0; bj < 2; ++bj)
#pragma unroll
            for (int n = 0; n < 2; ++n) bv[bj][n] = *(const f32x4*)(bd + u.e * D + c0 + 8 * bj + 4 * n);
#pragma unroll
        for (int ai = 0; ai < 2; ++ai)
#pragma unroll
            for (int m = 0; m < 4; ++m) {
                const int rl = ai * HALF + wr * 64 + m * 16 + fr;
                if (rl < nvalid) {
                    const int id = *(const PG8_LAS int*)(lds + PRE_OFF + rl * 4); const float gv = 16.0f * *(const PG8_LAS float*)(lds + PRE_OFF + 1024 + rl * 4);
                    int w[4];
#pragma unroll
                    for (int bj = 0; bj < 2; ++bj)
#pragma unroll
                        for (int n = 0; n < 2; ++n) { const f32x4 v = (acc[ai][bj][m][n] + bv[bj][n]) * gv; int t = 0;
                            t = __builtin_amdgcn_cvt_pk_fp8_f32(v[0], v[1], t, false); t = __builtin_amdgcn_cvt_pk_fp8_f32(v[2], v[3], t, true); w[2 * bj + n] = t; }
                    st16_wt<WT_EPI>(Y + (size_t)id * D + c0, (u32x4){(unsigned)w[0], (unsigned)w[1], (unsigned)w[2], (unsigned)w[3]});
                }
            }
    }
};

struct MoeSchedM {
    const PG8_LAS unsigned* P; const PG8_LAS unsigned* cntl; const PG8_LAS unsigned char* te;
    const int* list; unsigned* ready; unsigned* tmo; unsigned char* ws; int G, vcu;
    static constexpr int A_AUX = 16;
    __device__ __forceinline__ bool next(int i, GUnit& u) const {
        const unsigned L = (unsigned)i * (unsigned)G + (unsigned)vcu; const unsigned tot = (unsigned)__builtin_amdgcn_readfirstlane((int)P[NE]);
        unsigned mt;
        if (L < tot * 8u) { u.kind = 0; mt = L >> 3; u.pn = (int)(L & 7u); }
        else { const unsigned L2 = L - tot * 8u; if (L2 >= tot * 4u) return false; u.kind = 1; mt = L2 >> 2; u.pn = (int)(L2 & 3u); }
        const int e = __builtin_amdgcn_readfirstlane((int)te[mt]);
        u.pm = (int)mt; u.e = e; u.lt = (int)(mt - (unsigned)__builtin_amdgcn_readfirstlane((int)P[e])); return true;
    }
    __device__ __forceinline__ void aoffs_issue(const GUnit& u, int tid, unsigned (&raw)[2][2]) const {
        const int n = (int)cntl[u.e] - u.lt * BM;
#pragma unroll
        for (int i = 0; i < 2; ++i) { int R, C; stage_rc(tid * 16 + i * 8192, R, C);
#pragma unroll
            for (int h = 0; h < 2; ++h) { const int rr = h * HALF + R;
                if (u.kind == 0) { raw[h][i] = 0u; if (rr < n) raw[h][i] = (unsigned)list[(size_t)u.e * T + u.lt * BM + rr]; }
                else raw[h][i] = (unsigned)(u.pm * BM + rr); } }
    }
    __device__ __forceinline__ void aoffs_finish(const GUnit& u, int tid, const unsigned (&raw)[2][2], unsigned (&ao)[2][2]) const {
#pragma unroll
        for (int i = 0; i < 2; ++i) { int R, C; stage_rc(tid * 16 + i * 8192, R, C);
#pragma unroll
            for (int h = 0; h < 2; ++h) ao[h][i] = (u.kind == 0 ? (unsigned)WS_X1B + (raw[h][i] >> 2) * 1024u : (unsigned)WS_H + raw[h][i] * 1024u) + 2u * (unsigned)C; }
    }
    __device__ __forceinline__ const char* bbase(const GUnit& u) const {
        return (const char*)ws + (u.kind == 0 ? WS_BT1 + (size_t)u.e * 2048 * 1024 : WS_BT2 + (size_t)u.e * 1024 * 1024) + (size_t)u.pn * BM * 1024; }
    __device__ __forceinline__ void wait_ready(const GUnit& u, int lane) const {
        if (u.kind == 0) return;
        unsigned* p = ready + 64 * u.pm; unsigned sp = 0;
        while ((unsigned)__builtin_amdgcn_readfirstlane((int)__hip_atomic_load(p, __ATOMIC_RELAXED, __HIP_MEMORY_SCOPE_AGENT)) < 64u) {
            __builtin_amdgcn_s_sleep(2);
            if (++sp > (1u << 20)) { if (lane == 0) __hip_atomic_store(tmo, 0x6000u | (unsigned)u.pm, __ATOMIC_RELAXED, __HIP_MEMORY_SCOPE_AGENT); break; }
        }
    }
    __device__ __forceinline__ void publish(const GUnit& u, int lane) const {
        if (u.kind == 0 && lane == 0) __hip_atomic_fetch_add(ready + 64 * u.pm, 1u, __ATOMIC_RELAXED, __HIP_MEMORY_SCOPE_AGENT);
    }
};
struct EpiMoeM {
    static constexpr bool MID = false; static constexpr int SC_W = 0x7A7A7A7A, SC_A = 0x7F7F7F7F;
    EpiMoe1 e1; EpiMoe2 e2;
    __device__ __forceinline__ int sc_a(const GUnit& u) const { return u.kind ? EpiMoe2::SC_A : EpiMoe1::SC_A; }
    __device__ __forceinline__ void prefetch(PG8_LAS unsigned char* lds, const GUnit& u, int wid, int lane) const { if (u.kind) e2.prefetch(lds, u, wid, lane); else e1.prefetch(lds, u, wid, lane); }
    __device__ __forceinline__ void operator()(const f32x4 (&acc)[2][2][4][2], const GUnit& u, PG8_LAS unsigned char* lds, int wr, int wc, int fr, int fq) const {
        if (u.kind) e2(acc, u, lds, wr, wc, fr, fq); else e1(acc, u, lds, wr, wc, fr, fq);
    }
};
}
namespace attn_body {
using bf16 = __hip_bfloat16;
using bf16x8 = __attribute__((ext_vector_type(8))) short;
using s16x4 = __attribute__((ext_vector_type(4))) short;
using f32x16 = __attribute__((ext_vector_type(16))) float;
using u32x4 = __attribute__((ext_vector_type(4))) unsigned;
constexpr int SEQ = mk::S, D = 64, QP = 512, KP = 128, OP = 1024;
constexpr int NW = 8, QBLK = 32, QB = QBLK * NW, KVBLK = 64, NT = SEQ / KVBLK;
__device__ __forceinline__ int crow(int r, int hi) { return (r & 3) + 8 * (r >> 2) + 4 * hi; }
#define SBAR() __builtin_amdgcn_sched_barrier(0)
constexpr int NSLOT = 3, SLOTB = 8192;
constexpr int LDS_K = 0, LDS_V = NSLOT * SLOTB, LDS_WS = 2 * NSLOT * SLOTB, LDS_OST = LDS_WS + NW * 64 * 4, LDS_BYTES = LDS_OST + NW * 4096;
__device__ __forceinline__ void glds16(const void* gsrc, unsigned lds_dst) { unsigned keep;
    asm volatile("s_mov_b32 %0, m0\n\ts_mov_b32 m0, %2\n\ts_nop 0\n\tglobal_load_lds_dwordx4 %1, off\n\ts_mov_b32 m0, %0" : "=&s"(keep) : "v"(gsrc), "s"(lds_dst) : "memory"); }
__device__ __forceinline__ float max3f(float a, float b, float c) { float r; asm("v_max3_f32 %0, %1, %2, %3" : "=v"(r) : "v"(a), "v"(b), "v"(c)); return r; }
__device__ __forceinline__ float max2f(float a, float b) { float r; asm("v_max_f32_e32 %0, %1, %2" : "=v"(r) : "v"(a), "v"(b)); return r; }
__device__ __forceinline__ float fadd_s(float a, float b) { float r; asm("v_add_f32_e32 %0, %1, %2" : "=v"(r) : "v"(a), "v"(b)); return r; }
__device__ __forceinline__ float fsub_s(float a, float b) { float r; asm("v_sub_f32_e32 %0, %1, %2" : "=v"(r) : "v"(a), "v"(b)); return r; }
typedef float f32x2_t __attribute__((ext_vector_type(2))); typedef __bf16 bf16x2_t __attribute__((ext_vector_type(2)));
__device__ __forceinline__ unsigned cvtpk_s(float lo, float hi) { f32x2_t v = {lo, hi}; bf16x2_t b = __builtin_convertvector(v, bf16x2_t); return __builtin_bit_cast(unsigned, b); }
#define WAIT_BAR(N) asm volatile("s_waitcnt vmcnt(" #N ") lgkmcnt(0)\n\ts_barrier" ::: "memory")

__device__ __forceinline__ void qkt(f32x16& p0, f32x16& p1, const char* Kslot, const bf16x8* qr, const f32x16& negm, int r32, int hi) {
    const char* kb = Kslot + hi * 1024 + r32 * 16;
#pragma unroll
    for (int d0 = 0; d0 < 4; ++d0) {
        const bf16x8 b0 = *reinterpret_cast<const bf16x8*>(kb + d0 * 2048);
        const bf16x8 b1 = *reinterpret_cast<const bf16x8*>(kb + d0 * 2048 + 512);
        if (d0 == 0) { p0 = __builtin_amdgcn_mfma_f32_32x32x16_bf16(b0, qr[0], negm, 0, 0, 0); p1 = __builtin_amdgcn_mfma_f32_32x32x16_bf16(b1, qr[0], negm, 0, 0, 0); }
        else { p0 = __builtin_amdgcn_mfma_f32_32x32x16_bf16(b0, qr[d0], p0, 0, 0, 0); p1 = __builtin_amdgcn_mfma_f32_32x32x16_bf16(b1, qr[d0], p1, 0, 0, 0); } }
}
typedef __attribute__((address_space(3))) const char* lds_cptr;
typedef short v4i16_t __attribute__((ext_vector_type(4)));
__device__ __forceinline__ void kload8(bf16x8* kf, lds_cptr kp) {
    kf[0] = *(const __attribute__((address_space(3))) bf16x8*)(kp);        kf[1] = *(const __attribute__((address_space(3))) bf16x8*)(kp + 512);
    kf[2] = *(const __attribute__((address_space(3))) bf16x8*)(kp + 2048); kf[3] = *(const __attribute__((address_space(3))) bf16x8*)(kp + 2560);
    kf[4] = *(const __attribute__((address_space(3))) bf16x8*)(kp + 4096); kf[5] = *(const __attribute__((address_space(3))) bf16x8*)(kp + 4608);
    kf[6] = *(const __attribute__((address_space(3))) bf16x8*)(kp + 6144); kf[7] = *(const __attribute__((address_space(3))) bf16x8*)(kp + 6656);
}
__device__ __forceinline__ void kload2(bf16x8* kf, lds_cptr kp, int j) { kf[2 * j] = *(const __attribute__((address_space(3))) bf16x8*)(kp + j * 2048); kf[2 * j + 1] = *(const __attribute__((address_space(3))) bf16x8*)(kp + j * 2048 + 512); }
__device__ __forceinline__ s16x4 vtr(lds_cptr p) { return __builtin_bit_cast(s16x4, __builtin_amdgcn_ds_read_tr16_b64_v4i16((__attribute__((address_space(3))) v4i16_t*)p)); }
__device__ __forceinline__ float rowmax(const f32x16& p0, const f32x16& p1) {
    float a = max3f(p0[0], p0[1], p1[0]), b = max3f(p0[2], p0[3], p1[1]); a = max3f(a, p1[2], p1[3]);
#pragma unroll
    for (int r = 4; r < 16; r += 4) { a = max3f(a, p0[r], p0[r + 1]); b = max3f(b, p0[r + 2], p0[r + 3]); a = max3f(a, p1[r], p1[r + 1]); b = max3f(b, p1[r + 2], p1[r + 3]); }
    const float m = max2f(a, b);
    auto rr = __builtin_amdgcn_permlane32_swap(__float_as_uint(m), __float_as_uint(m), false, false);
    return max2f(__uint_as_float(rr[0]), __uint_as_float(rr[1]));
}
__device__ __forceinline__ void pv(f32x16* o, int vb, bf16x8 pa0, bf16x8 pa1, bf16x8 pa2, bf16x8 pa3) {
#pragma unroll
    for (int d0 = 0; d0 < 2; ++d0) { s16x4 lo[4], hi[4];
#pragma unroll
        for (int ks = 0; ks < 4; ++ks) {
            asm volatile("ds_read_b64_tr_b16 %0,%1 offset:%c2" : "=&v"(lo[ks]) : "v"(vb), "i"(d0 * 4096 + ks * 1024) : "memory");
            asm volatile("ds_read_b64_tr_b16 %0,%1 offset:%c2" : "=&v"(hi[ks]) : "v"(vb), "i"(d0 * 4096 + ks * 1024 + 512) : "memory"); }
        asm volatile("s_waitcnt lgkmcnt(0)" ::: "memory"); SBAR();
#define PK(k) (bf16x8){lo[k][0], lo[k][1], lo[k][2], lo[k][3], hi[k][0], hi[k][1], hi[k][2], hi[k][3]}
        o[d0] = __builtin_amdgcn_mfma_f32_32x32x16_bf16(pa0, PK(0), o[d0], 0, 0, 0);
        o[d0] = __builtin_amdgcn_mfma_f32_32x32x16_bf16(pa1, PK(1), o[d0], 0, 0, 0);
        o[d0] = __builtin_amdgcn_mfma_f32_32x32x16_bf16(pa2, PK(2), o[d0], 0, 0, 0);
        o[d0] = __builtin_amdgcn_mfma_f32_32x32x16_bf16(pa3, PK(3), o[d0], 0, 0, 0);
#undef PK
    }
}

template <int THRL, bool FIXREF> __device__ __forceinline__ void attn_unit(int b, int h, int qb, const bf16* Q, const bf16* __restrict__ K, const bf16* __restrict__ V, bf16* O, float* SSQ, char* shm, float mref) {
    int tid_ = threadIdx.x; asm volatile("" : "+v"(tid_));
    const int tid = tid_, lane = tid & 63, r32 = lane & 31, hi = lane >> 5; const int wid = __builtin_amdgcn_readfirstlane(tid >> 6);
    const long rowbase = (long)b * SEQ; const int q0 = qb * QB; const int kvh = h >> 2;
    const bf16* Qw = Q + (rowbase + q0 + wid * QBLK) * QP + h * D;
    const bf16 *Kh = K + rowbase * KP + kvh * D, *Vh = V + rowbase * KP + kvh * D;
    const unsigned lds0 = (unsigned)(uintptr_t)shm;
    float* wsf = (float*)(shm + LDS_WS) + wid * 64;
    const bf16* ksrc = Kh + (long)lane * KP + wid * 8;
    const bf16* vsrc = Vh + (long)(16 * (wid & 3) + (lane >> 2)) * KP + (wid >> 2) * 32 + (lane & 3) * 8;
    const unsigned kdst = lds0 + LDS_K + wid * 1024, vdst = lds0 + LDS_V + wid * 1024;
#define DMA_K(t, slot) glds16(ksrc + (long)(t) * KVBLK * KP, (unsigned)__builtin_amdgcn_readfirstlane(kdst + (slot)))
#define DMA_V(t, slot) glds16(vsrc + (long)(t) * KVBLK * KP, (unsigned)__builtin_amdgcn_readfirstlane(vdst + (slot)))
    const int vb0 = (int)(lds0 + LDS_V) + ((lane >> 4) & 1) * 32 + (lane & 3) * 8 + (4 * hi + ((lane & 15) >> 2)) * 64;
    const char* Kbase = shm + LDS_K; bf16x8 kf[8];
    const lds_cptr shm3 = (lds_cptr)shm; const lds_cptr kp0 = shm3 + LDS_K + hi * 1024 + r32 * 16; const lds_cptr vp0 = shm3 + LDS_V + ((lane >> 4) & 1) * 32 + (lane & 3) * 8 + (4 * hi + ((lane & 15) >> 2)) * 64;
    DMA_K(0, 0); DMA_V(0, 0); DMA_K(1, SLOTB);
    bf16x8 qr[4];
#pragma unroll
    for (int d0 = 0; d0 < 4; ++d0) qr[d0] = __builtin_nontemporal_load(reinterpret_cast<const bf16x8*>(&Qw[(long)r32 * QP + d0 * 16 + hi * 8]));
    float mhat = 0.f, l_reg = 0.f; f32x16 o[2]; o[0] = f32x16{}; o[1] = f32x16{}; f32x16 negm = f32x16{}; asm volatile("" : "+v"(negm));
    bool resc = false;
#define START(P0, P1) do { const float rm = FIXREF ? mref : rowmax(P0, P1); resc = false; \
    { const float dl = rm; mhat = fadd_s(mhat, dl); \
      _Pragma("unroll") for (int r = 0; r < 16; ++r) { P0[r] = fsub_s(P0[r], dl); P1[r] = fsub_s(P1[r], dl); } \
      _Pragma("unroll") for (int r = 0; r < 16; ++r) negm[r] = -mhat; asm volatile("" : "+v"(negm)); } \
    _Pragma("unroll") for (int r = 0; r < 16; ++r) P0[r] = __builtin_amdgcn_exp2f(P0[r]); } while (0)
#define RESC() do { if (!FIXREF && resc) { asm volatile("s_waitcnt lgkmcnt(0)" ::: "memory"); \
      _Pragma("unroll") for (int d_ = 0; d_ < 2; ++d_) _Pragma("unroll") for (int r = 0; r < 16; ++r) o[d_][r] *= wsf[crow(r, hi)]; } } while (0)
    f32x16 pA0, pA1, pB0, pB1;
    int sl_prev = 0, sl_cur = 0, sl_next = SLOTB;
#define ROT() do { sl_prev = sl_cur; sl_cur = sl_next; sl_next = (sl_next == (NSLOT - 1) * SLOTB) ? 0 : sl_next + SLOTB; } while (0)
    DMA_K(2, 2 * SLOTB);
    WAIT_BAR(3);
    qkt(pA0, pA1, Kbase, qr, negm, r32, hi); asm volatile("s_nop 15\n\ts_nop 7" : "+v"(pA0), "+v"(pA1));
    START(pA0, pA1);
    _Pragma("unroll") for (int r = 0; r < 16; ++r) pA1[r] = __builtin_amdgcn_exp2f(pA1[r]);
    WAIT_BAR(0);
    DMA_K(3, 0); DMA_V(1, SLOTB);
    ROT();
    kload8(kf, kp0 + sl_cur);
    WAIT_BAR(2);
    s16x4 vlo[8], vhi[8]; u32x4 pw0, pw1, pw2, pw3;
#define PKW(P, B) cvtpk_s(P[B], P[B + 1])
#define PAF(k) __builtin_bit_cast(bf16x8, pw##k)
#define VFR(i) (bf16x8){vlo[i][0], vlo[i][1], vlo[i][2], vlo[i][3], vhi[i][0], vhi[i][1], vhi[i][2], vhi[i][3]}
#define PIN(x) asm volatile("" : "+v"(x))
#define MX3(a, b, c) __builtin_fmaxf(__builtin_fmaxf((a), (b)), (c))
#define GAPA(MF, A0, A1, A2, A3, W0, W1, PW) do { MF; sacc += A0; sacc += A1; sacc += A2; sacc += A3; PIN(sacc); W0; W1; PIN(PW); SBAR(); } while (0)
#define EX(v) __builtin_amdgcn_exp2f(v)
#define GAPB(MF, X, B) do { MF; X[B] = EX(X[B]); X[B + 1] = EX(X[B + 1]); X[B + 2] = EX(X[B + 2]); X[B + 3] = EX(X[B + 3]); PIN(X); SBAR(); } while (0)
#define VRD(i) do { vlo[i] = vtr(vp_ + (((i) >> 2) * 4096 + ((i) & 3) * 1024)); vhi[i] = vtr(vp_ + (((i) >> 2) * 4096 + ((i) & 3) * 1024 + 512)); } while (0)
#define KRD(G, j) do { if (G) { kload2(kf, kp0 + sl_next, j); SBAR(); } } while (0)
#define STEP(C0, C1, P0, P1, t, GK, GV, GL) do { SBAR(); \
    const lds_cptr vp_ = vp0 + sl_prev; \
    VRD(0); SBAR(); float sacc = (P0[0] + P0[1]); \
    GAPA(C0 = __builtin_amdgcn_mfma_f32_32x32x16_bf16(kf[0], qr[0], negm, 0, 0, 0), P0[2], P0[3], P0[4], P0[5],     pw0[0] = PKW(P0, 0), pw0[1] = PKW(P0, 2), pw0); \
    VRD(4); SBAR(); GAPA(C1 = __builtin_amdgcn_mfma_f32_32x32x16_bf16(kf[1], qr[0], negm, 0, 0, 0), P0[6], P0[7], P0[8], P0[9],     pw0[2] = PKW(P0, 4), pw0[3] = PKW(P0, 6), pw0); \
    VRD(1); SBAR(); GAPA(C0 = __builtin_amdgcn_mfma_f32_32x32x16_bf16(kf[2], qr[1], C0, 0, 0, 0),   P0[10], P0[11], P0[12], P0[13], pw1[0] = PKW(P0, 8), pw1[1] = PKW(P0, 10), pw1); \
    VRD(5); SBAR(); GAPA(C1 = __builtin_amdgcn_mfma_f32_32x32x16_bf16(kf[3], qr[1], C1, 0, 0, 0),   P0[14], P0[15], P1[0], P1[1],   pw1[2] = PKW(P0, 12), pw1[3] = PKW(P0, 14), pw1); \
    VRD(2); SBAR(); GAPA(C0 = __builtin_amdgcn_mfma_f32_32x32x16_bf16(kf[4], qr[2], C0, 0, 0, 0),   P1[2], P1[3], P1[4], P1[5],     pw2[0] = PKW(P1, 0), pw2[1] = PKW(P1, 2), pw2); \
    VRD(6); SBAR(); GAPA(C1 = __builtin_amdgcn_mfma_f32_32x32x16_bf16(kf[5], qr[2], C1, 0, 0, 0),   P1[6], P1[7], P1[8], P1[9],     pw2[2] = PKW(P1, 4), pw2[3] = PKW(P1, 6), pw2); \
    VRD(3); SBAR(); GAPA(C0 = __builtin_amdgcn_mfma_f32_32x32x16_bf16(kf[6], qr[3], C0, 0, 0, 0),   P1[10], P1[11], P1[12], P1[13], pw3[0] = PKW(P1, 8), pw3[1] = PKW(P1, 10), pw3); \
    VRD(7); SBAR(); GAPA(C1 = __builtin_amdgcn_mfma_f32_32x32x16_bf16(kf[7], qr[3], C1, 0, 0, 0),   P1[14], P1[15], 0.f, 0.f,       pw3[2] = PKW(P1, 12), pw3[3] = PKW(P1, 14), pw3); \
    l_reg += sacc; \
    if (GK) { DMA_K((t) + 3, sl_cur); } if (GV) { DMA_V((t) + 1, sl_next); } \
    if constexpr (!FIXREF) { float a = MX3(C0[0], C0[1], C1[0]), b = MX3(C0[2], C0[3], C1[1]); a = MX3(a, C1[2], C1[3]); \
      _Pragma("unroll") for (int r = 4; r < 16; r += 4) { a = MX3(a, C0[r], C0[r + 1]); b = MX3(b, C0[r + 2], C0[r + 3]); a = MX3(a, C1[r], C1[r + 1]); b = MX3(b, C1[r + 2], C1[r + 3]); } \
      float rm = __builtin_fmaxf(a, b); { auto rr = __builtin_amdgcn_permlane32_swap(__float_as_uint(rm), __float_as_uint(rm), false, false); rm = __builtin_fmaxf(__uint_as_float(rr[0]), __uint_as_float(rr[1])); } \
      resc = false; \
      if (__builtin_expect(__any(rm > (float)THRL), 0)) { const float dl = __builtin_fmaxf(rm, 0.f); mhat += dl; \
        _Pragma("unroll") for (int r = 0; r < 16; ++r) { C0[r] -= dl; C1[r] -= dl; } \
        _Pragma("unroll") for (int r = 0; r < 16; ++r) negm[r] = -mhat; asm volatile("" : "+v"(negm)); \
        const float f = __builtin_amdgcn_exp2f(-dl); l_reg *= f; if (hi == 0) wsf[r32] = f; resc = true; } } \
    SBAR(); \
    GAPB(o[0] = __builtin_amdgcn_mfma_f32_32x32x16_bf16(PAF(0), VFR(0), o[0], 0, 0, 0), C0, 0); \
    GAPB(o[1] = __builtin_amdgcn_mfma_f32_32x32x16_bf16(PAF(0), VFR(4), o[1], 0, 0, 0), C0, 4); \
    KRD(GL, 0); GAPB(o[0] = __builtin_amdgcn_mfma_f32_32x32x16_bf16(PAF(1), VFR(1), o[0], 0, 0, 0), C0, 8); \
    KRD(GL, 1); GAPB(o[1] = __builtin_amdgcn_mfma_f32_32x32x16_bf16(PAF(1), VFR(5), o[1], 0, 0, 0), C0, 12); \
    KRD(GL, 2); GAPB(o[0] = __builtin_amdgcn_mfma_f32_32x32x16_bf16(PAF(2), VFR(2), o[0], 0, 0, 0), C1, 0); \
    KRD(GL, 3); GAPB(o[1] = __builtin_amdgcn_mfma_f32_32x32x16_bf16(PAF(2), VFR(6), o[1], 0, 0, 0), C1, 4); \
    GAPB(o[0] = __builtin_amdgcn_mfma_f32_32x32x16_bf16(PAF(3), VFR(3), o[0], 0, 0, 0), C1, 8); \
    GAPB(o[1] = __builtin_amdgcn_mfma_f32_32x32x16_bf16(PAF(3), VFR(7), o[1], 0, 0, 0), C1, 12); \
    } while (0)
    int t = 1;
    for (; t + 5 < NT; t += 2) {
        STEP(pB0, pB1, pA0, pA1, t, true, true, true);     WAIT_BAR(2); RESC(); ROT();
        STEP(pA0, pA1, pB0, pB1, t + 1, true, true, true); WAIT_BAR(2); RESC(); ROT();
    }
#define ENDW(tt) do { if ((tt) + 3 < NT) { WAIT_BAR(2); } else if ((tt) + 2 < NT) { WAIT_BAR(1); } else { WAIT_BAR(0); } } while (0)
    for (; t + 1 < NT; t += 2) {
        STEP(pB0, pB1, pA0, pA1, t, (t + 3 < NT), (t + 1 < NT), (t + 1 < NT));         ENDW(t);     RESC(); ROT();
        STEP(pA0, pA1, pB0, pB1, t + 1, (t + 4 < NT), (t + 2 < NT), (t + 2 < NT));     ENDW(t + 1); RESC(); ROT();
    }
    STEP(pB0, pB1, pA0, pA1, NT - 1, false, false, false); RESC();
    { float sacc = pB0[0] + pB0[1]; _Pragma("unroll") for (int r = 2; r < 16; ++r) sacc += pB0[r]; _Pragma("unroll") for (int r = 0; r < 16; ++r) sacc += pB1[r]; l_reg += sacc;
      pw0 = (u32x4){PKW(pB0, 0), PKW(pB0, 2), PKW(pB0, 4), PKW(pB0, 6)}; pw1 = (u32x4){PKW(pB0, 8), PKW(pB0, 10), PKW(pB0, 12), PKW(pB0, 14)}; pw2 = (u32x4){PKW(pB1, 0), PKW(pB1, 2), PKW(pB1, 4), PKW(pB1, 6)}; pw3 = (u32x4){PKW(pB1, 8), PKW(pB1, 10), PKW(pB1, 12), PKW(pB1, 14)};
      SBAR(); pv(o, vb0 + sl_cur, PAF(0), PAF(1), PAF(2), PAF(3)); }
#undef PKW
#undef PAF
#undef VFR
#undef PIN
#undef MX3
#undef GAPA
#undef GAPB
#undef EX
#undef VRD
#undef KRD
#undef STEP
#undef ENDW
    { auto rr = __builtin_amdgcn_permlane32_swap(__float_as_uint(l_reg), __float_as_uint(l_reg), false, false); l_reg = __uint_as_float(rr[0]) + __uint_as_float(rr[1]); }
    if (hi == 0) wsf[32 + r32] = l_reg; asm volatile("s_waitcnt lgkmcnt(0)" ::: "memory");
    float rli[16];
#pragma unroll
    for (int r = 0; r < 16; ++r) rli[r] = __builtin_amdgcn_rcpf(wsf[32 + crow(r, hi)]);
    const long orow0 = rowbase + q0 + wid * QBLK;
    bf16* Ow = O + orow0 * OP + h * D;
    { bf16* stg = (bf16*)(shm + LDS_OST) + wid * 2048;
#pragma unroll
      for (int r = 0; r < 16; ++r) { const int orow = crow(r, hi);
#pragma unroll
          for (int d0 = 0; d0 < 2; ++d0) stg[orow * 64 + d0 * 32 + r32] = __float2bfloat16(o[d0][r] * rli[r]); }
      asm volatile("s_waitcnt lgkmcnt(0)" ::: "memory");
#pragma unroll
      for (int i = 0; i < 4; ++i) { const int row = i * 8 + (lane >> 3), ch = lane & 7; const u32x4 v = *(const u32x4*)(stg + row * 64 + ch * 8); mk::st16_wt<WT_EPI>(Ow + (long)row * OP + ch * 8, v);
          float ss = 0.f;
#pragma unroll
          for (int k = 0; k < 4; ++k) { const float lo = __uint_as_float(v[k] << 16), hi2 = __uint_as_float(v[k] & 0xffff0000u); ss += lo * lo + hi2 * hi2; }
          ss += __shfl_xor(ss, 1); ss += __shfl_xor(ss, 2); ss += __shfl_xor(ss, 4);
          if (ch == 0) SSQ[(orow0 + row) * 8 + h] = ss; } }
    asm volatile("s_waitcnt lgkmcnt(0)\n\ts_barrier" ::: "memory");
#undef DMA_K
#undef DMA_V
#undef START
#undef RESC
#undef ROT
}
#undef SBAR
#undef WAIT_BAR
}
namespace lru {
using namespace mk;
#define LLAS __attribute__((address_space(3)))
typedef short bf16x8 __attribute__((ext_vector_type(8)));
typedef float f32x16 __attribute__((ext_vector_type(16)));
typedef float f32x4 __attribute__((ext_vector_type(4)));
typedef float f32x2 __attribute__((ext_vector_type(2)));
typedef unsigned u32x4 __attribute__((ext_vector_type(4)));
constexpr int XPITCH = 144, HPITCH = 272;
constexpr int WAVE_BYTES = 64 * HPITCH;
constexpr int CW_OFF = 9728;
constexpr int PART_OFF = 8 * WAVE_BYTES;
constexpr int LDS_NEED = PART_OFF + 2048;
constexpr float LOG2E = 1.4426950408889634f, LN2 = 0.6931471805599453f;

struct Params { const bf16_t* LX; const bf16_t* LG; const float *cw, *cb, *ba, *bi, *lam, *gain; const bf16_t* WL; f32x2* SUMS; bf16_t* MIX; unsigned* AB; };

using mk::st16_wt;
__device__ __forceinline__ unsigned cvtpk(float lo, float hi) { unsigned r; asm volatile("v_cvt_pk_bf16_f32 %0, %1, %2" : "=v"(r) : "v"(lo), "v"(hi)); return r; }

__device__ __forceinline__ void build_xc(const Params& P, LLAS unsigned char* wl, int b, int c, int n, int lane, bf16x8 (&xcA)[2][4]) {
    const bf16_t* LXb = P.LX + (size_t)b * S * LW + 64 * n;
#pragma unroll
    for (int it = 0; it < 9; ++it) {
        const int rr = (lane >> 3) + 8 * it;
        if (rr < 67) { const int s = 64 * c - 2 + rr; u32x4 v = (u32x4){0u, 0u, 0u, 0u};
            if (s >= 0 && s < S) v = __builtin_nontemporal_load((const u32x4*)(LXb + (size_t)s * LW + 8 * (lane & 7)));
            *(LLAS u32x4*)(wl + rr * XPITCH + 16 * (lane & 7)) = v; }
    }
    LLAS float* cwl = (LLAS float*)(wl + CW_OFF);
#pragma unroll
    for (int j = 0; j < 4; ++j) cwl[j * 64 + lane] = P.cw[j * LW + 64 * n + lane];
    cwl[4 * 64 + lane] = P.cb[64 * n + lane];
    const int i = lane & 31, hi = lane >> 5;
#pragma unroll
    for (int ks = 0; ks < 4; ++ks) {
        const int cb0 = 16 * ks + 8 * hi;
        f32x4 w[5][2];
#pragma unroll
        for (int j = 0; j < 5; ++j) { w[j][0] = *(const LLAS f32x4*)(cwl + j * 64 + cb0); w[j][1] = *(const LLAS f32x4*)(cwl + j * 64 + cb0 + 4); }
#pragma unroll
        for (int mt = 0; mt < 2; ++mt) {
            f32x4 a0 = w[4][0], a1 = w[4][1];
#pragma unroll
            for (int j = 0; j < 4; ++j) {
                const u32x4 xv = *(const LLAS u32x4*)(wl + (32 * mt + i + j) * XPITCH + cb0 * 2);
                f32x4 x0, x1;
                x0[0] = __uint_as_float(xv[0] << 16); x0[1] = __uint_as_float(xv[0] & 0xffff0000u); x0[2] = __uint_as_float(xv[1] << 16); x0[3] = __uint_as_float(xv[1] & 0xffff0000u);
                x1[0] = __uint_as_float(xv[2] << 16); x1[1] = __uint_as_float(xv[2] & 0xffff0000u); x1[2] = __uint_as_float(xv[3] << 16); x1[3] = __uint_as_float(xv[3] & 0xffff0000u);
                a0 += x0 * w[j][0]; a1 += x1 * w[j][1];
            }
            u32x4 pk; pk[0] = cvtpk(a0[0], a0[1]); pk[1] = cvtpk(a0[2], a0[3]); pk[2] = cvtpk(a1[0], a1[1]); pk[3] = cvtpk(a1[2], a1[3]);
            xcA[mt][ks] = __builtin_bit_cast(bf16x8, pk);
        }
    }
}
__device__ __forceinline__ bf16x8 ident_frag(int ks, int nh, int r32, int hi) {
    const int jj = 32 * nh + r32 - 16 * ks - 8 * hi; bf16x8 f;
#pragma unroll
    for (int j = 0; j < 8; ++j) f[j] = (j == jj) ? (short)0x3F80 : (short)0;
    return f;
}
__device__ __forceinline__ void gate_ab(f32x16& ra, f32x16& ri, const f32x16& xc, float ba, float bi, float c1, unsigned* ab  ) {
    u32x4 pk4;
    const float nba = -ba * LOG2E, nbi = -bi * LOG2E;
#pragma unroll
    for (int r = 0; r < 16; ++r) {
        const float rg = __builtin_amdgcn_rcpf(1.0f + __builtin_amdgcn_exp2f(fmaf(ra[r], -LOG2E, nba)));
        const float ig = __builtin_amdgcn_rcpf(1.0f + __builtin_amdgcn_exp2f(fmaf(ri[r], -LOG2E, nbi)));
        const unsigned yb = cvtpk(0.0f, c1 * rg);
        const float a = __builtin_amdgcn_exp2f(__uint_as_float(yb));
        const float em = fmaf(-a, a, 1.0f);
        const unsigned bb = cvtpk(__builtin_amdgcn_sqrtf(em) * ig * xc[r], 0.0f);
        pk4[r & 3] = yb | bb; if ((r & 3) == 3) st16_wt(ab + (r >> 2) * 256, pk4);
        ra[r] = a; ri[r] = __uint_as_float(bb << 16);
    }
}
__device__ __forceinline__ float xhalf(float x, int hi) {
    const auto r = __builtin_amdgcn_permlane32_swap(__float_as_uint(x), __float_as_uint(x), false, false);
    return __uint_as_float(hi ? r[0] : r[1]);
}
template <bool ST> __device__ __forceinline__ void scan_fwd(const f32x16& a, const f32x16& b, float& h, float& Aprod, LLAS unsigned char* hs  , int hi) {
    float Ag[4], Bg[4], pA[4], pB[4];
#pragma unroll
    for (int g = 0; g < 4; ++g) { float A = a[4 * g], B = b[4 * g];
#pragma unroll
        for (int e = 1; e < 4; ++e) { B = fmaf(a[4 * g + e], B, b[4 * g + e]); A *= a[4 * g + e]; }
        Ag[g] = A; Bg[g] = B; pA[g] = xhalf(A, hi); pB[g] = xhalf(B, hi); }
    float ap = 1.0f;
#pragma unroll
    for (int g = 0; g < 4; ++g) {
        const float A1 = hi ? pA[g] : Ag[g], B1 = hi ? pB[g] : Bg[g], A2 = hi ? Ag[g] : pA[g], B2 = hi ? Bg[g] : pB[g];
        const float h1 = fmaf(A1, h, B1); float x = hi ? h1 : h; h = fmaf(A2, h1, B2); ap *= A1 * A2;
        if constexpr (ST) {
#pragma unroll
            for (int e = 0; e < 4; ++e) { x = fmaf(a[4 * g + e], x, b[4 * g + e]); *(LLAS float*)(hs + (8 * g + 4 * hi + e) * HPITCH) = x; } }
    }
    Aprod = ap;
}
template <bool ST> __device__ __forceinline__ void scan_bwd(const f32x16& a, const f32x16& b, float& h, float& Aprod, LLAS unsigned char* hs, int hi) {
    float Ag[4], Bg[4], pA[4], pB[4];
#pragma unroll
    for (int g = 0; g < 4; ++g) { float A = a[4 * g + 3], B = b[4 * g + 3];
#pragma unroll
        for (int e = 2; e >= 0; --e) { B = fmaf(a[4 * g + e], B, b[4 * g + e]); A *= a[4 * g + e]; }
        Ag[g] = A; Bg[g] = B; pA[g] = xhalf(A, hi); pB[g] = xhalf(B, hi); }
    float ap = 1.0f;
#pragma unroll
    for (int g = 3; g >= 0; --g) {
        const float A1 = hi ? Ag[g] : pA[g], B1 = hi ? Bg[g] : pB[g], A2 = hi ? pA[g] : Ag[g], B2 = hi ? pB[g] : Bg[g];
        const float h1 = fmaf(A1, h, B1); float x = hi ? h : h1; h = fmaf(A2, h1, B2); ap *= A1 * A2;
        if constexpr (ST) {
#pragma unroll
            for (int e = 3; e >= 0; --e) { x = fmaf(a[4 * g + e], x, b[4 * g + e]); LLAS float* p = (LLAS float*)(hs + (8 * g + 4 * hi + e) * HPITCH); *p = *p + x; } }
    }
    Aprod = ap;
}
__device__ __forceinline__ void tile_ab(const bf16x8 (&xcA)[4], const bf16x8 (&Bf)[2][4], int nh, int r32, int hi, float ba, float bi, float c1, f32x16& a, f32x16& b, unsigned* ab) {
    f32x16 ra = f32x16{}, ri = f32x16{}, xc = f32x16{};
#pragma unroll
    for (int ks = 0; ks < 4; ++ks) { ra = __builtin_amdgcn_mfma_f32_32x32x16_bf16(xcA[ks], Bf[0][ks], ra, 0, 0, 0); ri = __builtin_amdgcn_mfma_f32_32x32x16_bf16(xcA[ks], Bf[1][ks], ri, 0, 0, 0); }
    if (nh == 0) { xc = __builtin_amdgcn_mfma_f32_32x32x16_bf16(xcA[0], ident_frag(0, 0, r32, hi), xc, 0, 0, 0); xc = __builtin_amdgcn_mfma_f32_32x32x16_bf16(xcA[1], ident_frag(1, 0, r32, hi), xc, 0, 0, 0); }
    else         { xc = __builtin_amdgcn_mfma_f32_32x32x16_bf16(xcA[2], ident_frag(2, 1, r32, hi), xc, 0, 0, 0); xc = __builtin_amdgcn_mfma_f32_32x32x16_bf16(xcA[3], ident_frag(3, 1, r32, hi), xc, 0, 0, 0); }
    gate_ab(ra, ri, xc, ba, bi, c1, ab);
    a = ra; b = ri;
}
__device__ __forceinline__ void load_bf(const Params& P, int n, int dir, int nh, int lane, bf16x8 (&Bf)[2][4]) {
#pragma unroll
    for (int q = 0; q < 2; ++q)
#pragma unroll
        for (int ks = 0; ks < 4; ++ks) Bf[q][ks] = *(const bf16x8*)(P.WL + ((((size_t)(n * 4 + dir * 2 + q) * 2 + nh) * 4 + ks) * 64 + lane) * 8);
}
__device__ __forceinline__ float softplus_neg(float lam) { const float L = -lam; return (L > 20.f) ? L : log1pf(expf(L)); }

__device__ __forceinline__ void lru_summaries(const Params& P, LLAS unsigned char* lds, int b, int c) {
    int tid_ = threadIdx.x; asm volatile("" : "+v"(tid_));
    const int tid = tid_, lane = tid & 63, r32 = lane & 31, hi = lane >> 5; const int n = __builtin_amdgcn_readfirstlane(tid >> 6);
    LLAS unsigned char* wl = lds + n * WAVE_BYTES;
    bf16x8 xcA[2][4];
    build_xc(P, wl, b, c, n, lane, xcA);
    bf16x8 Bf[2][4]; load_bf(P, n, 0, 0, lane, Bf);
#pragma unroll 1
    for (int it = 0; it < 4; ++it) {
        const int nh = it >> 1, dir = it & 1; const int ch = 64 * n + 32 * nh + r32;
        const float ba = P.ba[dir * LW + ch], bi = P.bi[dir * LW + ch], c1 = -8.0f * LOG2E * softplus_neg(P.lam[dir * LW + ch]);
        unsigned* abp = P.AB + ((((size_t)(b * NCH + c) * 8 + n) * 2 + nh) * 2 + dir) * 2048 + 4 * lane;
        f32x16 a0, b0, a1, b1;
        tile_ab(xcA[0], Bf, nh, r32, hi, ba, bi, c1, a0, b0, abp);
        tile_ab(xcA[1], Bf, nh, r32, hi, ba, bi, c1, a1, b1, abp + 1024);
        if (it < 3) load_bf(P, n, (it + 1) & 1, (it + 1) >> 1, lane, Bf);
        float A0, B0 = 0.f, A1, B1 = 0.f;
        if (dir == 0) { scan_fwd<false>(a0, b0, B0, A0, wl, hi); scan_fwd<false>(a1, b1, B1, A1, wl, hi); }
        else          { scan_bwd<false>(a0, b0, B0, A0, wl, hi); scan_bwd<false>(a1, b1, B1, A1, wl, hi); }
        const float Ac = A0 * A1, Bc = (dir == 0) ? fmaf(A1, B0, B1) : fmaf(A0, B1, B0);
        if (hi == 0) P.SUMS[((size_t)(b * 2 + dir) * NCH + c) * LW + ch] = (f32x2){Ac, Bc};
    }
}
constexpr int CARRY_OFF = 142336;
__device__ __forceinline__ void carries_to_lds(const f32x2* SUMS, LLAS unsigned char* lds, int b, int c, int tid) {
    const f32x2* sf = SUMS + (size_t)(b * 2 + 0) * NCH * LW + tid; const f32x2* sb = SUMS + (size_t)(b * 2 + 1) * NCH * LW + tid;
    float hf = 0.f, hb = 0.f;
    for (int c0 = 0; c0 < c; c0 += 16) { f32x2 v[16];
#pragma unroll
        for (int u = 0; u < 16; ++u) { const int cc = c0 + u; v[u] = sf[(size_t)(cc < c ? cc : c - 1) * LW]; if (cc >= c) v[u] = (f32x2){1.0f, 0.0f}; }
#pragma unroll
        for (int u = 0; u < 16; ++u) hf = fmaf(v[u][0], hf, v[u][1]); }
    for (int c0 = NCH - 1; c0 > c; c0 -= 16) { f32x2 v[16];
#pragma unroll
        for (int u = 0; u < 16; ++u) { const int cc = c0 - u; v[u] = sb[(size_t)(cc > c ? cc : c + 1) * LW]; if (cc <= c) v[u] = (f32x2){1.0f, 0.0f}; }
#pragma unroll
        for (int u = 0; u < 16; ++u) hb = fmaf(v[u][0], hb, v[u][1]); }
    LLAS float* cr = (LLAS float*)(lds + CARRY_OFF);
    cr[tid] = hf; cr[LW + tid] = hb;
}
__device__ __forceinline__ float gelu_tanh(float x) {
    const float u = 0.7978845608028654f * (x + 0.044715f * x * x * x);
    return x * __builtin_amdgcn_rcpf(1.0f + __builtin_amdgcn_exp2f(-2.0f * LOG2E * u));
}
__device__ __forceinline__ void lru_apply(const Params& P, LLAS unsigned char* lds, int b, int c) {
    int tid_ = threadIdx.x; asm volatile("" : "+v"(tid_));
    const int tid = tid_, lane = tid & 63, r32 = lane & 31, hi = lane >> 5; const int n = __builtin_amdgcn_readfirstlane(tid >> 6);
    LLAS unsigned char* wl = lds + n * WAVE_BYTES;
    u32x4 qa[4][4], qb[4][4];
    { const unsigned* abp = P.AB + ((size_t)(b * NCH + c) * 8 + n) * 8192 + 4 * lane;
#pragma unroll
      for (int dt = 0; dt < 4; ++dt)
#pragma unroll
          for (int g = 0; g < 4; ++g) { qa[dt][g] = __builtin_nontemporal_load((const u32x4*)(abp + dt * 1024 + g * 256)); qb[dt][g] = __builtin_nontemporal_load((const u32x4*)(abp + 4096 + dt * 1024 + g * 256)); } }
    carries_to_lds(P.SUMS, lds, b, c, tid);
    __syncthreads();
#pragma unroll
    for (int nh = 0; nh < 2; ++nh) {
        const int ch = 64 * n + 32 * nh + r32;
        LLAS unsigned char* hc0 = wl + (32 * nh + r32) * 4; LLAS unsigned char* hc1 = hc0 + 32 * HPITCH;
        f32x16 a, bb; float Ad;
#define LRU_UNPACK(dt) do { _Pragma("unroll") for (int g = 0; g < 4; ++g) { const u32x4 v = nh ? qb[dt][g] : qa[dt][g]; _Pragma("unroll") for (int e = 0; e < 4; ++e) { \
            a[4 * g + e] = __builtin_amdgcn_exp2f(__uint_as_float(v[e] & 0xffff0000u)); bb[4 * g + e] = __uint_as_float(v[e] << 16); } } } while (0)
        {
            float h = *(const LLAS float*)(lds + CARRY_OFF + ch * 4);
            LRU_UNPACK(0); scan_fwd<true>(a, bb, h, Ad, hc0, hi);
            LRU_UNPACK(1); scan_fwd<true>(a, bb, h, Ad, hc1, hi);
        }
        {
            float h = *(const LLAS float*)(lds + CARRY_OFF + (LW + ch) * 4);
            LRU_UNPACK(3); scan_bwd<true>(a, bb, h, Ad, hc1, hi);
            LRU_UNPACK(2); scan_bwd<true>(a, bb, h, Ad, hc0, hi);
        }
#undef LRU_UNPACK
    }
    const int ch8 = 8 * (lane & 7);
    const size_t t0 = (size_t)b * S + (size_t)c * 64;
    float v[8][8];
    LLAS float* part = (LLAS float*)(lds + PART_OFF);
#pragma unroll
    for (int it = 0; it < 8; ++it) {
        const int row = (lane >> 3) + 8 * it;
        const f32x4 h0 = *(const LLAS f32x4*)(wl + row * HPITCH + ch8 * 4), h1 = *(const LLAS f32x4*)(wl + row * HPITCH + ch8 * 4 + 16);
        const u32x4 gv = __builtin_nontemporal_load((const u32x4*)(P.LG + (t0 + row) * LW + 64 * n + ch8));
        float ss = 0.f;
#pragma unroll
        for (int q = 0; q < 4; ++q) {
            const float g0 = __uint_as_float(gv[q] << 16), g1 = __uint_as_float(gv[q] & 0xffff0000u);
            const float hA = (q < 2) ? h0[2 * q] : h1[2 * q - 4], hB = (q < 2) ? h0[2 * q + 1] : h1[2 * q - 3];
            v[it][2 * q] = hA * gelu_tanh(g0); v[it][2 * q + 1] = hB * gelu_tanh(g1);
            ss += v[it][2 * q] * v[it][2 * q] + v[it][2 * q + 1] * v[it][2 * q + 1];
        }
        ss += __shfl_xor(ss, 1); ss += __shfl_xor(ss, 2); ss += __shfl_xor(ss, 4);
        if ((lane & 7) == 0) part[n * 64 + row] = ss;
    }
    __syncthreads();
    f32x4 g0 = *(const f32x4*)(P.gain + 64 * n + ch8), g1 = *(const f32x4*)(P.gain + 64 * n + ch8 + 4);
#pragma unroll
    for (int it = 0; it < 8; ++it) {
        const int row = (lane >> 3) + 8 * it;
        float tot = 0.f;
#pragma unroll
        for (int w = 0; w < 8; ++w) tot += part[w * 64 + row];
        const float rs = 1.0f / sqrtf(tot * (1.0f / 512.0f) + 1e-5f);
        u32x4 o; o[0] = cvtpk(v[it][0] * rs * g0[0], v[it][1] * rs * g0[1]); o[1] = cvtpk(v[it][2] * rs * g0[2], v[it][3] * rs * g0[3]);
        o[2] = cvtpk(v[it][4] * rs * g1[0], v[it][5] * rs * g1[1]); o[3] = cvtpk(v[it][6] * rs * g1[2], v[it][7] * rs * g1[3]);
        st16_wt<WT_EPI>(P.MIX + (t0 + row) * 1024 + 512 + 64 * n + ch8, o);
    }
    __syncthreads();
}
#undef LLAS
}
namespace mkf {
using namespace mk;
#define GAS __attribute__((address_space(1)))
#define LAS __attribute__((address_space(3)))
typedef unsigned v4u __attribute__((ext_vector_type(4)));
typedef float f32x4 __attribute__((ext_vector_type(4)));
typedef float f32x16 __attribute__((ext_vector_type(16)));
typedef short bf16x8 __attribute__((ext_vector_type(8)));
typedef GAS unsigned gu32;
#define RLX_AGENT __ATOMIC_RELAXED, __HIP_MEMORY_SCOPE_AGENT
#define LDS_WAIT() asm volatile("s_waitcnt lgkmcnt(0)" ::: "memory")
constexpr int NWAVES = 8;
constexpr int RING_OFF = 0, RING_BYTES = 131072;
constexpr int LDSCTL_OFF = 141312, MISC_OFF = LDSCTL_OFF;
constexpr int LDS_BYTES = 147456;
static_assert(lru::LDS_NEED <= LDSCTL_OFF && attn_body::LDS_BYTES <= RING_BYTES && pg8::STAGE_BYTES + 8192 <= LDSCTL_OFF && MISC_OFF + 512 <= lru::CARRY_OFF && lru::CARRY_OFF + 4096 <= LDS_BYTES, "LDS map");

#define XB_TMO      128
#define XB_XCNT(j)  (256  + 64 * (j))
#define XB_XSUB(j)  (1280 + 64 * (j))
#define XB_XGEN(j)  (2304 + 64 * (j))
#define XB_TOP      3328
#define XB_TOPGEN   3392
#define XCD_BAR_WORDS 3456
#define XB_SPIN_CAP (1u << 18)
__device__ __forceinline__ unsigned xb_ld(unsigned* p)              { return __hip_atomic_load(p, __ATOMIC_RELAXED, __HIP_MEMORY_SCOPE_AGENT); }
__device__ __forceinline__ unsigned xb_add(unsigned* p, unsigned v) { return __hip_atomic_fetch_add(p, v, __ATOMIC_RELAXED, __HIP_MEMORY_SCOPE_AGENT); }
__device__ __forceinline__ unsigned xb_xcc_id() { return (unsigned)__builtin_amdgcn_s_getreg((3 << 11) | 20) & 0xFu; }
#define XB_SPIN(cond, bar) do { unsigned _sp = 0; while (cond) { __builtin_amdgcn_s_sleep(1); \
    if ((++_sp & 255u) == 0u) { if (xb_ld(&(bar)[XB_TMO])) break; if (_sp > XB_SPIN_CAP) { atomicAdd(&(bar)[XB_TMO], 1u); break; } } } } while (0)
struct XcdBarrier { unsigned* bar; unsigned x; volatile LAS unsigned* st; };
__device__ __forceinline__ XcdBarrier xcd_barrier_post(unsigned* bar, volatile LAS unsigned* st) {
    XcdBarrier b; b.bar = bar; b.x = xb_xcc_id(); b.st = st;
    if (threadIdx.x == 0) (void)xb_add(&bar[XB_XCNT(b.x)], 1u);
    return b;
}
__device__ __forceinline__ void xcd_barrier_complete(unsigned* bar, unsigned x, unsigned& nloc, unsigned& nx) {
    const unsigned G = gridDim.x * gridDim.y * gridDim.z;
    unsigned sum, cnt, mine, sp = 0u;
    for (;;) {
        sum = 0u; cnt = 0u; mine = 0u;
#pragma unroll
        for (unsigned j = 0; j < 16; ++j) { const unsigned c = xb_ld(&bar[XB_XCNT(j)]); sum += c; cnt += (c > 0u) ? 1u : 0u; mine = (j == x) ? c : mine; }
        if (sum == G) break;
        __builtin_amdgcn_s_sleep(1);
        if ((++sp & 255u) == 0u) { if (xb_ld(&bar[XB_TMO])) break; if (sp > XB_SPIN_CAP) { atomicAdd(&bar[XB_TMO], 1u); break; } }
    }
    nloc = mine > 0u ? mine : 1u; nx = cnt > 0u ? cnt : 1u;
}
__device__ __forceinline__ void xcd_barrier(const XcdBarrier& b) {
    asm volatile("s_waitcnt vmcnt(0)" ::: "memory");
    __syncthreads();
    if (threadIdx.x == 0) {
        unsigned* bar = b.bar;
        __builtin_amdgcn_s_waitcnt(0);
        unsigned nloc = b.st[0], nx = b.st[1];
        if (nloc == 0u) { xcd_barrier_complete(bar, b.x, nloc, nx); b.st[0] = nloc; b.st[1] = nx; }
        const unsigned old = xb_add(&bar[XB_XSUB(b.x)], 1u);
        const unsigned gen = old / nloc;
        if (old + 1u == (gen + 1u) * nloc) {
            __builtin_amdgcn_fence(__ATOMIC_RELEASE, "agent");
            asm volatile("s_waitcnt vmcnt(0)" ::: "memory");
            const unsigned og = xb_add(&bar[XB_TOP], 1u);
            const unsigned tg = og / nx;
            if (og + 1u == (tg + 1u) * nx) xb_add(&bar[XB_TOPGEN], 1u);
            else XB_SPIN(xb_ld(&bar[XB_TOPGEN]) == tg, bar);
            __builtin_amdgcn_fence(__ATOMIC_ACQUIRE, "agent");
            xb_add(&bar[XB_XGEN(b.x)], 1u);
            asm volatile("s_waitcnt vmcnt(0)" ::: "memory");
        } else {
            XB_SPIN(xb_ld(&bar[XB_XGEN(b.x)]) == gen, bar);
            __builtin_amdgcn_fence(__ATOMIC_ACQUIRE, "agent");
            asm volatile("s_waitcnt vmcnt(0)" ::: "memory");
        }
    }
    __syncthreads();
}

struct Args { const float* in[25]; float* out; unsigned char* ws; int ph_lo, ph_hi, flags, li; };
enum { FL_LRU = 1, FL_ATTN = 2 };

__device__ __forceinline__ float wave_sum(float v) {
#pragma unroll
    for (int o = 1; o < 64; o <<= 1) v += __shfl_xor(v, o);
    return v;
}
template <class DST> __device__ __forceinline__ void transpose_item(const float* W, int ldn, const float* gk, bf16_t* WT, const DST& dst, LAS float* scr, int k0, int n0, int lane) {
    f32x4 v[8];
#pragma unroll
    for (int i = 0; i < 8; ++i) v[i] = *(const GAS f32x4*)(W + (size_t)(k0 + 8 * i + (lane >> 3)) * ldn + n0 + 4 * (lane & 7));
#pragma unroll
    for (int i = 0; i < 8; ++i) { const int kk = 8 * i + (lane >> 3); if (gk) v[i] *= gk[k0 + kk]; LAS float* d = scr + kk * 33 + 4 * (lane & 7); d[0] = v[i].x; d[1] = v[i].y; d[2] = v[i].z; d[3] = v[i].w; }
    LDS_WAIT(); asm volatile("" ::: "memory");
    const int c = lane & 7;
#pragma unroll
    for (int j = 0; j < 4; ++j) { const int n = (lane >> 3) + 8 * j; const LAS float* s = scr + (8 * c) * 33 + n;
        v4u o; o.x = pk2(s[0 * 33], s[1 * 33]); o.y = pk2(s[2 * 33], s[3 * 33]); o.z = pk2(s[4 * 33], s[5 * 33]); o.w = pk2(s[6 * 33], s[7 * 33]);
        st16_wt<WT_P0>(WT + (size_t)dst(n0 + n) * D + k0 + 8 * c, o); }
    LDS_WAIT(); asm volatile("" ::: "memory");
}
struct ItemSrc { const float* W; const float* gk; unsigned char* WT; int rowbase, half, kind, k0, n0; };
__device__ __forceinline__ void f8_item_load(const ItemSrc& s, int lane, f32x4 (&v)[8]) {
#pragma unroll
    for (int i = 0; i < 8; ++i) v[i] = __builtin_nontemporal_load((const GAS f32x4*)(s.W + (size_t)(s.k0 + 8 * i + (lane >> 3)) * D + s.n0 + 4 * (lane & 7)));
}
__device__ __forceinline__ void f8_item_store(const ItemSrc& s, int lane, f32x4 (&v)[8], LAS float* scr) {
#pragma unroll
    for (int i = 0; i < 8; ++i) { const int kk = 8 * i + (lane >> 3); float m = 32.0f; if (s.gk) m *= s.gk[s.k0 + kk]; v[i] *= m; LAS float* d = scr + kk * 33 + 4 * (lane & 7); d[0] = v[i].x; d[1] = v[i].y; d[2] = v[i].z; d[3] = v[i].w; }
    LDS_WAIT(); asm volatile("" ::: "memory");
    const int c = lane & 3;
#pragma unroll
    for (int j = 0; j < 2; ++j) { const int n = (lane >> 2) + 16 * j; const LAS float* p = scr + (16 * c) * 33 + n; int o[4];
#pragma unroll
        for (int q = 0; q < 4; ++q) { int w = 0; w = __builtin_amdgcn_cvt_pk_fp8_f32(p[(4 * q) * 33], p[(4 * q + 1) * 33], w, false); w = __builtin_amdgcn_cvt_pk_fp8_f32(p[(4 * q + 2) * 33], p[(4 * q + 3) * 33], w, true); o[q] = w; }
        const int col = s.n0 + n; const int row = s.rowbase + (s.kind == 0 ? gu_dst(col, s.half) : down_dst(col));
        st16_wt<WT_P0>(s.WT + (size_t)row * 1024 + s.k0 + 16 * c, (v4u){(unsigned)o[0], (unsigned)o[1], (unsigned)o[2], (unsigned)o[3]}); }
    LDS_WAIT(); asm volatile("" ::: "memory");
}
struct DstWin { __device__ int operator()(int c) const { return win_dst(c); } };
struct DstNat { __device__ int operator()(int c) const { return c; } };
struct DstPerm { __device__ int operator()(int c) const { return perm256_dst(c); } };
struct DstGU { int base, half; __device__ int operator()(int c) const { return base + gu_dst(c, half); } };
struct DstDown { int base; __device__ int operator()(int c) const { return base + perm256_dst(c); } };

constexpr int EXP_ITEMS = NE * 3 * 16 * 32;
constexpr int EXP_STEAL = 4096;
constexpr int EXP_N1 = EXP_ITEMS - EXP_STEAL;
constexpr int EXP_N0 = EXP_N1 - 64 * 8 * 8;
__device__ __forceinline__ void convert_expert_items(const Args& a, LAS float* scr, int lane, int first, int stride, int lo, int hi) {
    unsigned char* ws = a.ws; const float* n2g = a.in[15]; constexpr int I_E = 16 * 32;
    auto mkitem = [&](int r) { ItemSrc s; int e, q, ii;
        if (r < NE * 2 * I_E) { e = r / (2 * I_E); q = (r / I_E) & 1; ii = r % I_E; } else { const int rd = r - NE * 2 * I_E; e = rd / I_E; q = 2; ii = rd % I_E; }
        s.k0 = 64 * (ii / 32); s.n0 = 32 * (ii % 32); s.half = q & 1; s.kind = (q == 2);
        s.W = a.in[q == 0 ? 18 : (q == 1 ? 20 : 22)] + (size_t)e * D * D; s.gk = (q == 2) ? (const float*)nullptr : n2g; s.WT = ws + (q == 2 ? WS_BT2 : WS_BT1); s.rowbase = (q == 2) ? e * 1024 : e * 2048; return s; };
    int r = lo + first; f32x4 va[8], vb[8]; ItemSrc sa, sb;
    if (r < hi) { sa = mkitem(r); f8_item_load(sa, lane, va); }
    while (r < hi) {
        const int r1 = r + stride; if (r1 < hi) { sb = mkitem(r1); f8_item_load(sb, lane, vb); }
        f8_item_store(sa, lane, va, scr);
        if (r1 >= hi) break;
        const int r2 = r1 + stride; if (r2 < hi) { sa = mkitem(r2); f8_item_load(sa, lane, va); }
        f8_item_store(sb, lane, vb, scr);
        r = r2;
    }
}
__device__ __forceinline__ void p0_prologue(const Args& a, LAS unsigned char* lds, int vcu, int G, int wave, int lane) {
    unsigned char* ws = a.ws;
    LAS float* scr = (LAS float*)(lds + RING_OFF + wave * 16384);
    const int gw = vcu * NWAVES + wave, NGW = G * NWAVES;
    constexpr int I_IN = 16 * 56, I_OUT = 16 * 32, I_E = 16 * 32;
    const float* w_in = a.in[2]; const float* w_out = a.in[14]; const float* aog = a.in[12]; const float* n2g = a.in[15];
    for (int r = gw; r < I_IN + I_OUT; r += NGW) {
        if (r < I_IN) transpose_item(w_in, INW, (const float*)nullptr, (bf16_t*)(ws + WS_WIN), DstWin{}, scr, 64 * (r / 56), 32 * (r % 56), lane);
        else { const int q = r - I_IN, k0 = 64 * (q / 32);
            transpose_item(w_out, D, k0 < 512 ? aog : (const float*)nullptr, (bf16_t*)(ws + WS_WOUT), DstPerm{}, scr, k0, 32 * (q % 32), lane); }
    }
    convert_expert_items(a, scr, lane, gw, NGW, 0, G == 256 ? EXP_N0 : EXP_N1);
    const float* x = a.in[0]; const float* n1g = a.in[1]; bf16_t* XN = (bf16_t*)(ws + WS_XN);
    f32x4 gv[4];
#pragma unroll
    for (int j = 0; j < 4; ++j) gv[j] = *(const f32x4*)(n1g + 4 * lane + 256 * j);
    for (int m0 = 2 * gw; m0 < T; m0 += 2 * NGW) {
        f32x4 v[2][4]; float s[2] = {0.f, 0.f};
#pragma unroll
        for (int r = 0; r < 2; ++r) { const GAS f32x4* xr = (const GAS f32x4*)(x + (size_t)(m0 + r) * D) + lane;
#pragma unroll
            for (int j = 0; j < 4; ++j) v[r][j] = __builtin_nontemporal_load(xr + 64 * j); }
#pragma unroll
        for (int r = 0; r < 2; ++r) {
#pragma unroll
            for (int j = 0; j < 4; ++j) s[r] += (v[r][j].x * v[r][j].x + v[r][j].y * v[r][j].y) + (v[r][j].z * v[r][j].z + v[r][j].w * v[r][j].w);
            const float rs = 1.0f / sqrtf(wave_sum(s[r]) * (1.0f / D) + 1e-5f);
            GAS unsigned long long* o8 = (GAS unsigned long long*)(XN + (size_t)(m0 + r) * D) + lane;
#pragma unroll
            for (int j = 0; j < 4; ++j) o8[64 * j] = (unsigned long long)pk2(v[r][j].x * rs * gv[j].x, v[r][j].y * rs * gv[j].y) | ((unsigned long long)pk2(v[r][j].z * rs * gv[j].z, v[r][j].w * rs * gv[j].w) << 32);
        }
    }
    const int gt = vcu * (NWAVES * 64) + wave * 64 + lane, NGT = G * NWAVES * 64;
    for (int idx = gt; idx < 8 * 4 * 2 * 4 * 64 * 8; idx += NGT) {
        if (idx < 2048) nv::tbl_rope(idx, (float*)(ws + WS_ROPE));
        nv::tbl_wl(idx, a.in[7], a.in[9], (bf16_t*)(ws + WS_WL));
        if (idx < 64 * 64 * 8) nv::tbl_rtr(idx, a.in[16], n2g, (bf16_t*)(ws + WS_RTR));
    }
}
__device__ __forceinline__ void p5_route(const Args& a, LAS unsigned char* lds, int G) {
    unsigned char* ws = a.ws;
    const float* X1 = (const float*)(ws + WS_X1); const bf16_t* RT = (const bf16_t*)(ws + WS_RTR); const float* br = a.in[17];
    float* listr = (float*)(ws + WS_LISTR); float* listg = (float*)(ws + WS_LISTG); int* list = (int*)(ws + WS_LIST); unsigned* cnt = (unsigned*)(ws + WS_CTL) + CW_CNT;
    LAS float* PD = (LAS float*)(lds); LAS float* PS = (LAS float*)(lds + 33792); LAS unsigned* CL = (LAS unsigned*)(lds + 34816); LAS unsigned* BASE = (LAS unsigned*)(lds + 34944);
    int tid_ = threadIdx.x; asm volatile("" : "+v"(tid_));
    const int tid = tid_, lane = tid & 63, i = lane & 31, hi = lane >> 5; const int wid = __builtin_amdgcn_readfirstlane(tid >> 6), tile = wid >> 2, q = wid & 3;
    for (int grp = blockIdx.x; grp < T / 64; grp += G) {
        if (tid < 32) CL[tid] = 0u;
        const int tok0 = grp * 64 + tile * 32;
        f32x16 acc = f32x16{}; float ss = 0.f;
        const float* xp = X1 + (size_t)(tok0 + i) * D + q * 256 + hi * 8;
#pragma unroll 4
        for (int ks = 0; ks < 16; ++ks) {
            const f32x4 x0 = *(const f32x4*)(xp + ks * 16), x1 = *(const f32x4*)(xp + ks * 16 + 4);
            ss += (x0[0] * x0[0] + x0[1] * x0[1]) + (x0[2] * x0[2] + x0[3] * x0[3]) + (x1[0] * x1[0] + x1[1] * x1[1]) + (x1[2] * x1[2] + x1[3] * x1[3]);
            unsigned hh[4], ll[4];
#pragma unroll
            for (int p = 0; p < 2; ++p) { const float e0 = x0[2 * p], e1 = x0[2 * p + 1]; const unsigned h0 = f2bf(e0), h1 = f2bf(e1); hh[p] = h0 | (h1 << 16); ll[p] = pk2(e0 - bf2f(h0), e1 - bf2f(h1)); }
#pragma unroll
            for (int p = 0; p < 2; ++p) { const float e0 = x1[2 * p], e1 = x1[2 * p + 1]; const unsigned h0 = f2bf(e0), h1 = f2bf(e1); hh[2 + p] = h0 | (h1 << 16); ll[2 + p] = pk2(e0 - bf2f(h0), e1 - bf2f(h1)); }
            const bf16x8 ah = __builtin_bit_cast(bf16x8, (v4u){hh[0], hh[1], hh[2], hh[3]}), al = __builtin_bit_cast(bf16x8, (v4u){ll[0], ll[1], ll[2], ll[3]});
            const int ksg = q * 16 + ks;
            const bf16x8 bh = *(const bf16x8*)(RT + ((size_t)ksg * 64 + lane) * 8), bl = *(const bf16x8*)(RT + 32768 + ((size_t)ksg * 64 + lane) * 8);
            acc = __builtin_amdgcn_mfma_f32_32x32x16_bf16(ah, bh, acc, 0, 0, 0);
            acc = __builtin_amdgcn_mfma_f32_32x32x16_bf16(ah, bl, acc, 0, 0, 0);
            acc = __builtin_amdgcn_mfma_f32_32x32x16_bf16(al, bh, acc, 0, 0, 0);
        }
#pragma unroll
        for (int r = 0; r < 16; ++r) PD[((tile * 4 + q) * 32 + ((r & 3) + 8 * (r >> 2) + 4 * hi)) * 33 + i] = acc[r];
        ss += __shfl_xor(ss, 32);
        if (hi == 0) PS[(tile * 4 + q) * 32 + i] = ss;
        __syncthreads();
        int se[4]; unsigned sp[4]; float sg[4]; float rs_tok = 0.f; const bool sel = (q == 0 && hi == 0); const int tok = tok0 + i;
        if (sel) {
            float lg[32];
            const float sq = (PS[(tile * 4 + 0) * 32 + i] + PS[(tile * 4 + 1) * 32 + i]) + (PS[(tile * 4 + 2) * 32 + i] + PS[(tile * 4 + 3) * 32 + i]);
            const float rs = 1.0f / sqrtf(sq * (1.0f / D) + 1e-5f);
#pragma unroll
            for (int e = 0; e < 32; ++e) { const float v = (PD[((tile * 4 + 0) * 32 + i) * 33 + e] + PD[((tile * 4 + 1) * 32 + i) * 33 + e]) + (PD[((tile * 4 + 2) * 32 + i) * 33 + e] + PD[((tile * 4 + 3) * 32 + i) * 33 + e]); lg[e] = v * rs + br[e]; }
            unsigned taken = 0u; float tv[4];
#pragma unroll
            for (int k = 0; k < 4; ++k) { float best = -INFINITY; int bi = 0;
#pragma unroll
                for (int e = 0; e < 32; ++e) { const bool c = (lg[e] > best) && !((taken >> e) & 1u); best = c ? lg[e] : best; bi = c ? e : bi; }
                taken |= 1u << bi; se[k] = bi; tv[k] = best; }
            float sum = 0.f;
#pragma unroll
            for (int k = 0; k < 4; ++k) { sg[k] = __expf(tv[k] - tv[0]); sum += sg[k]; }
            const float inv = 1.0f / sum;
#pragma unroll
            for (int k = 0; k < 4; ++k) { sg[k] *= inv; sp[k] = __hip_atomic_fetch_add(&CL[se[k]], 1u, __ATOMIC_RELAXED, __HIP_MEMORY_SCOPE_WORKGROUP); }
            rs_tok = rs;
        }
        __syncthreads();
        if (tid < 32) BASE[tid] = __hip_atomic_fetch_add(cnt + tid * CNT_STRIDE, CL[tid], RLX_AGENT);
        __syncthreads();
        if (sel) {
#pragma unroll
            for (int k = 0; k < 4; ++k) { const size_t pos = (size_t)se[k] * T + BASE[se[k]] + sp[k]; list[pos] = tok * 4 + k; listr[pos] = rs_tok; listg[pos] = sg[k]; }
        }
        __syncthreads();
    }
}
__device__ __forceinline__ void p8_final(const Args& a, int vcu, int G, int wave, int lane) {
    const float* X1 = (const float*)(a.ws + WS_X1); const unsigned char* Y = a.ws + WS_Y; const float* fg = a.in[24];
    const int gw = vcu * NWAVES + wave, NGW = G * NWAVES;
    f32x4 gv[4];
#pragma unroll
    for (int j = 0; j < 4; ++j) gv[j] = *(const f32x4*)(fg + 4 * lane + 256 * j);
    for (int m0 = 2 * gw; m0 < T; m0 += 2 * NGW) {
        f32x4 v[2][4]; unsigned yq[2][4][4];
#pragma unroll
        for (int r = 0; r < 2; ++r)
#pragma unroll
            for (int j = 0; j < 4; ++j) { v[r][j] = __builtin_nontemporal_load((const GAS f32x4*)(X1 + (size_t)(m0 + r) * D) + lane + 64 * j);
#pragma unroll
                for (int k = 0; k < 4; ++k) yq[r][j][k] = __builtin_nontemporal_load((const GAS unsigned*)(Y + ((size_t)(m0 + r) * 4 + k) * D) + lane + 64 * j); }
#pragma unroll
        for (int r = 0; r < 2; ++r) { float s = 0.f;
#pragma unroll
            for (int j = 0; j < 4; ++j) { f32x4 ys = (f32x4){0.f, 0.f, 0.f, 0.f};
#pragma unroll
                for (int k = 0; k < 4; ++k) { const auto lo = __builtin_amdgcn_cvt_pk_f32_fp8((int)yq[r][j][k], false), hi = __builtin_amdgcn_cvt_pk_f32_fp8((int)yq[r][j][k], true); ys.x += lo[0]; ys.y += lo[1]; ys.z += hi[0]; ys.w += hi[1]; }
                v[r][j] += ys * 0.0625f;
                s += (v[r][j].x * v[r][j].x + v[r][j].y * v[r][j].y) + (v[r][j].z * v[r][j].z + v[r][j].w * v[r][j].w); }
            const float rs = 1.0f / sqrtf(wave_sum(s) * (1.0f / D) + 1e-5f);
#pragma unroll
            for (int j = 0; j < 4; ++j) __builtin_nontemporal_store(v[r][j] * gv[j] * rs, (GAS f32x4*)(a.out + (size_t)(m0 + r) * D) + lane + 64 * j); }
    }
}

__global__ void __launch_bounds__(NWAVES * 64, 2) mk_fwd(Args args) {
    extern __shared__ __attribute__((aligned(16))) unsigned char lds_raw[];
    LAS unsigned char* lds = (LAS unsigned char*)lds_raw;
    volatile LAS unsigned* MISC = (volatile LAS unsigned*)(lds + MISC_OFF);
    const int tid = threadIdx.x, lane = tid & 63, wave = __builtin_amdgcn_readfirstlane(tid >> 6);
    const int G = gridDim.x; const int bx = blockIdx.x; const int vcu = (G % 8 == 0) ? (bx % 8) * (G / 8) + bx / 8 : bx;
    unsigned char* ws = args.ws;
    gu32* ctl = (gu32*)(ws + WS_CTL);
    for (int u = tid; u < 128; u += NWAVES * 64) MISC[u] = 0u;
    __syncthreads();
    XcdBarrier bar = xcd_barrier_post((unsigned*)ctl + CW_BAR + args.li * XCD_BAR_WORDS, MISC);
    const int lo = args.ph_lo, hi = args.ph_hi;
#define IN(k) (lo <= (k) && (k) < hi)
#define SEAM(k) do { if (IN(k) && IN((k) + 1)) xcd_barrier(bar); } while (0)

    if (IN(0)) { p0_prologue(args, lds, vcu, G, wave, lane); SEAM(0); }

    if (IN(1)) {
        pg8::StaticSched Sc; Sc.init(ws + WS_WIN, T, INW, G, bx);
        pg8::EpiInProj E{(bf16_t*)(ws + WS_Q), (bf16_t*)(ws + WS_K), (bf16_t*)(ws + WS_V), (bf16_t*)(ws + WS_LX), (bf16_t*)(ws + WS_LG), args.in[3], args.in[4], (const float*)(ws + WS_ROPE)};
        pg8::gemm_phase<pg8::EpiInProj, pg8::StaticSched>(lds + RING_OFF, (const char*)(ws + WS_XN), Sc, E);
        { pg8::GUnit u2; const int nidle = 2 * G - 448;
          if (G == 256 && !Sc.next(1, u2)) { int j = 0, my = -1; for (int c2 = 0; c2 < G; ++c2) { pg8::StaticSched S2 = Sc; S2.c = c2; pg8::GUnit t2; if (!S2.next(1, t2)) { if (c2 == bx) my = j; ++j; } }
              (void)nidle; if (my >= 0) convert_expert_items(args, (LAS float*)(lds + RING_OFF + wave * 16384), lane, my * NWAVES + wave, j * NWAVES, EXP_N0, EXP_N1); } }
        SEAM(1);
    }
    const lru::Params LP{(const bf16_t*)(ws + WS_LX), (const bf16_t*)(ws + WS_LG), args.in[5], args.in[6], args.in[8], args.in[10], args.in[11], args.in[13], (const bf16_t*)(ws + WS_WL),
                         (lru::f32x2*)(ws + WS_SUMS), (bf16_t*)(ws + WS_MIX), (unsigned*)(ws + WS_X1)};
    if (IN(2)) {
        if (args.flags & FL_LRU) for (int task = bx; task < NB * NCH; task += G) lru::lru_summaries(LP, lds, task / NCH, task % NCH);
        SEAM(2);
    }
    if (IN(3)) {
        const bool lru_first = (vcu & 1) == 0;
        if ((args.flags & FL_LRU) && lru_first) { __syncthreads(); for (int task = bx; task < NB * NCH; task += G) lru::lru_apply(LP, lds, task / NCH, task % NCH); __syncthreads(); }
        if (args.flags & FL_ATTN) {
            float gq = 0.f, gk = 0.f; { const float a0 = fabsf(args.in[3][lane]), a1 = fabsf(args.in[4][lane]); gq = a0; gk = a1;
#pragma unroll
                for (int o = 1; o < 64; o <<= 1) { gq = fmaxf(gq, __shfl_xor(gq, o)); gk = fmaxf(gk, __shfl_xor(gk, o)); } }
            const float smax = 8.0f * 1.4426950408889634f * gq * gk * 1.01f; const bool fixref = __builtin_amdgcn_readfirstlane(smax < 40.0f ? 1 : 0) != 0;
            for (int L = vcu; L < NB * 8 * (S / 256); L += G) {
                const int per = 64;
                const int grp = L / per, r = L % per;
                const int b = grp >> 2, kvh = (grp >> 1) & 1, hp = grp & 1, hg = 2 * hp + (r >> 5), qb = r & 31;
                if (fixref) attn_body::attn_unit<8, true>(b, kvh * 4 + hg, qb, (const attn_body::bf16*)(ws + WS_Q), (const attn_body::bf16*)(ws + WS_K), (const attn_body::bf16*)(ws + WS_V),
                                        (attn_body::bf16*)(ws + WS_MIX), (float*)(ws + WS_SSQ), (char*)lds_raw + RING_OFF, smax - 20.0f);
                else attn_body::attn_unit<8, false>(b, kvh * 4 + hg, qb, (const attn_body::bf16*)(ws + WS_Q), (const attn_body::bf16*)(ws + WS_K), (const attn_body::bf16*)(ws + WS_V),
                                        (attn_body::bf16*)(ws + WS_MIX), (float*)(ws + WS_SSQ), (char*)lds_raw + RING_OFF, 0.0f);
            }
        }
        if ((args.flags & FL_LRU) && !lru_first) { __syncthreads(); for (int task = bx; task < NB * NCH; task += G) lru::lru_apply(LP, lds, task / NCH, task % NCH); __syncthreads(); }
        SEAM(3);
    }
    if (IN(4)) {
        pg8::StaticSched Sc; Sc.init(ws + WS_WOUT, T, D, G, bx);
        pg8::EpiOut E{args.in[0], (const float*)(ws + WS_SSQ), (float*)(ws + WS_X1), ws + WS_X1B};
        pg8::gemm_phase<pg8::EpiOut, pg8::StaticSched>(lds + RING_OFF, (const char*)(ws + WS_MIX), Sc, E);
        SEAM(4);
    }
    if (IN(5)) { p5_route(args, lds, G); SEAM(5); }
    if (IN(6) || IN(7)) {
        __syncthreads();
        if (tid < 64) { const unsigned c = (tid < NE) ? __hip_atomic_load(ctl + CW_CNT + tid * CNT_STRIDE, RLX_AGENT) : 0u; unsigned tl = (c + 255u) >> 8, s = tl;
#pragma unroll
            for (int o = 1; o < 32; o <<= 1) { const unsigned v = __shfl_up(s, o); if ((tid & 31) >= o) s += v; }
            if (tid < NE) { MISC[16 + tid + 1] = s; MISC[64 + tid] = c; if (tid == 0) MISC[16] = 0u; } }
        __syncthreads();
        if (tid < 320) { int e = 0; for (int k = 1; k < NE; ++k) e += (MISC[16 + k] <= (unsigned)tid) ? 1 : 0; ((volatile LAS unsigned char*)(lds + MISC_OFF + 512))[tid] = (unsigned char)e; }
        __syncthreads();
    }
    const LAS unsigned* Pl = (const LAS unsigned*)(lds + MISC_OFF + 64); const LAS unsigned* Cl = (const LAS unsigned*)(lds + MISC_OFF + 256); const LAS unsigned char* Te = (const LAS unsigned char*)(lds + MISC_OFF + 512);
#if MOE_MERGE
    if (IN(6)) {
        pg8::MoeSchedM Sc{Pl, Cl, Te, (const int*)(ws + WS_LIST), (unsigned*)ctl + CW_READY, (unsigned*)ctl + CW_TMO, ws, G, vcu};
        pg8::EpiMoeM E{pg8::EpiMoe1{Cl, (const float*)(ws + WS_LISTR), args.in[19], args.in[21], ws + WS_H}, pg8::EpiMoe2{Cl, (const int*)(ws + WS_LIST), (const float*)(ws + WS_LISTG), args.in[23], ws + WS_Y}};
        pg8::gemm_phase<pg8::EpiMoeM, pg8::MoeSchedM, true>(lds + RING_OFF, (const char*)ws, Sc, E);
        if (IN(8)) xcd_barrier(bar);
    }
#else
    if (IN(6)) {
        pg8::MoeSched Sc{Pl, Cl, Te, (const int*)(ws + WS_LIST), (const char*)(ws + WS_BT1), (size_t)2048 * 1024, 8, G, vcu, true};
        pg8::EpiMoe1 E{Cl, (const float*)(ws + WS_LISTR), args.in[19], args.in[21], ws + WS_H};
        pg8::gemm_phase<pg8::EpiMoe1, pg8::MoeSched, true>(lds + RING_OFF, (const char*)(ws + WS_X1B), Sc, E);
        for (;;) {
            __syncthreads();
            if (tid == 0) MISC[8] = __hip_atomic_fetch_add(ctl + 3, 8u, RLX_AGENT);
            __syncthreads();
            const unsigned base = MISC[8];
            if (base >= (unsigned)EXP_STEAL) break;
            convert_expert_items(args, (LAS float*)(lds + RING_OFF + wave * 16384), lane, (int)base + wave, EXP_STEAL, EXP_N1, EXP_ITEMS);
        }
        SEAM(6);
    }
    if (IN(7)) {
        pg8::MoeSched Sc{Pl, Cl, Te, (const int*)(ws + WS_LIST), (const char*)(ws + WS_BT2), (size_t)1024 * 1024, 4, G, vcu, false};
        pg8::EpiMoe2 E{Cl, (const int*)(ws + WS_LIST), (const float*)(ws + WS_LISTG), args.in[23], ws + WS_Y};
        pg8::gemm_phase<pg8::EpiMoe2, pg8::MoeSched, true>(lds + RING_OFF, (const char*)(ws + WS_H), Sc, E);
        SEAM(7);
    }
#endif
    if (IN(8)) p8_final(args, vcu, G, wave, lane);
#undef IN
#undef SEAM
}

static int g_grid = 0;
static bool mk_setup() {
    if (g_grid == 0) {
        int dev = 0, cus = 0, per_cu = 0;
        if (hipGetDevice(&dev) != hipSuccess || hipDeviceGetAttribute(&cus, hipDeviceAttributeMultiprocessorCount, dev) != hipSuccess) { g_grid = -1; return false; }
        if (hipFuncSetAttribute((const void*)mk_fwd, hipFuncAttributeMaxDynamicSharedMemorySize, LDS_BYTES) != hipSuccess) { fprintf(stderr, "kernel_launch: hipFuncSetAttribute failed\n"); g_grid = -1; return false; }
        if (hipOccupancyMaxActiveBlocksPerMultiprocessor(&per_cu, (const void*)mk_fwd, NWAVES * 64, LDS_BYTES) != hipSuccess || per_cu < 1) { fprintf(stderr, "kernel_launch: occupancy query says %d blocks per CU\n", per_cu); g_grid = -1; return false; }
        (void)hipGetLastError();
        g_grid = cus;
    }
    return g_grid > 0;
}
static void mk_launch(void* const* d_in, float* out, void* ws, int lo, int hi, int flags, int li, hipStream_t st) {
    if (!mk_setup()) return;
    Args a{};
    for (int i = 0; i < 25; ++i) a.in[i] = (const float*)d_in[i];
    a.out = out; a.ws = (unsigned char*)ws; a.ph_lo = lo; a.ph_hi = hi; a.flags = flags; a.li = li;
    hipLaunchKernelGGL(mk_fwd, dim3(g_grid), dim3(NWAVES * 64), LDS_BYTES, st, a);
}
}
extern "C" void kernel_launch(void* const* d_in, const int* in_sizes, int n_in, void* d_out, int out_size, void* d_ws, size_t ws_size, hipStream_t stream) {
    if (n_in != 25 || ws_size < (size_t)mk::WS_END || out_size != mk::T * mk::D) { fprintf(stderr, "kernel_launch: unexpected n_in %d / ws_size %zu / out_size %d\n", n_in, ws_size, out_size); return; }
    (void)hipMemsetAsync((char*)d_ws + mk::WS_CTL, 0, mk::CTL_ZERO_BYTES, stream);
    mkf::mk_launch(d_in, (float*)d_out, d_ws, 0, 9, mkf::FL_LRU | mkf::FL_ATTN, 0, stream);
}
```

```cpp
#define ONE_LAUNCH 1
#include <hip/hip_runtime.h>
#include <hip/hip_bf16.h>
#include <stdint.h>
#include <math.h>
#include <cstdio>

#ifndef MOE_MERGE
#define MOE_MERGE 0
#endif
namespace mk {
constexpr int NB = 2, S = 8192, T = NB * S, D = 1024, INW = 1792, NE = 32, LW = 512;
constexpr float C2 = 0.125f * 1.4426950408889634f;
constexpr int LC = 64, NCH = S / LC;
constexpr size_t MiB = 1u << 20;
constexpr size_t WS_CTL = 0, CTL_ZERO_BYTES = MOE_MERGE ? 1 * MiB : 32 * 1024;
constexpr size_t WS_ROPE = 1 * MiB;
constexpr size_t WS_WL = 1 * MiB + 64 * 1024;
constexpr size_t WS_RTR = 1 * MiB + 512 * 1024;
constexpr size_t WS_SUMS = 2 * MiB;
constexpr size_t WS_SSQ = 4 * MiB;
constexpr size_t WS_RSTD = 4 * MiB + 512 * 1024;
constexpr size_t WS_GATEV = 4 * MiB + 768 * 1024;
constexpr size_t WS_LIST = 5 * MiB;
constexpr size_t WS_WIN = 8 * MiB, WS_WOUT = 12 * MiB, WS_BT1 = 14 * MiB, WS_BT2 = 142 * MiB, WS_XN = 206 * MiB, WS_X1 = 238 * MiB;
constexpr size_t WS_Q = 302 * MiB, WS_K = 318 * MiB, WS_V = 322 * MiB, WS_LX = 326 * MiB, WS_LG = 342 * MiB, WS_MIX = 358 * MiB;
constexpr size_t WS_H = 302 * MiB, WS_Y = 14 * MiB, WS_X1B = 206 * MiB, WS_END = 446 * MiB;
constexpr size_t WS_LISTR = 2 * MiB;
constexpr size_t WS_LISTG = 224 * MiB;
constexpr size_t WS_SCR = 390 * MiB;
constexpr int CW_READY = 65536;
constexpr int CW_TMO = 0, CW_CODE = 1, CW_CNT = 64, CNT_STRIDE = 64, CW_BAR = 4096;

typedef unsigned short bf16_t;
__host__ __device__ __forceinline__ unsigned f2bf(float f) { unsigned u = __builtin_bit_cast(unsigned, f); return (u + 0x7fffu + ((u >> 16) & 1u)) >> 16; }
__host__ __device__ __forceinline__ float bf2f(unsigned h) { return __builtin_bit_cast(float, (h & 0xffffu) << 16); }
__host__ __device__ __forceinline__ unsigned pk2(float lo, float hi) { return f2bf(lo) | (f2bf(hi) << 16); }

typedef unsigned u32x4_t __attribute__((ext_vector_type(4)));
#ifndef WT_STORES
#define WT_STORES 1
#endif
template <int ON = 1> __device__ __forceinline__ void st16_wt(void* p, u32x4_t v) {
  if constexpr (ON) {
#if WT_STORES
    asm volatile("global_store_dwordx4 %0, %1, off sc1\n\ts_nop 1" :: "v"(p), "v"(v) : "memory");
#else
    *(u32x4_t*)p = v;
#endif
  } else *(u32x4_t*)p = v;
}
#ifndef WT_P0
#define WT_P0 0
#endif
#ifndef WT_EPI
#define WT_EPI 0
#endif
__host__ __device__ __forceinline__ int perm_cl(int o) { const int fq = o >> 3, n = (o >> 2) & 1, e = o & 3; return 16 * n + 4 * fq + e; }
__host__ __device__ __forceinline__ int perm256_dst(int c) { const int pn = c >> 8, cp = c & 255, bj = cp >> 7, wc = (cp >> 5) & 3; return 256 * pn + 128 * bj + 32 * wc + perm_cl(cp & 31); }
__host__ __device__ __forceinline__ int win_dst(int c) {
    if (c < 768) { const int pn = c >> 8, cp = c & 255, wc = cp >> 6, bj = (cp >> 5) & 1, j = cp & 31; return 256 * pn + 128 * bj + 32 * wc + j; }
    return perm256_dst(c);
}
__host__ __device__ __forceinline__ int down_dst(int c) { const int pn = c >> 8, cp = c & 255, wc = cp >> 6, fq = (cp >> 4) & 3, bj = (cp >> 3) & 1, n = (cp >> 2) & 1, e = cp & 3; return 256 * pn + 128 * bj + 32 * wc + 16 * n + 4 * fq + e; }
__host__ __device__ __forceinline__ int gu_dst(int hc, int half) { const int j = hc >> 7, wc = (hc >> 5) & 3; return 256 * j + 128 * half + 32 * wc + perm_cl(hc & 31); }
}
namespace nv {
using namespace mk;
__device__ __forceinline__ void tbl_rope(int idx, float* rope) {
    const int pos = idx >> 4, i = idx & 15; const float ang = (float)pos * powf(10000.0f, -(float)i / 16.0f);
    rope[idx] = cosf(ang); rope[2048 + idx] = sinf(ang);
}
__device__ __forceinline__ void tbl_wl(int idx, const float* wa, const float* wi, bf16_t* WL) {
    const int j = idx & 7, lane = (idx >> 3) & 63, ks = (idx >> 9) & 3, nh = (idx >> 11) & 1, mat = (idx >> 12) & 3, n = idx >> 14;
    const int r32 = lane & 31, hi = lane >> 5, i = 16 * ks + 8 * hi + j, jc = 32 * nh + r32, dir = mat >> 1;
    const float* W = (mat & 1) ? wi : wa;
    WL[idx] = (bf16_t)f2bf(W[((size_t)(dir * 8 + n) * 64 + i) * 64 + jc]);
}
__device__ __forceinline__ void tbl_rtr(int idx, const float* wr, const float* n2g, bf16_t* RT) {
    const int j = idx & 7, lane = (idx >> 3) & 63, ks = idx >> 9; const int e = lane & 31, hi = lane >> 5, k = 16 * ks + 8 * hi + j;
    const float w = n2g[k] * wr[(size_t)k * NE + e]; const unsigned h = f2bf(w);
    RT[idx] = (bf16_t)h; RT[32768 + idx] = (bf16_t)f2bf(w - bf2f(h));
}
}
namespace pg8 {
using mk::bf16_t;
#define PG8_LAS __attribute__((address_space(3)))
typedef short bf16x8 __attribute__((ext_vector_type(8)));
typedef float f32x4 __attribute__((ext_vector_type(4)));
typedef unsigned u32x4 __attribute__((ext_vector_type(4)));
typedef unsigned u32x2 __attribute__((ext_vector_type(2)));
typedef int v8i __attribute__((ext_vector_type(8)));
typedef int v4i __attribute__((ext_vector_type(4)));
constexpr int BM = 256, BK = 64, HALF = 128, HTB = HALF * BK * 2, STAGE_BYTES = 8 * HTB, NXCD = 8, WGM = 8, KD = 1024;

__host__ __device__ __forceinline__ int lds_byte(int r, int c) { const int st = (r >> 4) * 2 + (c >> 5), rr = r & 15, cc = c & 31, ob = rr * 64 + cc * 2; return st * 1024 + (ob ^ (((ob >> 9) & 1) << 5)); }
__host__ __device__ __forceinline__ void stage_rc(int b, int& R, int& C) { const int st = b / 1024, sb = b % 1024, swz = sb ^ (((sb >> 9) & 1) << 5); R = (st >> 1) * 16 + swz / 64; C = (st & 1) * 32 + (swz % 64) / 2; }

struct GUnit { int pm, pn, e, lt, kind; };

struct StaticSched {
    const char* Bt; int nM, nN, nwg, G, c;
    __device__ void init(const void* Bt_, int M, int N, int G_, int c_) { Bt = (const char*)Bt_; nM = M / BM; nN = N / BM; nwg = nM * nN; G = G_; c = c_; }
    __device__ __forceinline__ bool next(int i, GUnit& u) const {
        const long L = (long)i * G + c; if (L >= nwg) return false;
        int wgid = (int)L; { const int q = nwg / NXCD, r = nwg % NXCD, xcd = wgid % NXCD, off = wgid / NXCD; wgid = (xcd < r ? xcd * (q + 1) : r * (q + 1) + (xcd - r) * q) + off; }
        const int nig = WGM * nN, gid = wgid / nig, fm = gid * WGM, gsz = (nM - fm) < WGM ? (nM - fm) : WGM;
        u.pm = fm + ((wgid % nig) % gsz); u.pn = (wgid % nig) / gsz; u.e = 0; u.lt = 0; u.kind = 0; return true;
    }
    __device__ __forceinline__ void aoffs_issue(const GUnit& u, int tid, unsigned (&raw)[2][2]) const {
#pragma unroll
        for (int i = 0; i < 2; ++i) { int R, C; stage_rc(tid * 16 + i * 8192, R, C);
#pragma unroll
            for (int h = 0; h < 2; ++h) raw[h][i] = (unsigned)((u.pm * BM + h * HALF + R) * KD + C) * 2u; }
    }
    __device__ __forceinline__ void aoffs_finish(const GUnit&, int, const unsigned (&raw)[2][2], unsigned (&ao)[2][2]) const {
#pragma unroll
        for (int h = 0; h < 2; ++h)
#pragma unroll
            for (int i = 0; i < 2; ++i) ao[h][i] = raw[h][i];
    }
    __device__ __forceinline__ const char* bbase(const GUnit& u) const { return Bt + (size_t)u.pn * BM * KD * 2; }
    static constexpr int A_AUX = 0;
    __device__ __forceinline__ void wait_ready(const GUnit&, int) const {}
    __device__ __forceinline__ void publish(const GUnit&, int) const {}
};

template <class Epi, class Sched, bool F8 = false>
__device__ __forceinline__ void gemm_phase(PG8_LAS unsigned char* lds, const char* Abase, const Sched& S, const Epi& E) {
    int tid_ = threadIdx.x; asm volatile("" : "+v"(tid_));
    const int tid = tid_, wid = __builtin_amdgcn_readfirstlane(tid >> 6), lane = tid & 63, wr = wid >> 2, wc = wid & 3, fr = lane & 15, fq = lane >> 4;
    constexpr int K = KD, nt = F8 ? K / 128 : K / BK; constexpr unsigned ROWB = F8 ? 1024u : 2048u;
    unsigned voffB[2];
#pragma unroll
    for (int i = 0; i < 2; ++i) { int R, C; stage_rc(tid * 16 + i * 8192, R, C); voffB[i] = (unsigned)R * ROWB + 2u * (unsigned)C; }
    PG8_LAS u32x4* aon = (PG8_LAS u32x4*)(lds + STAGE_BYTES) + tid;
    constexpr unsigned kstep = BK * 2;
    constexpr size_t hstep = (size_t)HALF * ROWB;
    const unsigned ldsw = (unsigned)wid * 1024u;
    const int aoff = lds_byte(wr * 64 + fr, fq * 8), boff = lds_byte(wc * 32 + fr, fq * 8);
#define PG8_SA(b, h) (((b) * 2 + (h)) * HTB)
#define PG8_SB(b, h) ((4 + (b) * 2 + (h)) * HTB)
#define PG8_STAGE_B(bufoff, gbase) do { _Pragma("unroll") for (int _i = 0; _i < 2; ++_i) \
        __builtin_amdgcn_global_load_lds((const unsigned*)((const char*)(gbase) + voffB[_i]), (PG8_LAS unsigned*)(lds + (bufoff) + ldsw + _i * 8192), 16, 0, 0); } while (0)
#define PG8_STAGE_A(bufoff, o0, o1) do { \
        __builtin_amdgcn_global_load_lds((const unsigned*)(Abase + (o0)), (PG8_LAS unsigned*)(lds + (bufoff) + ldsw), 16, 0, Sched::A_AUX); \
        __builtin_amdgcn_global_load_lds((const unsigned*)(Abase + (o1)), (PG8_LAS unsigned*)(lds + (bufoff) + ldsw + 8192), 16, 0, Sched::A_AUX); } while (0)
#define PG8_LD2(p) __builtin_shufflevector(*(const PG8_LAS v4i*)(p), *(const PG8_LAS v4i*)((p) + 1024), 0, 1, 2, 3, 4, 5, 6, 7)
#define PG8_LDA(dst, b, h) do { _Pragma("unroll") for (int m = 0; m < 4; ++m) dst[m] = PG8_LD2(lds + PG8_SA(b, h) + aoff + m * 2048); } while (0)
#define PG8_LDB(dst, b, h) do { _Pragma("unroll") for (int n = 0; n < 2; ++n) dst[n] = PG8_LD2(lds + PG8_SB(b, h) + boff + n * 2048); } while (0)
#define PG8_HALF(v, k) __builtin_bit_cast(bf16x8, (v4i){(v)[4 * (k)], (v)[4 * (k) + 1], (v)[4 * (k) + 2], (v)[4 * (k) + 3]})
#define PG8_MMA(ai, bj, At, Bt) do { __builtin_amdgcn_s_setprio(1); \
        if constexpr (F8) { _Pragma("unroll") for (int m = 0; m < 4; ++m) _Pragma("unroll") for (int n = 0; n < 2; ++n) \
            asm volatile("v_mfma_scale_f32_16x16x128_f8f6f4 %0, %1, %2, %0, %3, %4 op_sel_hi:[0,0,0]" : "+v"(acc[ai][bj][m][n]) : "v"(Bt[n]), "v"(At[m]), "v"(scw), "v"(sca)); } \
        else { _Pragma("unroll") for (int m = 0; m < 4; ++m) _Pragma("unroll") for (int n = 0; n < 2; ++n) _Pragma("unroll") for (int k = 0; k < 2; ++k) \
            acc[ai][bj][m][n] = __builtin_amdgcn_mfma_f32_16x16x32_bf16(PG8_HALF(Bt[n], k), PG8_HALF(At[m], k), acc[ai][bj][m][n], 0, 0, 0); } \
        __builtin_amdgcn_s_setprio(0); } while (0)
#define PG8_WAIT_V(n) asm volatile("s_waitcnt vmcnt(" #n ")" ::: "memory")
#define PG8_WAIT_L(n) asm volatile("s_waitcnt lgkmcnt(" #n ")" ::: "memory")
#define PG8_BAR __builtin_amdgcn_s_barrier()
#define PG8_SCHED __builtin_amdgcn_sched_barrier(0)
    GUnit cur, nxt, nn; int ui = 0;
    if (!S.next(0, cur)) return;
    f32x4 acc[2][2][4][2];
#pragma unroll
    for (int a = 0; a < 2; ++a)
#pragma unroll
        for (int b = 0; b < 2; ++b)
#pragma unroll
            for (int m = 0; m < 4; ++m)
#pragma unroll
                for (int n = 0; n < 2; ++n) acc[a][b][m][n] = (f32x4){0.f, 0.f, 0.f, 0.f};
    v8i At[4], B0[2], B1[2];
    int scw = Epi::SC_W, sca = E.sc_a(cur); if constexpr (F8) asm volatile("" : "+v"(scw), "+v"(sca));
    unsigned aoC[2][2], rawN[2][2];
    S.wait_ready(cur, lane);
    { unsigned raw0[2][2]; S.aoffs_issue(cur, tid, raw0); S.aoffs_finish(cur, tid, raw0, aoC); }
    GUnit prv = cur; bool have_prv = false;
    bool has_next = S.next(1, nxt);
    if (has_next) S.aoffs_issue(nxt, tid, rawN);
    const char* cB = S.bbase(cur);
    PG8_STAGE_B(PG8_SB(0, 0), cB); PG8_STAGE_B(PG8_SB(0, 1), cB + hstep); PG8_STAGE_A(PG8_SA(0, 0), aoC[0][0], aoC[0][1]); PG8_STAGE_A(PG8_SA(0, 1), aoC[1][0], aoC[1][1]);
    if (wr == 1) PG8_BAR;
    PG8_WAIT_V(2); PG8_BAR;
    PG8_STAGE_B(PG8_SB(1, 0), cB + kstep); PG8_STAGE_A(PG8_SA(1, 0), aoC[0][0] + kstep, aoC[0][1] + kstep); PG8_STAGE_B(PG8_SB(1, 1), cB + hstep + kstep);
    PG8_WAIT_V(6); PG8_BAR;
    for (;;) {
        const bool has_nn = has_next && S.next(ui + 2, nn);
        if (has_next && nxt.kind && have_prv) { PG8_WAIT_V(0); S.publish(prv, lane); have_prv = false; }
        if (has_next) S.wait_ready(nxt, lane);
        const char* nB = cB;
        { unsigned aoN[2][2];
          if (has_next) { S.aoffs_finish(nxt, tid, rawN, aoN); nB = S.bbase(nxt); }
          else {
#pragma unroll
            for (int h = 0; h < 2; ++h)
#pragma unroll
                for (int i = 0; i < 2; ++i) aoN[h][i] = aoC[h][i];
          }
          *aon = (u32x4){aoN[0][0], aoN[0][1], aoN[1][0], aoN[1][1]}; }
        if (has_nn) S.aoffs_issue(nn, tid, rawN);
#pragma unroll 1
        for (int t = 0; t < nt; t += 2) {
            const bool last = (t == nt - 2);
            if constexpr (Epi::MID) { if (t == nt / 2) E.mid(acc, cur, wr, fr); }
            if (t == 2 && have_prv) { S.publish(prv, lane); have_prv = false; }
            if (last) E.prefetch(lds, cur, wid, lane);
            const unsigned k1 = (unsigned)(t + 1) * kstep;
            unsigned a2_00 = aoC[0][0] + (unsigned)(t + 2) * kstep, a2_01 = aoC[0][1] + (unsigned)(t + 2) * kstep, a2_10 = aoC[1][0] + (unsigned)(t + 2) * kstep, a2_11 = aoC[1][1] + (unsigned)(t + 2) * kstep;
            if (last) { const u32x4 v = *aon; a2_00 = v.x; a2_01 = v.y; a2_10 = v.z; a2_11 = v.w; }
            const char* b2 = last ? nB : cB + (size_t)(t + 2) * kstep; const char* b3 = b2 + kstep;
            PG8_LDB(B0, 0, 0); PG8_LDB(B1, 0, 1); PG8_SCHED; PG8_LDA(At, 0, 0); PG8_STAGE_A(PG8_SA(1, 1), aoC[1][0] + k1, aoC[1][1] + k1);
            PG8_WAIT_V(8); PG8_WAIT_L(0); PG8_BAR; PG8_MMA(0, 0, At, B0); PG8_MMA(0, 1, At, B1); PG8_BAR; PG8_SCHED;
            PG8_LDA(At, 0, 1); PG8_STAGE_B(PG8_SB(0, 0), b2); PG8_STAGE_B(PG8_SB(0, 1), b2 + hstep); PG8_STAGE_A(PG8_SA(0, 0), a2_00, a2_01);
            PG8_WAIT_V(8); PG8_WAIT_L(0); PG8_BAR; PG8_MMA(1, 0, At, B0); PG8_MMA(1, 1, At, B1); PG8_BAR; PG8_SCHED;
            PG8_LDB(B0, 1, 0); PG8_LDB(B1, 1, 1); PG8_SCHED; PG8_LDA(At, 1, 0); PG8_STAGE_A(PG8_SA(0, 1), a2_10, a2_11);
            PG8_WAIT_V(8); PG8_WAIT_L(0); PG8_BAR; PG8_MMA(0, 0, At, B0); PG8_MMA(0, 1, At, B1); PG8_BAR; PG8_SCHED;
            PG8_LDA(At, 1, 1); PG8_STAGE_B(PG8_SB(1, 0), b3); PG8_STAGE_B(PG8_SB(1, 1), b3 + hstep); PG8_STAGE_A(PG8_SA(1, 0), a2_00 + kstep, a2_01 + kstep);
            PG8_WAIT_V(8); PG8_WAIT_L(0); PG8_BAR; PG8_MMA(1, 0, At, B0); PG8_MMA(1, 1, At, B1); PG8_BAR; PG8_SCHED;
        }
        if constexpr (F8) asm volatile("s_nop 15\n\ts_nop 15" ::: "memory");
        if (wr == 0) PG8_BAR;
        E(acc, cur, lds, wr, wc, fr, fq);
        prv = cur; have_prv = true;
        if (!has_next) break;
#pragma unroll
        for (int a = 0; a < 2; ++a)
#pragma unroll
            for (int b = 0; b < 2; ++b)
#pragma unroll
                for (int m = 0; m < 4; ++m)
#pragma unroll
                    for (int n = 0; n < 2; ++n) acc[a][b][m][n] = (f32x4){0.f, 0.f, 0.f, 0.f};
        cur = nxt; nxt = nn; has_next = has_nn; cB = nB; ++ui;
        if constexpr (F8) { sca = E.sc_a(cur); asm volatile("" : "+v"(sca)); }
        { const u32x4 v = *aon; aoC[0][0] = v.x; aoC[0][1] = v.y; aoC[1][0] = v.z; aoC[1][1] = v.w; }
        if (wr == 1) PG8_BAR;
    }
    PG8_WAIT_V(0);
    if (have_prv) S.publish(prv, lane);
    PG8_BAR;
#undef PG8_SA
#undef PG8_SB
#undef PG8_STAGE_A
#undef PG8_STAGE_B
#undef PG8_LDA
#undef PG8_LDB
#undef PG8_MMA
#undef PG8_LD2
#undef PG8_HALF
#undef PG8_WAIT_V
#undef PG8_WAIT_L
#undef PG8_BAR
#undef PG8_SCHED
}
}
namespace pg8 {
using namespace mk;
__device__ __forceinline__ unsigned cvt_pk_bf16(float lo, float hi) { unsigned r; asm volatile("v_cvt_pk_bf16_f32 %0, %1, %2" : "=v"(r) : "v"(lo), "v"(hi)); return r; }

struct EpiInProj {
    static constexpr bool MID = false; static constexpr int SC_W = 0x7F7F7F7F, SC_A = 0x7F7F7F7F;
    __device__ __forceinline__ void prefetch(PG8_LAS unsigned char*, const GUnit&, int, int) const {}
    __device__ __forceinline__ int sc_a(const GUnit&) const { return SC_A; }
    bf16_t *Q, *Kb, *V, *LX, *LG; const float *qg, *kg, *rope;
    __device__ __forceinline__ void operator()(const f32x4 (&acc)[2][2][4][2], const GUnit& u, PG8_LAS unsigned char* lds, int wr, int wc, int fr_, int fq_) const {
        int fr = fr_, fq = fq_; asm volatile("" : "+v"(fr), "+v"(fq));
        const int row0 = u.pm * BM + wr * 64 + fr;
        if (u.pn >= 3) {
            bf16_t* base = (u.pn < 5) ? LX : LG; const int col0 = ((u.pn - 3) & 1) * 256 + wc * 32 + 8 * fq;
#pragma unroll
            for (int ai = 0; ai < 2; ++ai)
#pragma unroll
                for (int m = 0; m < 4; ++m) { bf16_t* rowp = base + (size_t)(row0 + ai * HALF + m * 16) * 512 + col0;
#pragma unroll
                    for (int bj = 0; bj < 2; ++bj) { const f32x4 v0 = acc[ai][bj][m][0], v1 = acc[ai][bj][m][1];
                        u32x4 w; w.x = cvt_pk_bf16(v0[0], v0[1]); w.y = cvt_pk_bf16(v0[2], v0[3]); w.z = cvt_pk_bf16(v1[0], v1[1]); w.w = cvt_pk_bf16(v1[2], v1[3]);
                        st16_wt<WT_EPI>(rowp + bj * HALF, w); } }
            return;
        }
        if (u.pn == 2 && wc >= 2) {
#pragma unroll
            for (int ai = 0; ai < 2; ++ai)
#pragma unroll
                for (int m = 0; m < 4; ++m) { bf16_t* rowp = V + (size_t)(row0 + ai * HALF + m * 16) * 128 + 64 * (wc - 2) + 4 * fq;
#pragma unroll
                    for (int bj = 0; bj < 2; ++bj)
#pragma unroll
                        for (int n = 0; n < 2; ++n) { const f32x4 v = acc[ai][bj][m][n]; u32x2 w; w.x = cvt_pk_bf16(v[0], v[1]); w.y = cvt_pk_bf16(v[2], v[3]); *(u32x2*)(rowp + 32 * bj + 16 * n) = w; } }
            return;
        }
        const bool isq = u.pn < 2; const float* gp = (isq ? qg : kg) + 4 * fq; const float osc = isq ? C2 : 1.0f;
#pragma unroll
        for (int ai = 0; ai < 2; ++ai)
#pragma unroll
            for (int m = 0; m < 4; ++m) {
                const int t = row0 + ai * HALF + m * 16;
                float ss = 0.f;
#pragma unroll
                for (int bj = 0; bj < 2; ++bj)
#pragma unroll
                    for (int n = 0; n < 2; ++n) { const f32x4 v = acc[ai][bj][m][n]; ss += (v[0] * v[0] + v[1] * v[1]) + (v[2] * v[2] + v[3] * v[3]); }
                ss += __shfl_xor(ss, 16); ss += __shfl_xor(ss, 32);
                const float rs = osc / sqrtf(ss * (1.0f / 64.0f) + 1e-6f);
                const int s = t & (S - 1), posr = s >> 6, posc = s & 63;
                bf16_t* rowp = isq ? Q + (size_t)t * 512 + 64 * (4 * u.pn + wc) + 4 * fq : Kb + (size_t)t * 128 + 64 * wc + 4 * fq;
#pragma unroll
                for (int bj = 0; bj < 2; ++bj) {
                    const int pos = bj ? posc : posr;
                    const f32x4 c4 = *(const f32x4*)(rope + pos * 16 + 4 * fq), s4 = *(const f32x4*)(rope + 2048 + pos * 16 + 4 * fq);
                    const f32x4 g0 = *(const f32x4*)(gp + 32 * bj), g1 = *(const f32x4*)(gp + 32 * bj + 16);
                    const f32x4 x1 = acc[ai][bj][m][0] * g0 * rs, x2 = acc[ai][bj][m][1] * g1 * rs;
                    const f32x4 o1 = x1 * c4 - x2 * s4, o2 = x2 * c4 + x1 * s4;
                    u32x2 w1, w2; w1.x = cvt_pk_bf16(o1[0], o1[1]); w1.y = cvt_pk_bf16(o1[2], o1[3]); w2.x = cvt_pk_bf16(o2[0], o2[1]); w2.y = cvt_pk_bf16(o2[2], o2[3]);
                    *(u32x2*)(rowp + 32 * bj) = w1; *(u32x2*)(rowp + 32 * bj + 16) = w2;
                }
                asm volatile("" ::: "memory");
            }
    }
};

struct EpiOut {
    static constexpr bool MID = true; static constexpr int SC_W = 0x7F7F7F7F, SC_A = 0x7F7F7F7F;
    __device__ __forceinline__ void prefetch(PG8_LAS unsigned char*, const GUnit&, int, int) const {}
    __device__ __forceinline__ int sc_a(const GUnit&) const { return SC_A; }
    const float* x; const float* SSQ; float* X1; unsigned char* X1F8;
    __device__ __forceinline__ void mid(f32x4 (&acc)[2][2][4][2], const GUnit& u, int wr, int fr_) const {
        int fr = fr_; asm volatile("" : "+v"(fr));
#pragma unroll
        for (int ai = 0; ai < 2; ++ai)
#pragma unroll
            for (int m = 0; m < 4; ++m) {
                const float* p = SSQ + (size_t)(u.pm * BM + ai * HALF + wr * 64 + m * 16 + fr) * 8;
                const f32x4 a = *(const f32x4*)p, b = *(const f32x4*)(p + 4);
                const float s = ((a[0] + a[1]) + (a[2] + a[3])) + ((b[0] + b[1]) + (b[2] + b[3]));
                const float sa = 1.0f / sqrtf(s * (1.0f / 512.0f) + 1e-5f);
#pragma unroll
                for (int bj = 0; bj < 2; ++bj)
#pragma unroll
                    for (int n = 0; n < 2; ++n) acc[ai][bj][m][n] *= sa;
            }
    }
    __device__ __forceinline__ void operator()(const f32x4 (&acc)[2][2][4][2], const GUnit& u, PG8_LAS unsigned char* lds, int wr, int wc, int fr_, int fq_) const {
        int fr = fr_, fq = fq_; asm volatile("" : "+v"(fr), "+v"(fq));
        const int row0 = u.pm * BM + wr * 64 + fr, col0 = u.pn * BM + wc * 32 + 8 * fq;
#pragma unroll
        for (int ai = 0; ai < 2; ++ai)
#pragma unroll
            for (int m = 0; m < 4; ++m) { const size_t off = (size_t)(row0 + ai * HALF + m * 16) * D + col0;
#pragma unroll
                for (int bj = 0; bj < 2; ++bj) {
                    const f32x4 v0 = __builtin_nontemporal_load((const f32x4*)(x + off + bj * HALF)) + acc[ai][bj][m][0], v1 = __builtin_nontemporal_load((const f32x4*)(x + off + bj * HALF + 4)) + acc[ai][bj][m][1];
                    st16_wt<WT_EPI>(X1 + off + bj * HALF, __builtin_bit_cast(u32x4, v0)); st16_wt<WT_EPI>(X1 + off + bj * HALF + 4, __builtin_bit_cast(u32x4, v1));
                    int w0 = 0, w1 = 0; w0 = __builtin_amdgcn_cvt_pk_fp8_f32(v0[0], v0[1], w0, false); w0 = __builtin_amdgcn_cvt_pk_fp8_f32(v0[2], v0[3], w0, true);
                    w1 = __builtin_amdgcn_cvt_pk_fp8_f32(v1[0], v1[1], w1, false); w1 = __builtin_amdgcn_cvt_pk_fp8_f32(v1[2], v1[3], w1, true);
                    *(u32x2*)(X1F8 + off + bj * HALF) = (u32x2){(unsigned)w0, (unsigned)w1}; }
                if (m & 1) asm volatile("" ::: "memory"); }
    }
};

struct MoeSched {
    const PG8_LAS unsigned* P;
    const PG8_LAS unsigned* cntl;
    const PG8_LAS unsigned char* te;
    const int* list; const char* Bt; size_t estride; int ntn, G, vcu; bool gather;
    __device__ __forceinline__ bool next(int i, GUnit& u) const {
        const unsigned L = (unsigned)i * (unsigned)G + (unsigned)vcu; const unsigned mt = L / (unsigned)ntn;
        const unsigned tot = (unsigned)__builtin_amdgcn_readfirstlane((int)P[NE]);
        if (mt >= tot) return false;
        const int e = __builtin_amdgcn_readfirstlane((int)te[mt]);
        u.kind = 0; u.pm = (int)mt; u.pn = (int)(L % (unsigned)ntn); u.e = e; u.lt = (int)(mt - (unsigned)__builtin_amdgcn_readfirstlane((int)P[e])); return true;
    }
    __device__ __forceinline__ void aoffs_issue(const GUnit& u, int tid, unsigned (&raw)[2][2]) const {
        const int n = (int)cntl[u.e] - u.lt * BM;
#pragma unroll
        for (int i = 0; i < 2; ++i) { int R, C; stage_rc(tid * 16 + i * 8192, R, C);
#pragma unroll
            for (int h = 0; h < 2; ++h) {
                const int rr = h * HALF + R;
                if (gather) { raw[h][i] = 0u; if (rr < n) raw[h][i] = (unsigned)list[(size_t)u.e * T + u.lt * BM + rr]; }
                else raw[h][i] = (unsigned)(u.pm * BM + rr);
            } }
    }
    __device__ __forceinline__ void aoffs_finish(const GUnit&, int tid, const unsigned (&raw)[2][2], unsigned (&ao)[2][2]) const {
#pragma unroll
        for (int i = 0; i < 2; ++i) { int R, C; stage_rc(tid * 16 + i * 8192, R, C);
#pragma unroll
            for (int h = 0; h < 2; ++h) ao[h][i] = (gather ? (raw[h][i] >> 2) : raw[h][i]) * 1024u + 2u * (unsigned)C; }
    }
    __device__ __forceinline__ const char* bbase(const GUnit& u) const { return Bt + (size_t)u.e * estride + (size_t)u.pn * BM * 1024; }
    static constexpr int A_AUX = 0;
    __device__ __forceinline__ void wait_ready(const GUnit&, int) const {}
    __device__ __forceinline__ void publish(const GUnit&, int) const {}
};

struct EpiMoe1 {
    static constexpr bool MID = false; static constexpr int SC_W = 0x7A7A7A7A, SC_A = 0x7F7F7F7F;
    const PG8_LAS unsigned* cntl; const float* listr; const float* bg; const float* bu; unsigned char* H;
    __device__ __forceinline__ int sc_a(const GUnit&) const { return SC_A; }
    static constexpr int PRE_OFF = STAGE_BYTES + 8192;
    __device__ __forceinline__ void prefetch(PG8_LAS unsigned char* lds, const GUnit& u, int wid, int lane) const {
        if (wid < 4) { const int nvalid = (int)cntl[u.e] - u.lt * BM; int r = wid * 64 + lane; r = r < nvalid ? r : 0;
            __builtin_amdgcn_global_load_lds((const unsigned*)(listr + (size_t)u.e * T + u.lt * BM + r), (PG8_LAS unsigned*)(lds + PRE_OFF + wid * 256), 4, 0, 0); }
    }
    __device__ __forceinline__ void operator()(const f32x4 (&acc)[2][2][4][2], const GUnit& u, PG8_LAS unsigned char* lds, int wr, int wc, int fr_, int fq_) const {
        int fr = fr_, fq = fq_; asm volatile("" : "+v"(fr), "+v"(fq));
        const int nvalid = (int)cntl[u.e] - u.lt * BM; const int hc0 = u.pn * HALF + wc * 32 + 8 * fq;
        f32x4 bgv[2], buv[2];
#pragma unroll
        for (int n = 0; n < 2; ++n) { bgv[n] = *(const f32x4*)(bg + u.e * D + hc0 + 4 * n); buv[n] = *(const f32x4*)(bu + u.e * D + hc0 + 4 * n); }
#pragma unroll
        for (int ai = 0; ai < 2; ++ai)
#pragma unroll
            for (int m = 0; m < 4; ++m) {
                const int rl = ai * HALF + wr * 64 + m * 16 + fr;
                if (rl < nvalid) {
                    const float rs = *(const PG8_LAS float*)(lds + PRE_OFF + rl * 4);
                    int w[2] = {0, 0};
#pragma unroll
                    for (int n = 0; n < 2; ++n) {
                        f32x4 g = acc[ai][0][m][n] * rs + bgv[n], uu = acc[ai][1][m][n] * rs + buv[n], hv;
#pragma unroll
                        for (int e = 0; e < 4; ++e) { const float gc = fminf(g[e], 7.0f), uc = fminf(fmaxf(uu[e], -7.0f), 7.0f);
                            const float sg = __builtin_amdgcn_rcpf(1.0f + __builtin_amdgcn_exp2f(-1.702f * 1.4426950408889634f * gc)); hv[e] = (uc + 1.0f) * gc * sg; }
                        w[n] = __builtin_amdgcn_cvt_pk_fp8_f32(4.0f * hv[0], 4.0f * hv[1], w[n], false); w[n] = __builtin_amdgcn_cvt_pk_fp8_f32(4.0f * hv[2], 4.0f * hv[3], w[n], true);
                    }
#if MOE_MERGE
                    __hip_atomic_store((unsigned long long*)(H + (size_t)(u.pm * BM + rl) * 1024 + hc0), (unsigned long long)(unsigned)w[0] | ((unsigned long long)(unsigned)w[1] << 32), __ATOMIC_RELAXED, __HIP_MEMORY_SCOPE_AGENT);
#else
                    *(u32x2*)(H + (size_t)(u.pm * BM + rl) * 1024 + hc0) = (u32x2){(unsigned)w[0], (unsigned)w[1]};
#endif
                }
            }
    }
};
struct EpiMoe2 {
    static constexpr bool MID = false; static constexpr int SC_W = 0x7A7A7A7A, SC_A = 0x7D7D7D7D;
    const PG8_LAS unsigned* cntl; const int* list; const float* listg; const float* bd; unsigned char* Y;
    __device__ __forceinline__ int sc_a(const GUnit&) const { return SC_A; }
    static constexpr int PRE_OFF = STAGE_BYTES + 8192;
    __device__ __forceinline__ void prefetch(PG8_LAS unsigned char* lds, const GUnit& u, int wid, int lane) const {
        const int nvalid = (int)cntl[u.e] - u.lt * BM; int r = (wid & 3) * 64 + lane; r = r < nvalid ? r : 0;
        const size_t pos = (size_t)u.e * T + u.lt * BM + r;
        const unsigned* src = (wid < 4) ? (const unsigned*)(list + pos) : (const unsigned*)(listg + pos);
        __builtin_amdgcn_global_load_lds(src, (PG8_LAS unsigned*)(lds + PRE_OFF + (wid >> 2) * 1024 + (wid & 3) * 256), 4, 0, 0);
    }
    __device__ __forceinline__ void operator()(const f32x4 (&acc)[2][2][4][2], const GUnit& u, PG8_LAS unsigned char* lds, int wr, int wc, int fr_, int fq_) const {
        int fr = fr_, fq = fq_; asm volatile("" : "+v"(fr), "+v"(fq));
        const int nvalid = (int)cntl[u.e] - u.lt * BM; const int c0 = u.pn * BM + wc * 64 + 16 * fq;
        f32x4 bv[2][2];
#pragma unroll
        for (int bj = 0; bj < 2; ++bj)
#pragma unroll
            for (int n = 0; n < 2; ++n) bv[bj][n] = *(const f32x4*)(bd + u.e * D + c0 + 8 * bj + 4 * n);
#pragma unroll
        for (int ai = 0; ai < 2; ++ai)
#pragma unroll
            for (int m = 0; m < 4; ++m) {
                const int rl = ai * HALF + wr * 64 + m * 16 + fr;
                if (rl < nvalid) {
                    const int id = *(const PG8_LAS int*)(lds + PRE_OFF + rl * 4); const float gv = 16.0f * *(const PG8_LAS float*)(lds + PRE_OFF + 1024 + rl * 4);
                    int w[4];
#pragma unroll
                    for (int bj = 0; bj < 2; ++bj)
#pragma unroll
                        for (int n = 0; n < 2; ++n) { const f32x4 v = (acc[ai][bj][m][n] + bv[bj][n]) * gv; int t = 0;
                            t = __builtin_amdgcn_cvt_pk_fp8_f32(v[0], v[1], t, false); t = __builtin_amdgcn_cvt_pk_fp8_f32(v[2], v[3], t, true); w[2 * bj + n] = t; }
                    st16_wt<WT_EPI>(Y + (size_t)id * D + c0, (u32x4){(unsigned)w[0], (unsigned)w[1], (unsigned)w[2], (unsigned)w[3]});
                }
            }
    }
};

struct MoeSchedM {
    const PG8_LAS unsigned* P; const PG8_LAS unsigned* cntl; const PG8_LAS unsigned char* te;
    const int* list; unsigned* ready; unsigned* tmo; unsigned char* ws; int G, vcu;
    static constexpr int A_AUX = 16;
    __device__ __forceinline__ bool next(int i, GUnit& u) const {
        const unsigned L = (unsigned)i * (unsigned)G + (unsigned)vcu; const unsigned tot = (unsigned)__builtin_amdgcn_readfirstlane((int)P[NE]);
        unsigned mt;
        if (L < tot * 8u) { u.kind = 0; mt = L >> 3; u.pn = (int)(L & 7u); }
        else { const unsigned L2 = L - tot * 8u; if (L2 >= tot * 4u) return false; u.kind = 1; mt = L2 >> 2; u.pn = (int)(L2 & 3u); }
        const int e = __builtin_amdgcn_readfirstlane((int)te[mt]);
        u.pm = (int)mt; u.e = e; u.lt = (int)(mt - (unsigned)__builtin_amdgcn_readfirstlane((int)P[e])); return true;
    }
    __device__ __forceinline__ void aoffs_issue(const GUnit& u, int tid, unsigned (&raw)[2][2]) const {
        const int n = (int)cntl[u.e] - u.lt * BM;
#pragma unroll
        for (int i = 0; i < 2; ++i) { int R, C; stage_rc(tid * 16 + i * 8192, R, C);
#pragma unroll
            for (int h = 0; h < 2; ++h) { const int rr = h * HALF + R;
                if (u.kind == 0) { raw[h][i] = 0u; if (rr < n) raw[h][i] = (unsigned)list[(size_t)u.e * T + u.lt * BM + rr]; }
                else raw[h][i] = (unsigned)(u.pm * BM + rr); } }
    }
    __device__ __forceinline__ void aoffs_finish(const GUnit& u, int tid, const unsigned (&raw)[2][2], unsigned (&ao)[2][2]) const {
#pragma unroll
        for (int i = 0; i < 2; ++i) { int R, C; stage_rc(tid * 16 + i * 8192, R, C);
#pragma unroll
            for (int h = 0; h < 2; ++h) ao[h][i] = (u.kind == 0 ? (unsigned)WS_X1B + (raw[h][i] >> 2) * 1024u : (unsigned)WS_H + raw[h][i] * 1024u) + 2u * (unsigned)C; }
    }
    __device__ __forceinline__ const char* bbase(const GUnit& u) const {
        return (const char*)ws + (u.kind == 0 ? WS_BT1 + (size_t)u.e * 2048 * 1024 : WS_BT2 + (size_t)u.e * 1024 * 1024) + (size_t)u.pn * BM * 1024; }
    __device__ __forceinline__ void wait_ready(const GUnit& u, int lane) const {
        if (u.kind == 0) return;
        unsigned* p = ready + 64 * u.pm; unsigned sp = 0;
        while ((unsigned)__builtin_amdgcn_readfirstlane((int)__hip_atomic_load(p, __ATOMIC_RELAXED, __HIP_MEMORY_SCOPE_AGENT)) < 64u) {
            __builtin_amdgcn_s_sleep(2);
            if (++sp > (1u << 20)) { if (lane == 0) __hip_atomic_store(tmo, 0x6000u | (unsigned)u.pm, __ATOMIC_RELAXED, __HIP_MEMORY_SCOPE_AGENT); break; }
        }
    }
    __device__ __forceinline__ void publish(const GUnit& u, int lane) const {
        if (u.kind == 0 && lane == 0) __hip_atomic_fetch_add(ready + 64 * u.pm, 1u, __ATOMIC_RELAXED, __HIP_MEMORY_SCOPE_AGENT);
    }
};
struct EpiMoeM {
    static constexpr bool MID = false; static constexpr int SC_W = 0x7A7A7A7A, SC_A = 0x7F7F7F7F;
    EpiMoe1 e1; EpiMoe2 e2;
    __device__ __forceinline__ int sc_a(const GUnit& u) const { return u.kind ? EpiMoe2::SC_A : EpiMoe1::SC_A; }
    __device__ __forceinline__ void prefetch(PG8_LAS unsigned char* lds, const GUnit& u, int wid, int lane) const { if (u.kind) e2.prefetch(lds, u, wid, lane); else e1.prefetch(lds, u, wid, lane); }
    __device__ __forceinline__ void operator()(const f32x4 (&acc)[2][2][4][2], const GUnit& u, PG8_LAS unsigned char* lds, int wr, int wc, int fr, int fq) const {
        if (u.kind) e2(acc, u, lds, wr, wc, fr, fq); else e1(acc, u, lds, wr, wc, fr, fq);
    }
};
}
namespace attn_body {
using bf16 = __hip_bfloat16;
using bf16x8 = __attribute__((ext_vector_type(8))) short;
using s16x4 = __attribute__((ext_vector_type(4))) short;
using f32x16 = __attribute__((ext_vector_type(16))) float;
using u32x4 = __attribute__((ext_vector_type(4))) unsigned;
constexpr int SEQ = mk::S, D = 64, QP = 512, KP = 128, OP = 1024;
constexpr int NW = 8, QBLK = 32, QB = QBLK * NW, KVBLK = 64, NT = SEQ / KVBLK;
__device__ __forceinline__ int crow(int r, int hi) { return (r & 3) + 8 * (r >> 2) + 4 * hi; }
#define SBAR() __builtin_amdgcn_sched_barrier(0)
constexpr int NSLOT = 3, SLOTB = 8192;
constexpr int LDS_K = 0, LDS_V = NSLOT * SLOTB, LDS_WS = 2 * NSLOT * SLOTB, LDS_OST = LDS_WS + NW * 64 * 4, LDS_BYTES = LDS_OST + NW * 4096;
__device__ __forceinline__ void glds16(const void* gsrc, unsigned lds_dst) { unsigned keep;
    asm volatile("s_mov_b32 %0, m0\n\ts_mov_b32 m0, %2\n\ts_nop 0\n\tglobal_load_lds_dwordx4 %1, off\n\ts_mov_b32 m0, %0" : "=&s"(keep) : "v"(gsrc), "s"(lds_dst) : "memory"); }
__device__ __forceinline__ float max3f(float a, float b, float c) { float r; asm("v_max3_f32 %0, %1, %2, %3" : "=v"(r) : "v"(a), "v"(b), "v"(c)); return r; }
__device__ __forceinline__ float max2f(float a, float b) { float r; asm("v_max_f32_e32 %0, %1, %2" : "=v"(r) : "v"(a), "v"(b)); return r; }
__device__ __forceinline__ float fadd_s(float a, float b) { float r; asm("v_add_f32_e32 %0, %1, %2" : "=v"(r) : "v"(a), "v"(b)); return r; }
__device__ __forceinline__ float fsub_s(float a, float b) { float r; asm("v_sub_f32_e32 %0, %1, %2" : "=v"(r) : "v"(a), "v"(b)); return r; }
typedef float f32x2_t __attribute__((ext_vector_type(2))); typedef __bf16 bf16x2_t __attribute__((ext_vector_type(2)));
__device__ __forceinline__ unsigned cvtpk_s(float lo, float hi) { f32x2_t v = {lo, hi}; bf16x2_t b = __builtin_convertvector(v, bf16x2_t); return __builtin_bit_cast(unsigned, b); }
#define WAIT_BAR(N) asm volatile("s_waitcnt vmcnt(" #N ") lgkmcnt(0)\n\ts_barrier" ::: "memory")

__device__ __forceinline__ void qkt(f32x16& p0, f32x16& p1, const char* Kslot, const bf16x8* qr, const f32x16& negm, int r32, int hi) {
    const char* kb = Kslot + hi * 1024 + r32 * 16;
#pragma unroll
    for (int d0 = 0; d0 < 4; ++d0) {
        const bf16x8 b0 = *reinterpret_cast<const bf16x8*>(kb + d0 * 2048);
        const bf16x8 b1 = *reinterpret_cast<const bf16x8*>(kb + d0 * 2048 + 512);
        if (d0 == 0) { p0 = __builtin_amdgcn_mfma_f32_32x32x16_bf16(b0, qr[0], negm, 0, 0, 0); p1 = __builtin_amdgcn_mfma_f32_32x32x16_bf16(b1, qr[0], negm, 0, 0, 0); }
        else { p0 = __builtin_amdgcn_mfma_f32_32x32x16_bf16(b0, qr[d0], p0, 0, 0, 0); p1 = __builtin_amdgcn_mfma_f32_32x32x16_bf16(b1, qr[d0], p1, 0, 0, 0); } }
}
typedef __attribute__((address_space(3))) const char* lds_cptr;
typedef short v4i16_t __attribute__((ext_vector_type(4)));
__device__ __forceinline__ void kload8(bf16x8* kf, lds_cptr kp) {
    kf[0] = *(const __attribute__((address_space(3))) bf16x8*)(kp);        kf[1] = *(const __attribute__((address_space(3))) bf16x8*)(kp + 512);
    kf[2] = *(const __attribute__((address_space(3))) bf16x8*)(kp + 2048); kf[3] = *(const __attribute__((address_space(3))) bf16x8*)(kp + 2560);
    kf[4] = *(const __attribute__((address_space(3))) bf16x8*)(kp + 4096); kf[5] = *(const __attribute__((address_space(3))) bf16x8*)(kp + 4608);
    kf[6] = *(const __attribute__((address_space(3))) bf16x8*)(kp + 6144); kf[7] = *(const __attribute__((address_space(3))) bf16x8*)(kp + 6656);
}
__device__ __forceinline__ void kload2(bf16x8* kf, lds_cptr kp, int j) { kf[2 * j] = *(const __attribute__((address_space(3))) bf16x8*)(kp + j * 2048); kf[2 * j + 1] = *(const __attribute__((address_space(3))) bf16x8*)(kp + j * 2048 + 512); }
__device__ __forceinline__ s16x4 vtr(lds_cptr p) { return __builtin_bit_cast(s16x4, __builtin_amdgcn_ds_read_tr16_b64_v4i16((__attribute__((address_space(3))) v4i16_t*)p)); }
__device__ __forceinline__ float rowmax(const f32x16& p0, const f32x16& p1) {
    float a = max3f(p0[0], p0[1], p1[0]), b = max3f(p0[2], p0[3], p1[1]); a = max3f(a, p1[2], p1[3]);
#pragma unroll
    for (int r = 4; r < 16; r += 4) { a = max3f(a, p0[r], p0[r + 1]); b = max3f(b, p0[r + 2], p0[r + 3]); a = max3f(a, p1[r], p1[r + 1]); b = max3f(b, p1[r + 2], p1[r + 3]); }
    const float m = max2f(a, b);
    auto rr = __builtin_amdgcn_permlane32_swap(__float_as_uint(m), __float_as_uint(m), false, false);
    return max2f(__uint_as_float(rr[0]), __uint_as_float(rr[1]));
}
__device__ __forceinline__ void pv(f32x16* o, int vb, bf16x8 pa0, bf16x8 pa1, bf16x8 pa2, bf16x8 pa3) {
#pragma unroll
    for (int d0 = 0; d0 < 2; ++d0) { s16x4 lo[4], hi[4];
#pragma unroll
        for (int ks = 0; ks < 4; ++ks) {
            asm volatile("ds_read_b64_tr_b16 %0,%1 offset:%c2" : "=&v"(lo[ks]) : "v"(vb), "i"(d0 * 4096 + ks * 1024) : "memory");
            asm volatile("ds_read_b64_tr_b16 %0,%1 offset:%c2" : "=&v"(hi[ks]) : "v"(vb), "i"(d0 * 4096 + ks * 1024 + 512) : "memory"); }
        asm volatile("s_waitcnt lgkmcnt(0)" ::: "memory"); SBAR();
#define PK(k) (bf16x8){lo[k][0], lo[k][1], lo[k][2], lo[k][3], hi[k][0], hi[k][1], hi[k][2], hi[k][3]}
        o[d0] = __builtin_amdgcn_mfma_f32_32x32x16_bf16(pa0, PK(0), o[d0], 0, 0, 0);
        o[d0] = __builtin_amdgcn_mfma_f32_32x32x16_bf16(pa1, PK(1), o[d0], 0, 0, 0);
        o[d0] = __builtin_amdgcn_mfma_f32_32x32x16_bf16(pa2, PK(2), o[d0], 0, 0, 0);
        o[d0] = __builtin_amdgcn_mfma_f32_32x32x16_bf16(pa3, PK(3), o[d0], 0, 0, 0);
#undef PK
    }
}

template <int THRL, bool FIXREF> __device__ __forceinline__ void attn_unit(int b, int h, int qb, const bf16* Q, const bf16* __restrict__ K, const bf16* __restrict__ V, bf16* O, float* SSQ, char* shm, float mref) {
    int tid_ = threadIdx.x; asm volatile("" : "+v"(tid_));
    const int tid = tid_, lane = tid & 63, r32 = lane & 31, hi = lane >> 5; const int wid = __builtin_amdgcn_readfirstlane(tid >> 6);
    const long rowbase = (long)b * SEQ; const int q0 = qb * QB; const int kvh = h >> 2;
    const bf16* Qw = Q + (rowbase + q0 + wid * QBLK) * QP + h * D;
    const bf16 *Kh = K + rowbase * KP + kvh * D, *Vh = V + rowbase * KP + kvh * D;
    const unsigned lds0 = (unsigned)(uintptr_t)shm;
    float* wsf = (float*)(shm + LDS_WS) + wid * 64;
    const bf16* ksrc = Kh + (long)lane * KP + wid * 8;
    const bf16* vsrc = Vh + (long)(16 * (wid & 3) + (lane >> 2)) * KP + (wid >> 2) * 32 + (lane & 3) * 8;
    const unsigned kdst = lds0 + LDS_K + wid * 1024, vdst = lds0 + LDS_V + wid * 1024;
#define DMA_K(t, slot) glds16(ksrc + (long)(t) * KVBLK * KP, (unsigned)__builtin_amdgcn_readfirstlane(kdst + (slot)))
#define DMA_V(t, slot) glds16(vsrc + (long)(t) * KVBLK * KP, (unsigned)__builtin_amdgcn_readfirstlane(vdst + (slot)))
    const int vb0 = (int)(lds0 + LDS_V) + ((lane >> 4) & 1) * 32 + (lane & 3) * 8 + (4 * hi + ((lane & 15) >> 2)) * 64;
    const char* Kbase = shm + LDS_K; bf16x8 kf[8];
    const lds_cptr shm3 = (lds_cptr)shm; const lds_cptr kp0 = shm3 + LDS_K + hi * 1024 + r32 * 16; const lds_cptr vp0 = shm3 + LDS_V + ((lane >> 4) & 1) * 32 + (lane & 3) * 8 + (4 * hi + ((lane & 15) >> 2)) * 64;
    DMA_K(0, 0); DMA_V(0, 0); DMA_K(1, SLOTB);
    bf16x8 qr[4];
#pragma unroll
    for (int d0 = 0; d0 < 4; ++d0) qr[d0] = __builtin_nontemporal_load(reinterpret_cast<const bf16x8*>(&Qw[(long)r32 * QP + d0 * 16 + hi * 8]));
    float mhat = 0.f, l_reg = 0.f; f32x16 o[2]; o[0] = f32x16{}; o[1] = f32x16{}; f32x16 negm = f32x16{}; asm volatile("" : "+v"(negm));
    bool resc = false;
#define START(P0, P1) do { const float rm = FIXREF ? mref : rowmax(P0, P1); resc = false; \
    { const float dl = rm; mhat = fadd_s(mhat, dl); \
      _Pragma("unroll") for (int r = 0; r < 16; ++r) { P0[r] = fsub_s(P0[r], dl); P1[r] = fsub_s(P1[r], dl); } \
      _Pragma("unroll") for (int r = 0; r < 16; ++r) negm[r] = -mhat; asm volatile("" : "+v"(negm)); } \
    _Pragma("unroll") for (int r = 0; r < 16; ++r) P0[r] = __builtin_amdgcn_exp2f(P0[r]); } while (0)
#define RESC() do { if (!FIXREF && resc) { asm volatile("s_waitcnt lgkmcnt(0)" ::: "memory"); \
      _Pragma("unroll") for (int d_ = 0; d_ < 2; ++d_) _Pragma("unroll") for (int r = 0; r < 16; ++r) o[d_][r] *= wsf[crow(r, hi)]; } } while (0)
    f32x16 pA0, pA1, pB0, pB1;
    int sl_prev = 0, sl_cur = 0, sl_next = SLOTB;
#define ROT() do { sl_prev = sl_cur; sl_cur = sl_next; sl_next = (sl_next == (NSLOT - 1) * SLOTB) ? 0 : sl_next + SLOTB; } while (0)
    DMA_K(2, 2 * SLOTB);
    WAIT_BAR(3);
    qkt(pA0, pA1, Kbase, qr, negm, r32, hi); asm volatile("s_nop 15\n\ts_nop 7" : "+v"(pA0), "+v"(pA1));
    START(pA0, pA1);
    _Pragma("unroll") for (int r = 0; r < 16; ++r) pA1[r] = __builtin_amdgcn_exp2f(pA1[r]);
    WAIT_BAR(0);
    DMA_K(3, 0); DMA_V(1, SLOTB);
    ROT();
    kload8(kf, kp0 + sl_cur);
    WAIT_BAR(2);
    s16x4 vlo[8], vhi[8]; u32x4 pw0, pw1, pw2, pw3;
#define PKW(P, B) cvtpk_s(P[B], P[B + 1])
#define PAF(k) __builtin_bit_cast(bf16x8, pw##k)
#define VFR(i) (bf16x8){vlo[i][0], vlo[i][1], vlo[i][2], vlo[i][3], vhi[i][0], vhi[i][1], vhi[i][2], vhi[i][3]}
#define PIN(x) asm volatile("" : "+v"(x))
#define MX3(a, b, c) __builtin_fmaxf(__builtin_fmaxf((a), (b)), (c))
#define GAPA(MF, A0, A1, A2, A3, W0, W1, PW) do { MF; sacc += A0; sacc += A1; sacc += A2; sacc += A3; PIN(sacc); W0; W1; PIN(PW); SBAR(); } while (0)
#define EX(v) __builtin_amdgcn_exp2f(v)
#define GAPB(MF, X, B) do { MF; X[B] = EX(X[B]); X[B + 1] = EX(X[B + 1]); X[B + 2] = EX(X[B + 2]); X[B + 3] = EX(X[B + 3]); PIN(X); SBAR(); } while (0)
#define VRD(i) do { vlo[i] = vtr(vp_ + (((i) >> 2) * 4096 + ((i) & 3) * 1024)); vhi[i] = vtr(vp_ + (((i) >> 2) * 4096 + ((i) & 3) * 1024 + 512)); } while (0)
#define KRD(G, j) do { if (G) { kload2(kf, kp0 + sl_next, j); SBAR(); } } while (0)
#define STEP(C0, C1, P0, P1, t, GK, GV, GL) do { SBAR(); \
    const lds_cptr vp_ = vp0 + sl_prev; \
    VRD(0); SBAR(); float sacc = (P0[0] + P0[1]); \
    GAPA(C0 = __builtin_amdgcn_mfma_f32_32x32x16_bf16(kf[0], qr[0], negm, 0, 0, 0), P0[2], P0[3], P0[4], P0[5],     pw0[0] = PKW(P0, 0), pw0[1] = PKW(P0, 2), pw0); \
    VRD(4); SBAR(); GAPA(C1 = __builtin_amdgcn_mfma_f32_32x32x16_bf16(kf[1], qr[0], negm, 0, 0, 0), P0[6], P0[7], P0[8], P0[9],     pw0[2] = PKW(P0, 4), pw0[3] = PKW(P0, 6), pw0); \
    VRD(1); SBAR(); GAPA(C0 = __builtin_amdgcn_mfma_f32_32x32x16_bf16(kf[2], qr[1], C0, 0, 0, 0),   P0[10], P0[11], P0[12], P0[13], pw1[0] = PKW(P0, 8), pw1[1] = PKW(P0, 10), pw1); \
    VRD(5); SBAR(); GAPA(C1 = __builtin_amdgcn_mfma_f32_32x32x16_bf16(kf[3], qr[1], C1, 0, 0, 0),   P0[14], P0[15], P1[0], P1[1],   pw1[2] = PKW(P0, 12), pw1[3] = PKW(P0, 14), pw1); \
    VRD(2); SBAR(); GAPA(C0 = __builtin_amdgcn_mfma_f32_32x32x16_bf16(kf[4], qr[2], C0, 0, 0, 0),   P1[2], P1[3], P1[4], P1[5],     pw2[0] = PKW(P1, 0), pw2[1] = PKW(P1, 2), pw2); \
    VRD(6); SBAR(); GAPA(C1 = __builtin_amdgcn_mfma_f32_32x32x16_bf16(kf[5], qr[2], C1, 0, 0, 0),   P1[6], P1[7], P1[8], P1[9],     pw2[2] = PKW(P1, 4), pw2[3] = PKW(P1, 6), pw2); \
    VRD(3); SBAR(); GAPA(C0 = __builtin_amdgcn_mfma_f32_32x32x16_bf16(kf[6], qr[3], C0, 0, 0, 0),   P1[10], P1[11], P1[12], P1[13], pw3[0] = PKW(P1, 8), pw3[1] = PKW(P1, 10), pw3); \
    VRD(7); SBAR(); GAPA(C1 = __builtin_amdgcn_mfma_f32_32x32x16_bf16(kf[7], qr[3], C1, 0, 0, 0),   P1[14], P1[15], 0.f, 0.f,       pw3[2] = PKW(P1, 12), pw3[3] = PKW(P1, 14), pw3); \
    l_reg += sacc; \
    if (GK) { DMA_K((t) + 3, sl_cur); } if (GV) { DMA_V((t) + 1, sl_next); } \
    if constexpr (!FIXREF) { float a = MX3(C0[0], C0[1], C1[0]), b = MX3(C0[2], C0[3], C1[1]); a = MX3(a, C1[2], C1[3]); \
      _Pragma("unroll") for (int r = 4; r < 16; r += 4) { a = MX3(a, C0[r], C0[r + 1]); b = MX3(b, C0[r + 2], C0[r + 3]); a = MX3(a, C1[r], C1[r + 1]); b = MX3(b, C1[r + 2], C1[r + 3]); } \
      float rm = __builtin_fmaxf(a, b); { auto rr = __builtin_amdgcn_permlane32_swap(__float_as_uint(rm), __float_as_uint(rm), false, false); rm = __builtin_fmaxf(__uint_as_float(rr[0]), __uint_as_float(rr[1])); } \
      resc = false; \
      if (__builtin_expect(__any(rm > (float)THRL), 0)) { const float dl = __builtin_fmaxf(rm, 0.f); mhat += dl; \
        _Pragma("unroll") for (int r = 0; r < 16; ++r) { C0[r] -= dl; C1[r] -= dl; } \
        _Pragma("unroll") for (int r = 0; r < 16; ++r) negm[r] = -mhat; asm volatile("" : "+v"(negm)); \
        const float f = __builtin_amdgcn_exp2f(-dl); l_reg *= f; if (hi == 0) wsf[r32] = f; resc = true; } } \
    SBAR(); \
    GAPB(o[0] = __builtin_amdgcn_mfma_f32_32x32x16_bf16(PAF(0), VFR(0), o[0], 0, 0, 0), C0, 0); \
    GAPB(o[1] = __builtin_amdgcn_mfma_f32_32x32x16_bf16(PAF(0), VFR(4), o[1], 0, 0, 0), C0, 4); \
    KRD(GL, 0); GAPB(o[0] = __builtin_amdgcn_mfma_f32_32x32x16_bf16(PAF(1), VFR(1), o[0], 0, 0, 0), C0, 8); \
    KRD(GL, 1); GAPB(o[1] = __builtin_amdgcn_mfma_f32_32x32x16_bf16(PAF(1), VFR(5), o[1], 0, 0, 0), C0, 12); \
    KRD(GL, 2); GAPB(o[0] = __builtin_amdgcn_mfma_f32_32x32x16_bf16(PAF(2), VFR(2), o[0], 0, 0, 0), C1, 0); \
    KRD(GL, 3); GAPB(o[1] = __builtin_amdgcn_mfma_f32_32x32x16_bf16(PAF(2), VFR(6), o[1], 0, 0, 0), C1, 4); \
    GAPB(o[0] = __builtin_amdgcn_mfma_f32_32x32x16_bf16(PAF(3), VFR(3), o[0], 0, 0, 0), C1, 8); \
    GAPB(o[1] = __builtin_amdgcn_mfma_f32_32x32x16_bf16(PAF(3), VFR(7), o[1], 0, 0, 0), C1, 12); \
    } while (0)
    int t = 1;
    for (; t + 5 < NT; t += 2) {
        STEP(pB0, pB1, pA0, pA1, t, true, true, true);     WAIT_BAR(2); RESC(); ROT();
        STEP(pA0, pA1, pB0, pB1, t + 1, true, true, true); WAIT_BAR(2); RESC(); ROT();
    }
#define ENDW(tt) do { if ((tt) + 3 < NT) { WAIT_BAR(2); } else if ((tt) + 2 < NT) { WAIT_BAR(1); } else { WAIT_BAR(0); } } while (0)
    for (; t + 1 < NT; t += 2) {
        STEP(pB0, pB1, pA0, pA1, t, (t + 3 < NT), (t + 1 < NT), (t + 1 < NT));         ENDW(t);     RESC(); ROT();
        STEP(pA0, pA1, pB0, pB1, t + 1, (t + 4 < NT), (t + 2 < NT), (t + 2 < NT));     ENDW(t + 1); RESC(); ROT();
    }
    STEP(pB0, pB1, pA0, pA1, NT - 1, false, false, false); RESC();
    { float sacc = pB0[0] + pB0[1]; _Pragma("unroll") for (int r = 2; r < 16; ++r) sacc += pB0[r]; _Pragma("unroll") for (int r = 0; r < 16; ++r) sacc += pB1[r]; l_reg += sacc;
      pw0 = (u32x4){PKW(pB0, 0), PKW(pB0, 2), PKW(pB0, 4), PKW(pB0, 6)}; pw1 = (u32x4){PKW(pB0, 8), PKW(pB0, 10), PKW(pB0, 12), PKW(pB0, 14)}; pw2 = (u32x4){PKW(pB1, 0), PKW(pB1, 2), PKW(pB1, 4), PKW(pB1, 6)}; pw3 = (u32x4){PKW(pB1, 8), PKW(pB1, 10), PKW(pB1, 12), PKW(pB1, 14)};
      SBAR(); pv(o, vb0 + sl_cur, PAF(0), PAF(1), PAF(2), PAF(3)); }
#undef PKW
#undef PAF
#undef VFR
#undef PIN
#undef MX3
#undef GAPA
#undef GAPB
#undef EX
#undef VRD
#undef KRD
#undef STEP
#undef ENDW
    { auto rr = __builtin_amdgcn_permlane32_swap(__float_as_uint(l_reg), __float_as_uint(l_reg), false, false); l_reg = __uint_as_float(rr[0]) + __uint_as_float(rr[1]); }
    if (hi == 0) wsf[32 + r32] = l_reg; asm volatile("s_waitcnt lgkmcnt(0)" ::: "memory");
    float rli[16];
#pragma unroll
    for (int r = 0; r < 16; ++r) rli[r] = __builtin_amdgcn_rcpf(wsf[32 + crow(r, hi)]);
    const long orow0 = rowbase + q0 + wid * QBLK;
    bf16* Ow = O + orow0 * OP + h * D;
    { bf16* stg = (bf16*)(shm + LDS_OST) + wid * 2048;
#pragma unroll
      for (int r = 0; r < 16; ++r) { const int orow = crow(r, hi);
#pragma unroll
          for (int d0 = 0; d0 < 2; ++d0) stg[orow * 64 + d0 * 32 + r32] = __float2bfloat16(o[d0][r] * rli[r]); }
      asm volatile("s_waitcnt lgkmcnt(0)" ::: "memory");
#pragma unroll
      for (int i = 0; i < 4; ++i) { const int row = i * 8 + (lane >> 3), ch = lane & 7; const u32x4 v = *(const u32x4*)(stg + row * 64 + ch * 8); mk::st16_wt<WT_EPI>(Ow + (long)row * OP + ch * 8, v);
          float ss = 0.f;
#pragma unroll
          for (int k = 0; k < 4; ++k) { const float lo = __uint_as_float(v[k] << 16), hi2 = __uint_as_float(v[k] & 0xffff0000u); ss += lo * lo + hi2 * hi2; }
          ss += __shfl_xor(ss, 1); ss += __shfl_xor(ss, 2); ss += __shfl_xor(ss, 4);
          if (ch == 0) SSQ[(orow0 + row) * 8 + h] = ss; } }
    asm volatile("s_waitcnt lgkmcnt(0)\n\ts_barrier" ::: "memory");
#undef DMA_K
#undef DMA_V
#undef START
#undef RESC
#undef ROT
}
#undef SBAR
#undef WAIT_BAR
}
namespace lru {
using namespace mk;
#define LLAS __attribute__((address_space(3)))
typedef short bf16x8 __attribute__((ext_vector_type(8)));
typedef float f32x16 __attribute__((ext_vector_type(16)));
typedef float f32x4 __attribute__((ext_vector_type(4)));
typedef float f32x2 __attribute__((ext_vector_type(2)));
typedef unsigned u32x4 __attribute__((ext_vector_type(4)));
constexpr int XPITCH = 144, HPITCH = 272;
constexpr int WAVE_BYTES = 64 * HPITCH;
constexpr int CW_OFF = 9728;
constexpr int PART_OFF = 8 * WAVE_BYTES;
constexpr int LDS_NEED = PART_OFF + 2048;
constexpr float LOG2E = 1.4426950408889634f, LN2 = 0.6931471805599453f;

struct Params { const bf16_t* LX; const bf16_t* LG; const float *cw, *cb, *ba, *bi, *lam, *gain; const bf16_t* WL; f32x2* SUMS; bf16_t* MIX; unsigned* AB; };

using mk::st16_wt;
__device__ __forceinline__ unsigned cvtpk(float lo, float hi) { unsigned r; asm volatile("v_cvt_pk_bf16_f32 %0, %1, %2" : "=v"(r) : "v"(lo), "v"(hi)); return r; }

__device__ __forceinline__ void build_xc(const Params& P, LLAS unsigned char* wl, int b, int c, int n, int lane, bf16x8 (&xcA)[2][4]) {
    const bf16_t* LXb = P.LX + (size_t)b * S * LW + 64 * n;
#pragma unroll
    for (int it = 0; it < 9; ++it) {
        const int rr = (lane >> 3) + 8 * it;
        if (rr < 67) { const int s = 64 * c - 2 + rr; u32x4 v = (u32x4){0u, 0u, 0u, 0u};
            if (s >= 0 && s < S) v = __builtin_nontemporal_load((const u32x4*)(LXb + (size_t)s * LW + 8 * (lane & 7)));
            *(LLAS u32x4*)(wl + rr * XPITCH + 16 * (lane & 7)) = v; }
    }
    LLAS float* cwl = (LLAS float*)(wl + CW_OFF);
#pragma unroll
    for (int j = 0; j < 4; ++j) cwl[j * 64 + lane] = P.cw[j * LW + 64 * n + lane];
    cwl[4 * 64 + lane] = P.cb[64 * n + lane];
    const int i = lane & 31, hi = lane >> 5;
#pragma unroll
    for (int ks = 0; ks < 4; ++ks) {
        const int cb0 = 16 * ks + 8 * hi;
        f32x4 w[5][2];
#pragma unroll
        for (int j = 0; j < 5; ++j) { w[j][0] = *(const LLAS f32x4*)(cwl + j * 64 + cb0); w[j][1] = *(const LLAS f32x4*)(cwl + j * 64 + cb0 + 4); }
#pragma unroll
        for (int mt = 0; mt < 2; ++mt) {
            f32x4 a0 = w[4][0], a1 = w[4][1];
#pragma unroll
            for (int j = 0; j < 4; ++j) {
                const u32x4 xv = *(const LLAS u32x4*)(wl + (32 * mt + i + j) * XPITCH + cb0 * 2);
                f32x4 x0, x1;
                x0[0] = __uint_as_float(xv[0] << 16); x0[1] = __uint_as_float(xv[0] & 0xffff0000u); x0[2] = __uint_as_float(xv[1] << 16); x0[3] = __uint_as_float(xv[1] & 0xffff0000u);
                x1[0] = __uint_as_float(xv[2] << 16); x1[1] = __uint_as_float(xv[2] & 0xffff0000u); x1[2] = __uint_as_float(xv[3] << 16); x1[3] = __uint_as_float(xv[3] & 0xffff0000u);
                a0 += x0 * w[j][0]; a1 += x1 * w[j][1];
            }
            u32x4 pk; pk[0] = cvtpk(a0[0], a0[1]); pk[1] = cvtpk(a0[2], a0[3]); pk[2] = cvtpk(a1[0], a1[1]); pk[3] = cvtpk(a1[2], a1[3]);
            xcA[mt][ks] = __builtin_bit_cast(bf16x8, pk);
        }
    }
}
__device__ __forceinline__ bf16x8 ident_frag(int ks, int nh, int r32, int hi) {
    const int jj = 32 * nh + r32 - 16 * ks - 8 * hi; bf16x8 f;
#pragma unroll
    for (int j = 0; j < 8; ++j) f[j] = (j == jj) ? (short)0x3F80 : (short)0;
    return f;
}
__device__ __forceinline__ void gate_ab(f32x16& ra, f32x16& ri, const f32x16& xc, float ba, float bi, float c1) {
    const float nba = -ba * LOG2E, nbi = -bi * LOG2E;
#pragma unroll
    for (int r = 0; r < 16; ++r) {
        const float rg = __builtin_amdgcn_rcpf(1.0f + __builtin_amdgcn_exp2f(fmaf(ra[r], -LOG2E, nba)));
        const float ig = __builtin_amdgcn_rcpf(1.0f + __builtin_amdgcn_exp2f(fmaf(ri[r], -LOG2E, nbi)));
        const float a = __builtin_amdgcn_exp2f(c1 * rg);
        ra[r] = a; ri[r] = __builtin_amdgcn_sqrtf(fmaf(-a, a, 1.0f)) * ig * xc[r];
    }
}
__device__ __forceinline__ float xhalf(float x, int hi) {
    const auto r = __builtin_amdgcn_permlane32_swap(__float_as_uint(x), __float_as_uint(x), false, false);
    return __uint_as_float(hi ? r[0] : r[1]);
}
template <bool ACC> __device__ __forceinline__ void scan_fwd(const f32x16& a, const f32x16& b, float& h, float& p, f32x16& hs, f32x16& pc, int hi) {
    float Ag[4], Bg[4], pA[4], pB[4];
#pragma unroll
    for (int g = 0; g < 4; ++g) { float A = a[4 * g], B = b[4 * g];
#pragma unroll
        for (int e = 1; e < 4; ++e) { B = fmaf(a[4 * g + e], B, b[4 * g + e]); A *= a[4 * g + e]; }
        Ag[g] = A; Bg[g] = B; pA[g] = xhalf(A, hi); pB[g] = xhalf(B, hi); }
#pragma unroll
    for (int g = 0; g < 4; ++g) {
        const float A1 = hi ? pA[g] : Ag[g], B1 = hi ? pB[g] : Bg[g], A2 = hi ? Ag[g] : pA[g], B2 = hi ? Bg[g] : pB[g];
        const float h1 = fmaf(A1, h, B1), p1 = p * A1; float x = hi ? h1 : h, px = hi ? p1 : p; h = fmaf(A2, h1, B2); p = p1 * A2;
#pragma unroll
        for (int e = 0; e < 4; ++e) { x = fmaf(a[4 * g + e], x, b[4 * g + e]); px *= a[4 * g + e]; hs[4 * g + e] = ACC ? hs[4 * g + e] + x : x; pc[4 * g + e] = px; }
    }
}
template <bool ACC> __device__ __forceinline__ void scan_bwd(const f32x16& a, const f32x16& b, float& h, float& p, f32x16& hs, f32x16& pc, int hi) {
    float Ag[4], Bg[4], pA[4], pB[4];
#pragma unroll
    for (int g = 0; g < 4; ++g) { float A = a[4 * g + 3], B = b[4 * g + 3];
#pragma unroll
        for (int e = 2; e >= 0; --e) { B = fmaf(a[4 * g + e], B, b[4 * g + e]); A *= a[4 * g + e]; }
        Ag[g] = A; Bg[g] = B; pA[g] = xhalf(A, hi); pB[g] = xhalf(B, hi); }
#pragma unroll
    for (int g = 3; g >= 0; --g) {
        const float A1 = hi ? Ag[g] : pA[g], B1 = hi ? Bg[g] : pB[g], A2 = hi ? pA[g] : Ag[g], B2 = hi ? pB[g] : Bg[g];
        const float h1 = fmaf(A1, h, B1), p1 = p * A1; float x = hi ? h : h1, px = hi ? p : p1; h = fmaf(A2, h1, B2); p = p1 * A2;
#pragma unroll
        for (int e = 3; e >= 0; --e) { x = fmaf(a[4 * g + e], x, b[4 * g + e]); px *= a[4 * g + e]; hs[4 * g + e] = ACC ? hs[4 * g + e] + x : x; pc[4 * g + e] = px; }
    }
}
__device__ __forceinline__ void tile_ab(const bf16x8 (&xcA)[4], const bf16x8 (&Bf)[2][4], int nh, int r32, int hi, float ba, float bi, float c1, f32x16& a, f32x16& b) {
    f32x16 ra = f32x16{}, ri = f32x16{}, xc = f32x16{};
#pragma unroll
    for (int ks = 0; ks < 4; ++ks) { ra = __builtin_amdgcn_mfma_f32_32x32x16_bf16(xcA[ks], Bf[0][ks], ra, 0, 0, 0); ri = __builtin_amdgcn_mfma_f32_32x32x16_bf16(xcA[ks], Bf[1][ks], ri, 0, 0, 0); }
    if (nh == 0) { xc = __builtin_amdgcn_mfma_f32_32x32x16_bf16(xcA[0], ident_frag(0, 0, r32, hi), xc, 0, 0, 0); xc = __builtin_amdgcn_mfma_f32_32x32x16_bf16(xcA[1], ident_frag(1, 0, r32, hi), xc, 0, 0, 0); }
    else         { xc = __builtin_amdgcn_mfma_f32_32x32x16_bf16(xcA[2], ident_frag(2, 1, r32, hi), xc, 0, 0, 0); xc = __builtin_amdgcn_mfma_f32_32x32x16_bf16(xcA[3], ident_frag(3, 1, r32, hi), xc, 0, 0, 0); }
    gate_ab(ra, ri, xc, ba, bi, c1);
    a = ra; b = ri;
}
__device__ __forceinline__ void load_bf(const Params& P, int n, int dir, int nh, int lane, bf16x8 (&Bf)[2][4]) {
#pragma unroll
    for (int q = 0; q < 2; ++q)
#pragma unroll
        for (int ks = 0; ks < 4; ++ks) Bf[q][ks] = *(const bf16x8*)(P.WL + ((((size_t)(n * 4 + dir * 2 + q) * 2 + nh) * 4 + ks) * 64 + lane) * 8);
}
__device__ __forceinline__ float softplus_neg(float lam) { const float L = -lam; return (L > 20.f) ? L : log1pf(expf(L)); }

__device__ __forceinline__ u32x4 pack8(const f32x16& v, int half) {
    u32x4 o;
#pragma unroll
    for (int k = 0; k < 4; ++k) o[k] = cvtpk(v[8 * half + 2 * k], v[8 * half + 2 * k + 1]);
    return o;
}
__device__ __forceinline__ void lru_summaries(const Params& P, LLAS unsigned char* lds, int b, int c) {
    int tid_ = threadIdx.x; asm volatile("" : "+v"(tid_));
    const int tid = tid_, lane = tid & 63, r32 = lane & 31, hi = lane >> 5; const int n = __builtin_amdgcn_readfirstlane(tid >> 6);
    LLAS unsigned char* wl = lds + n * WAVE_BYTES;
    bf16x8 xcA[2][4];
    build_xc(P, wl, b, c, n, lane, xcA);
    bf16x8 Bf[2][4]; load_bf(P, n, 0, 0, lane, Bf);
#pragma unroll 1
    for (int nh = 0; nh < 2; ++nh) {
        const int ch = 64 * n + 32 * nh + r32;
        u32x4* abp = (u32x4*)P.AB + ((((size_t)(b * NCH + c) * 8 + n) * 2 + nh) * 12) * 64 + lane;
        f32x16 hs0, hs1;
        {
            const float ba = P.ba[ch], bi = P.bi[ch], c1 = -8.0f * LOG2E * softplus_neg(P.lam[ch]);
            float h = 0.f, p = 1.f;
            { f32x16 a, bb, pc; tile_ab(xcA[0], Bf, nh, r32, hi, ba, bi, c1, a, bb); scan_fwd<false>(a, bb, h, p, hs0, pc, hi); st16_wt(abp + 4 * 64, pack8(pc, 0)); st16_wt(abp + 5 * 64, pack8(pc, 1)); }
            { f32x16 a, bb, pc; tile_ab(xcA[1], Bf, nh, r32, hi, ba, bi, c1, a, bb); load_bf(P, n, 1, nh, lane, Bf);
              scan_fwd<false>(a, bb, h, p, hs1, pc, hi); st16_wt(abp + 6 * 64, pack8(pc, 0)); st16_wt(abp + 7 * 64, pack8(pc, 1)); }
            if (hi == 0) P.SUMS[((size_t)(b * 2 + 0) * NCH + c) * LW + ch] = (f32x2){p, h};
        }
        {
            const float ba = P.ba[LW + ch], bi = P.bi[LW + ch], c1 = -8.0f * LOG2E * softplus_neg(P.lam[LW + ch]);
            float h = 0.f, p = 1.f;
            { f32x16 a, bb, pc; tile_ab(xcA[1], Bf, nh, r32, hi, ba, bi, c1, a, bb); scan_bwd<true>(a, bb, h, p, hs1, pc, hi); st16_wt(abp + 10 * 64, pack8(pc, 0)); st16_wt(abp + 11 * 64, pack8(pc, 1));
              st16_wt(abp + 2 * 64, pack8(hs1, 0)); st16_wt(abp + 3 * 64, pack8(hs1, 1)); }
            { f32x16 a, bb, pc; tile_ab(xcA[0], Bf, nh, r32, hi, ba, bi, c1, a, bb); if (nh == 0) load_bf(P, n, 0, 1, lane, Bf);
              scan_bwd<true>(a, bb, h, p, hs0, pc, hi); st16_wt(abp + 8 * 64, pack8(pc, 0)); st16_wt(abp + 9 * 64, pack8(pc, 1));
              st16_wt(abp + 0 * 64, pack8(hs0, 0)); st16_wt(abp + 1 * 64, pack8(hs0, 1)); }
            if (hi == 0) P.SUMS[((size_t)(b * 2 + 1) * NCH + c) * LW + ch] = (f32x2){p, h};
        }
    }
}
constexpr int CARRY_OFF = 142336;
__device__ __forceinline__ void carries_to_lds(const f32x2* SUMS, LLAS unsigned char* lds, int b, int c, int tid) {
    const f32x2* sf = SUMS + (size_t)(b * 2 + 0) * NCH * LW + tid; const f32x2* sb = SUMS + (size_t)(b * 2 + 1) * NCH * LW + tid;
    float hf = 0.f, hb = 0.f;
    for (int c0 = 0; c0 < c; c0 += 16) { f32x2 v[16];
#pragma unroll
        for (int u = 0; u < 16; ++u) { const int cc = c0 + u; v[u] = sf[(size_t)(cc < c ? cc : c - 1) * LW]; if (cc >= c) v[u] = (f32x2){1.0f, 0.0f}; }
#pragma unroll
        for (int u = 0; u < 16; ++u) hf = fmaf(v[u][0], hf, v[u][1]); }
    for (int c0 = NCH - 1; c0 > c; c0 -= 16) { f32x2 v[16];
#pragma unroll
        for (int u = 0; u < 16; ++u) { const int cc = c0 - u; v[u] = sb[(size_t)(cc > c ? cc : c + 1) * LW]; if (cc <= c) v[u] = (f32x2){1.0f, 0.0f}; }
#pragma unroll
        for (int u = 0; u < 16; ++u) hb = fmaf(v[u][0], hb, v[u][1]); }
    LLAS float* cr = (LLAS float*)(lds + CARRY_OFF);
    cr[tid] = hf; cr[LW + tid] = hb;
}
__device__ __forceinline__ float gelu_tanh(float x) {
    const float u = 0.7978845608028654f * (x + 0.044715f * x * x * x);
    return x * __builtin_amdgcn_rcpf(1.0f + __builtin_amdgcn_exp2f(-2.0f * LOG2E * u));
}
__device__ __forceinline__ void lru_apply(const Params& P, LLAS unsigned char* lds, int b, int c) {
    int tid_ = threadIdx.x; asm volatile("" : "+v"(tid_));
    const int tid = tid_, lane = tid & 63, r32 = lane & 31, hi = lane >> 5; const int n = __builtin_amdgcn_readfirstlane(tid >> 6);
    LLAS unsigned char* wl = lds + n * WAVE_BYTES;
    u32x4 q[2][12];
    { const u32x4* abp = (const u32x4*)P.AB + (((size_t)(b * NCH + c) * 8 + n) * 24) * 64 + lane;
#pragma unroll
      for (int j = 0; j < 24; ++j) q[j / 12][j % 12] = __builtin_nontemporal_load(abp + j * 64); }
    carries_to_lds(P.SUMS, lds, b, c, tid);
    __syncthreads();
#pragma unroll
    for (int nh = 0; nh < 2; ++nh) {
        const int ch = 64 * n + 32 * nh + r32;
        const float cf = *(const LLAS float*)(lds + CARRY_OFF + ch * 4), cb = *(const LLAS float*)(lds + CARRY_OFF + (LW + ch) * 4);
#pragma unroll
        for (int th = 0; th < 4; ++th) {
            LLAS unsigned char* hc = wl + (32 * nh + r32) * 4 + (th >> 1) * 32 * HPITCH;
#pragma unroll
            for (int k = 0; k < 4; ++k) {
                const unsigned hv = q[nh][th][k], fv = q[nh][4 + th][k], bv = q[nh][8 + th][k];
                const int r = 8 * (th & 1) + 2 * k;
                const float x0 = fmaf(__uint_as_float(bv << 16), cb, fmaf(__uint_as_float(fv << 16), cf, __uint_as_float(hv << 16)));
                const float x1 = fmaf(__uint_as_float(bv & 0xffff0000u), cb, fmaf(__uint_as_float(fv & 0xffff0000u), cf, __uint_as_float(hv & 0xffff0000u)));
                *(LLAS float*)(hc + (8 * (r >> 2) + 4 * hi + (r & 3)) * HPITCH) = x0;
                *(LLAS float*)(hc + (8 * ((r + 1) >> 2) + 4 * hi + ((r + 1) & 3)) * HPITCH) = x1;
            }
        }
    }
    const int ch8 = 8 * (lane & 7);
    const size_t t0 = (size_t)b * S + (size_t)c * 64;
    float v[8][8];
    LLAS float* part = (LLAS float*)(lds + PART_OFF);
#pragma unroll
    for (int it = 0; it < 8; ++it) {
        const int row = (lane >> 3) + 8 * it;
        const f32x4 h0 = *(const LLAS f32x4*)(wl + row * HPITCH + ch8 * 4), h1 = *(const LLAS f32x4*)(wl + row * HPITCH + ch8 * 4 + 16);
        const u32x4 gv = __builtin_nontemporal_load((const u32x4*)(P.LG + (t0 + row) * LW + 64 * n + ch8));
        float ss = 0.f;
#pragma unroll
        for (int q = 0; q < 4; ++q) {
            const float g0 = __uint_as_float(gv[q] << 16), g1 = __uint_as_float(gv[q] & 0xffff0000u);
            const float hA = (q < 2) ? h0[2 * q] : h1[2 * q - 4], hB = (q < 2) ? h0[2 * q + 1] : h1[2 * q - 3];
            v[it][2 * q] = hA * gelu_tanh(g0); v[it][2 * q + 1] = hB * gelu_tanh(g1);
            ss += v[it][2 * q] * v[it][2 * q] + v[it][2 * q + 1] * v[it][2 * q + 1];
        }
        ss += __shfl_xor(ss, 1); ss += __shfl_xor(ss, 2); ss += __shfl_xor(ss, 4);
        if ((lane & 7) == 0) part[n * 64 + row] = ss;
    }
    __syncthreads();
    f32x4 g0 = *(const f32x4*)(P.gain + 64 * n + ch8), g1 = *(const f32x4*)(P.gain + 64 * n + ch8 + 4);
#pragma unroll
    for (int it = 0; it < 8; ++it) {
        const int row = (lane >> 3) + 8 * it;
        float tot = 0.f;
#pragma unroll
        for (int w = 0; w < 8; ++w) tot += part[w * 64 + row];
        const float rs = 1.0f / sqrtf(tot * (1.0f / 512.0f) + 1e-5f);
        u32x4 o; o[0] = cvtpk(v[it][0] * rs * g0[0], v[it][1] * rs * g0[1]); o[1] = cvtpk(v[it][2] * rs * g0[2], v[it][3] * rs * g0[3]);
        o[2] = cvtpk(v[it][4] * rs * g1[0], v[it][5] * rs * g1[1]); o[3] = cvtpk(v[it][6] * rs * g1[2], v[it][7] * rs * g1[3]);
        st16_wt<WT_EPI>(P.MIX + (t0 + row) * 1024 + 512 + 64 * n + ch8, o);
    }
    __syncthreads();
}
#undef LLAS
}
namespace mkf {
using namespace mk;
#define GAS __attribute__((address_space(1)))
#define LAS __attribute__((address_space(3)))
typedef unsigned v4u __attribute__((ext_vector_type(4)));
typedef float f32x4 __attribute__((ext_vector_type(4)));
typedef float f32x16 __attribute__((ext_vector_type(16)));
typedef short bf16x8 __attribute__((ext_vector_type(8)));
typedef GAS unsigned gu32;
#define RLX_AGENT __ATOMIC_RELAXED, __HIP_MEMORY_SCOPE_AGENT
#define LDS_WAIT() asm volatile("s_waitcnt lgkmcnt(0)" ::: "memory")
constexpr int NWAVES = 8;
constexpr int RING_OFF = 0, RING_BYTES = 131072;
constexpr int LDSCTL_OFF = 141312, MISC_OFF = LDSCTL_OFF;
constexpr int LDS_BYTES = 147456;
static_assert(lru::LDS_NEED <= LDSCTL_OFF && attn_body::LDS_BYTES <= RING_BYTES && pg8::STAGE_BYTES + 8192 <= LDSCTL_OFF && MISC_OFF + 512 <= lru::CARRY_OFF && lru::CARRY_OFF + 4096 <= LDS_BYTES, "LDS map");

#define XB_TMO      128
#define XB_XCNT(j)  (256  + 64 * (j))
#define XB_XSUB(j)  (1280 + 64 * (j))
#define XB_XGEN(j)  (2304 + 64 * (j))
#define XB_TOP      3328
#define XB_TOPGEN   3392
#define XCD_BAR_WORDS 3456
#define XB_SPIN_CAP (1u << 18)
__device__ __forceinline__ unsigned xb_ld(unsigned* p)              { return __hip_atomic_load(p, __ATOMIC_RELAXED, __HIP_MEMORY_SCOPE_AGENT); }
__device__ __forceinline__ unsigned xb_add(unsigned* p, unsigned v) { return __hip_atomic_fetch_add(p, v, __ATOMIC_RELAXED, __HIP_MEMORY_SCOPE_AGENT); }
__device__ __forceinline__ unsigned xb_xcc_id() { return (unsigned)__builtin_amdgcn_s_getreg((3 << 11) | 20) & 0xFu; }
#define XB_SPIN(cond, bar) do { unsigned _sp = 0; while (cond) { __builtin_amdgcn_s_sleep(1); \
    if ((++_sp & 255u) == 0u) { if (xb_ld(&(bar)[XB_TMO])) break; if (_sp > XB_SPIN_CAP) { atomicAdd(&(bar)[XB_TMO], 1u); break; } } } } while (0)
struct XcdBarrier { unsigned* bar; unsigned x; volatile LAS unsigned* st; };
__device__ __forceinline__ XcdBarrier xcd_barrier_post(unsigned* bar, volatile LAS unsigned* st) {
    XcdBarrier b; b.bar = bar; b.x = xb_xcc_id(); b.st = st;
    if (threadIdx.x == 0) (void)xb_add(&bar[XB_XCNT(b.x)], 1u);
    return b;
}
__device__ __forceinline__ void xcd_barrier_complete(unsigned* bar, unsigned x, unsigned& nloc, unsigned& nx) {
    const unsigned G = gridDim.x * gridDim.y * gridDim.z;
    unsigned sum, cnt, mine, sp = 0u;
    for (;;) {
        sum = 0u; cnt = 0u; mine = 0u;
#pragma unroll
        for (unsigned j = 0; j < 16; ++j) { const unsigned c = xb_ld(&bar[XB_XCNT(j)]); sum += c; cnt += (c > 0u) ? 1u : 0u; mine = (j == x) ? c : mine; }
        if (sum == G) break;
        __builtin_amdgcn_s_sleep(1);
        if ((++sp & 255u) == 0u) { if (xb_ld(&bar[XB_TMO])) break; if (sp > XB_SPIN_CAP) { atomicAdd(&bar[XB_TMO], 1u); break; } }
    }
    nloc = mine > 0u ? mine : 1u; nx = cnt > 0u ? cnt : 1u;
}
__device__ __forceinline__ void xcd_barrier(const XcdBarrier& b) {
    asm volatile("s_waitcnt vmcnt(0)" ::: "memory");
    __syncthreads();
    if (threadIdx.x == 0) {
        unsigned* bar = b.bar;
        __builtin_amdgcn_s_waitcnt(0);
        unsigned nloc = b.st[0], nx = b.st[1];
        if (nloc == 0u) { xcd_barrier_complete(bar, b.x, nloc, nx); b.st[0] = nloc; b.st[1] = nx; }
        const unsigned old = xb_add(&bar[XB_XSUB(b.x)], 1u);
        const unsigned gen = old / nloc;
        if (old + 1u == (gen + 1u) * nloc) {
            __builtin_amdgcn_fence(__ATOMIC_RELEASE, "agent");
            asm volatile("s_waitcnt vmcnt(0)" ::: "memory");
            const unsigned og = xb_add(&bar[XB_TOP], 1u);
            const unsigned tg = og / nx;
            if (og + 1u == (tg + 1u) * nx) xb_add(&bar[XB_TOPGEN], 1u);
            else XB_SPIN(xb_ld(&bar[XB_TOPGEN]) == tg, bar);
            __builtin_amdgcn_fence(__ATOMIC_ACQUIRE, "agent");
            xb_add(&bar[XB_XGEN(b.x)], 1u);
            asm volatile("s_waitcnt vmcnt(0)" ::: "memory");
        } else {
            XB_SPIN(xb_ld(&bar[XB_XGEN(b.x)]) == gen, bar);
            __builtin_amdgcn_fence(__ATOMIC_ACQUIRE, "agent");
            asm volatile("s_waitcnt vmcnt(0)" ::: "memory");
        }
    }
    __syncthreads();
}

struct Args { const float* in[25]; float* out; unsigned char* ws; int ph_lo, ph_hi, flags, li; };
enum { FL_LRU = 1, FL_ATTN = 2 };

__device__ __forceinline__ float wave_sum(float v) {
#pragma unroll
    for (int o = 1; o < 64; o <<= 1) v += __shfl_xor(v, o);
    return v;
}
template <class DST> __device__ __forceinline__ void transpose_item(const float* W, int ldn, const float* gk, bf16_t* WT, const DST& dst, LAS float* scr, int k0, int n0, int lane) {
    f32x4 v[8];
#pragma unroll
    for (int i = 0; i < 8; ++i) v[i] = *(const GAS f32x4*)(W + (size_t)(k0 + 8 * i + (lane >> 3)) * ldn + n0 + 4 * (lane & 7));
#pragma unroll
    for (int i = 0; i < 8; ++i) { const int kk = 8 * i + (lane >> 3); if (gk) v[i] *= gk[k0 + kk]; LAS float* d = scr + kk * 33 + 4 * (lane & 7); d[0] = v[i].x; d[1] = v[i].y; d[2] = v[i].z; d[3] = v[i].w; }
    LDS_WAIT(); asm volatile("" ::: "memory");
    const int c = lane & 7;
#pragma unroll
    for (int j = 0; j < 4; ++j) { const int n = (lane >> 3) + 8 * j; const LAS float* s = scr + (8 * c) * 33 + n;
        v4u o; o.x = pk2(s[0 * 33], s[1 * 33]); o.y = pk2(s[2 * 33], s[3 * 33]); o.z = pk2(s[4 * 33], s[5 * 33]); o.w = pk2(s[6 * 33], s[7 * 33]);
        st16_wt<WT_P0>(WT + (size_t)dst(n0 + n) * D + k0 + 8 * c, o); }
    LDS_WAIT(); asm volatile("" ::: "memory");
}
struct ItemSrc { const float* W; const float* gk; unsigned char* WT; int rowbase, half, kind, k0, n0; };
__device__ __forceinline__ void f8_item_load(const ItemSrc& s, int lane, f32x4 (&v)[8]) {
#pragma unroll
    for (int i = 0; i < 8; ++i) v[i] = __builtin_nontemporal_load((const GAS f32x4*)(s.W + (size_t)(s.k0 + 8 * i + (lane >> 3)) * D + s.n0 + 4 * (lane & 7)));
}
__device__ __forceinline__ void f8_item_store(const ItemSrc& s, int lane, f32x4 (&v)[8], LAS float* scr) {
#pragma unroll
    for (int i = 0; i < 8; ++i) { const int kk = 8 * i + (lane >> 3); float m = 32.0f; if (s.gk) m *= s.gk[s.k0 + kk]; v[i] *= m; LAS float* d = scr + kk * 33 + 4 * (lane & 7); d[0] = v[i].x; d[1] = v[i].y; d[2] = v[i].z; d[3] = v[i].w; }
    LDS_WAIT(); asm volatile("" ::: "memory");
    const int c = lane & 3;
#pragma unroll
    for (int j = 0; j < 2; ++j) { const int n = (lane >> 2) + 16 * j; const LAS float* p = scr + (16 * c) * 33 + n; int o[4];
#pragma unroll
        for (int q = 0; q < 4; ++q) { int w = 0; w = __builtin_amdgcn_cvt_pk_fp8_f32(p[(4 * q) * 33], p[(4 * q + 1) * 33], w, false); w = __builtin_amdgcn_cvt_pk_fp8_f32(p[(4 * q + 2) * 33], p[(4 * q + 3) * 33], w, true); o[q] = w; }
        const int col = s.n0 + n; const int row = s.rowbase + (s.kind == 0 ? gu_dst(col, s.half) : down_dst(col));
        st16_wt<WT_P0>(s.WT + (size_t)row * 1024 + s.k0 + 16 * c, (v4u){(unsigned)o[0], (unsigned)o[1], (unsigned)o[2], (unsigned)o[3]}); }
    LDS_WAIT(); asm volatile("" ::: "memory");
}
struct DstWin { __device__ int operator()(int c) const { return win_dst(c); } };
struct DstNat { __device__ int operator()(int c) const { return c; } };
struct DstPerm { __device__ int operator()(int c) const { return perm256_dst(c); } };
struct DstGU { int base, half; __device__ int operator()(int c) const { return base + gu_dst(c, half); } };
struct DstDown { int base; __device__ int operator()(int c) const { return base + perm256_dst(c); } };

constexpr int EXP_ITEMS = NE * 3 * 16 * 32;
constexpr int EXP_STEAL = 4096;
constexpr int EXP_N1 = EXP_ITEMS - EXP_STEAL;
constexpr int EXP_N0 = EXP_N1 - 64 * 8 * 8;
__device__ __forceinline__ void convert_expert_items(const Args& a, LAS float* scr, int lane, int first, int stride, int lo, int hi) {
    unsigned char* ws = a.ws; const float* n2g = a.in[15]; constexpr int I_E = 16 * 32;
    auto mkitem = [&](int r) { ItemSrc s; int e, q, ii;
        if (r < NE * 2 * I_E) { e = r / (2 * I_E); q = (r / I_E) & 1; ii = r % I_E; } else { const int rd = r - NE * 2 * I_E; e = rd / I_E; q = 2; ii = rd % I_E; }
        s.k0 = 64 * (ii / 32); s.n0 = 32 * (ii % 32); s.half = q & 1; s.kind = (q == 2);
        s.W = a.in[q == 0 ? 18 : (q == 1 ? 20 : 22)] + (size_t)e * D * D; s.gk = (q == 2) ? (const float*)nullptr : n2g; s.WT = ws + (q == 2 ? WS_BT2 : WS_BT1); s.rowbase = (q == 2) ? e * 1024 : e * 2048; return s; };
    int r = lo + first; f32x4 va[8], vb[8]; ItemSrc sa, sb;
    if (r < hi) { sa = mkitem(r); f8_item_load(sa, lane, va); }
    while (r < hi) {
        const int r1 = r + stride; if (r1 < hi) { sb = mkitem(r1); f8_item_load(sb, lane, vb); }
        f8_item_store(sa, lane, va, scr);
        if (r1 >= hi) break;
        const int r2 = r1 + stride; if (r2 < hi) { sa = mkitem(r2); f8_item_load(sa, lane, va); }
        f8_item_store(sb, lane, vb, scr);
        r = r2;
    }
}
__device__ __forceinline__ void p0_prologue(const Args& a, LAS unsigned char* lds, int vcu, int G, int wave, int lane) {
    unsigned char* ws = a.ws;
    LAS float* scr = (LAS float*)(lds + RING_OFF + wave * 16384);
    const int gw = vcu * NWAVES + wave, NGW = G * NWAVES;
    constexpr int I_IN = 16 * 56, I_OUT = 16 * 32, I_E = 16 * 32;
    const float* w_in = a.in[2]; const float* w_out = a.in[14]; const float* aog = a.in[12]; const float* n2g = a.in[15];
    for (int r = gw; r < I_IN + I_OUT; r += NGW) {
        if (r < I_IN) transpose_item(w_in, INW, (const float*)nullptr, (bf16_t*)(ws + WS_WIN), DstWin{}, scr, 64 * (r / 56), 32 * (r % 56), lane);
        else { const int q = r - I_IN, k0 = 64 * (q / 32);
            transpose_item(w_out, D, k0 < 512 ? aog : (const float*)nullptr, (bf16_t*)(ws + WS_WOUT), DstPerm{}, scr, k0, 32 * (q % 32), lane); }
    }
    convert_expert_items(a, scr, lane, gw, NGW, 0, G == 256 ? EXP_N0 : EXP_N1);
    const float* x = a.in[0]; const float* n1g = a.in[1]; bf16_t* XN = (bf16_t*)(ws + WS_XN);
    f32x4 gv[4];
#pragma unroll
    for (int j = 0; j < 4; ++j) gv[j] = *(const f32x4*)(n1g + 4 * lane + 256 * j);
    for (int m0 = 2 * gw; m0 < T; m0 += 2 * NGW) {
        f32x4 v[2][4]; float s[2] = {0.f, 0.f};
#pragma unroll
        for (int r = 0; r < 2; ++r) { const GAS f32x4* xr = (const GAS f32x4*)(x + (size_t)(m0 + r) * D) + lane;
#pragma unroll
            for (int j = 0; j < 4; ++j) v[r][j] = __builtin_nontemporal_load(xr + 64 * j); }
#pragma unroll
        for (int r = 0; r < 2; ++r) {
#pragma unroll
            for (int j = 0; j < 4; ++j) s[r] += (v[r][j].x * v[r][j].x + v[r][j].y * v[r][j].y) + (v[r][j].z * v[r][j].z + v[r][j].w * v[r][j].w);
            const float rs = 1.0f / sqrtf(wave_sum(s[r]) * (1.0f / D) + 1e-5f);
            GAS unsigned long long* o8 = (GAS unsigned long long*)(XN + (size_t)(m0 + r) * D) + lane;
#pragma unroll
            for (int j = 0; j < 4; ++j) o8[64 * j] = (unsigned long long)pk2(v[r][j].x * rs * gv[j].x, v[r][j].y * rs * gv[j].y) | ((unsigned long long)pk2(v[r][j].z * rs * gv[j].z, v[r][j].w * rs * gv[j].w) << 32);
        }
    }
    const int gt = vcu * (NWAVES * 64) + wave * 64 + lane, NGT = G * NWAVES * 64;
    for (int idx = gt; idx < 8 * 4 * 2 * 4 * 64 * 8; idx += NGT) {
        if (idx < 2048) nv::tbl_rope(idx, (float*)(ws + WS_ROPE));
        nv::tbl_wl(idx, a.in[7], a.in[9], (bf16_t*)(ws + WS_WL));
        if (idx < 64 * 64 * 8) nv::tbl_rtr(idx, a.in[16], n2g, (bf16_t*)(ws + WS_RTR));
    }
}
__device__ __forceinline__ void p5_route(const Args& a, LAS unsigned char* lds, int G) {
    unsigned char* ws = a.ws;
    const float* X1 = (const float*)(ws + WS_X1); const bf16_t* RT = (const bf16_t*)(ws + WS_RTR); const float* br = a.in[17];
    float* listr = (float*)(ws + WS_LISTR); float* listg = (float*)(ws + WS_LISTG); int* list = (int*)(ws + WS_LIST); unsigned* cnt = (unsigned*)(ws + WS_CTL) + CW_CNT;
    LAS float* PD = (LAS float*)(lds); LAS float* PS = (LAS float*)(lds + 33792); LAS unsigned* CL = (LAS unsigned*)(lds + 34816); LAS unsigned* BASE = (LAS unsigned*)(lds + 34944);
    int tid_ = threadIdx.x; asm volatile("" : "+v"(tid_));
    const int tid = tid_, lane = tid & 63, i = lane & 31, hi = lane >> 5; const int wid = __builtin_amdgcn_readfirstlane(tid >> 6), tile = wid >> 2, q = wid & 3;
    for (int grp = blockIdx.x; grp < T / 64; grp += G) {
        if (tid < 32) CL[tid] = 0u;
        const int tok0 = grp * 64 + tile * 32;
        f32x16 acc = f32x16{}; float ss = 0.f;
        const float* xp = X1 + (size_t)(tok0 + i) * D + q * 256 + hi * 8;
#pragma unroll 4
        for (int ks = 0; ks < 16; ++ks) {
            const f32x4 x0 = *(const f32x4*)(xp + ks * 16), x1 = *(const f32x4*)(xp + ks * 16 + 4);
            ss += (x0[0] * x0[0] + x0[1] * x0[1]) + (x0[2] * x0[2] + x0[3] * x0[3]) + (x1[0] * x1[0] + x1[1] * x1[1]) + (x1[2] * x1[2] + x1[3] * x1[3]);
            unsigned hh[4], ll[4];
#pragma unroll
            for (int p = 0; p < 2; ++p) { const float e0 = x0[2 * p], e1 = x0[2 * p + 1]; const unsigned h0 = f2bf(e0), h1 = f2bf(e1); hh[p] = h0 | (h1 << 16); ll[p] = pk2(e0 - bf2f(h0), e1 - bf2f(h1)); }
#pragma unroll
            for (int p = 0; p < 2; ++p) { const float e0 = x1[2 * p], e1 = x1[2 * p + 1]; const unsigned h0 = f2bf(e0), h1 = f2bf(e1); hh[2 + p] = h0 | (h1 << 16); ll[2 + p] = pk2(e0 - bf2f(h0), e1 - bf2f(h1)); }
            const bf16x8 ah = __builtin_bit_cast(bf16x8, (v4u){hh[0], hh[1], hh[2], hh[3]}), al = __builtin_bit_cast(bf16x8, (v4u){ll[0], ll[1], ll[2], ll[3]});
            const int ksg = q * 16 + ks;
            const bf16x8 bh = *(const bf16x8*)(RT + ((size_t)ksg * 64 + lane) * 8), bl = *(const bf16x8*)(RT + 32768 + ((size_t)ksg * 64 + lane) * 8);
            acc = __builtin_amdgcn_mfma_f32_32x32x16_bf16(ah, bh, acc, 0, 0, 0);
            acc = __builtin_amdgcn_mfma_f32_32x32x16_bf16(ah, bl, acc, 0, 0, 0);
            acc = __builtin_amdgcn_mfma_f32_32x32x16_bf16(al, bh, acc, 0, 0, 0);
        }
#pragma unroll
        for (int r = 0; r < 16; ++r) PD[((tile * 4 + q) * 32 + ((r & 3) + 8 * (r >> 2) + 4 * hi)) * 33 + i] = acc[r];
        ss += __shfl_xor(ss, 32);
        if (hi == 0) PS[(tile * 4 + q) * 32 + i] = ss;
        __syncthreads();
        int se[4]; unsigned sp[4]; float sg[4]; float rs_tok = 0.f; const bool sel = (q == 0 && hi == 0); const int tok = tok0 + i;
        if (sel) {
            float lg[32];
            const float sq = (PS[(tile * 4 + 0) * 32 + i] + PS[(tile * 4 + 1) * 32 + i]) + (PS[(tile * 4 + 2) * 32 + i] + PS[(tile * 4 + 3) * 32 + i]);
            const float rs = 1.0f / sqrtf(sq * (1.0f / D) + 1e-5f);
#pragma unroll
            for (int e = 0; e < 32; ++e) { const float v = (PD[((tile * 4 + 0) * 32 + i) * 33 + e] + PD[((tile * 4 + 1) * 32 + i) * 33 + e]) + (PD[((tile * 4 + 2) * 32 + i) * 33 + e] + PD[((tile * 4 + 3) * 32 + i) * 33 + e]); lg[e] = v * rs + br[e]; }
            unsigned taken = 0u; float tv[4];
#pragma unroll
            for (int k = 0; k < 4; ++k) { float best = -INFINITY; int bi = 0;
#pragma unroll
                for (int e = 0; e < 32; ++e) { const bool c = (lg[e] > best) && !((taken >> e) & 1u); best = c ? lg[e] : best; bi = c ? e : bi; }
                taken |= 1u << bi; se[k] = bi; tv[k] = best; }
            float sum = 0.f;
#pragma unroll
            for (int k = 0; k < 4; ++k) { sg[k] = __expf(tv[k] - tv[0]); sum += sg[k]; }
            const float inv = 1.0f / sum;
#pragma unroll
            for (int k = 0; k < 4; ++k) { sg[k] *= inv; sp[k] = __hip_atomic_fetch_add(&CL[se[k]], 1u, __ATOMIC_RELAXED, __HIP_MEMORY_SCOPE_WORKGROUP); }
            rs_tok = rs;
        }
        __syncthreads();
        if (tid < 32) BASE[tid] = __hip_atomic_fetch_add(cnt + tid * CNT_STRIDE, CL[tid], RLX_AGENT);
        __syncthreads();
        if (sel) {
#pragma unroll
            for (int k = 0; k < 4; ++k) { const size_t pos = (size_t)se[k] * T + BASE[se[k]] + sp[k]; list[pos] = tok * 4 + k; listr[pos] = rs_tok; listg[pos] = sg[k]; }
        }
        __syncthreads();
    }
}
__device__ __forceinline__ void p8_final(const Args& a, int vcu, int G, int wave, int lane) {
    const float* X1 = (const float*)(a.ws + WS_X1); const unsigned char* Y = a.ws + WS_Y; const float* fg = a.in[24];
    const int gw = vcu * NWAVES + wave, NGW = G * NWAVES;
    f32x4 gv[4];
#pragma unroll
    for (int j = 0; j < 4; ++j) gv[j] = *(const f32x4*)(fg + 4 * lane + 256 * j);
    for (int m0 = 2 * gw; m0 < T; m0 += 2 * NGW) {
        f32x4 v[2][4]; unsigned yq[2][4][4];
#pragma unroll
        for (int r = 0; r < 2; ++r)
#pragma unroll
            for (int j = 0; j < 4; ++j) { v[r][j] = __builtin_nontemporal_load((const GAS f32x4*)(X1 + (size_t)(m0 + r) * D) + lane + 64 * j);
#pragma unroll
                for (int k = 0; k < 4; ++k) yq[r][j][k] = __builtin_nontemporal_load((const GAS unsigned*)(Y + ((size_t)(m0 + r) * 4 + k) * D) + lane + 64 * j); }
#pragma unroll
        for (int r = 0; r < 2; ++r) { float s = 0.f;
#pragma unroll
            for (int j = 0; j < 4; ++j) { f32x4 ys = (f32x4){0.f, 0.f, 0.f, 0.f};
#pragma unroll
                for (int k = 0; k < 4; ++k) { const auto lo = __builtin_amdgcn_cvt_pk_f32_fp8((int)yq[r][j][k], false), hi = __builtin_amdgcn_cvt_pk_f32_fp8((int)yq[r][j][k], true); ys.x += lo[0]; ys.y += lo[1]; ys.z += hi[0]; ys.w += hi[1]; }
                v[r][j] += ys * 0.0625f;
                s += (v[r][j].x * v[r][j].x + v[r][j].y * v[r][j].y) + (v[r][j].z * v[r][j].z + v[r][j].w * v[r][j].w); }
            const float rs = 1.0f / sqrtf(wave_sum(s) * (1.0f / D) + 1e-5f);
#pragma unroll
            for (int j = 0; j < 4; ++j) __builtin_nontemporal_store(v[r][j] * gv[j] * rs, (GAS f32x4*)(a.out + (size_t)(m0 + r) * D) + lane + 64 * j); }
    }
}

__global__ void __launch_bounds__(NWAVES * 64, 2) mk_fwd(Args args) {
    extern __shared__ __attribute__((aligned(16))) unsigned char lds_raw[];
    LAS unsigned char* lds = (LAS unsigned char*)lds_raw;
    volatile LAS unsigned* MISC = (volatile LAS unsigned*)(lds + MISC_OFF);
    const int tid = threadIdx.x, lane = tid & 63, wave = __builtin_amdgcn_readfirstlane(tid >> 6);
    const int G = gridDim.x; const int bx = blockIdx.x; const int vcu = (G % 8 == 0) ? (bx % 8) * (G / 8) + bx / 8 : bx;
    unsigned char* ws = args.ws;
    gu32* ctl = (gu32*)(ws + WS_CTL);
    for (int u = tid; u < 128; u += NWAVES * 64) MISC[u] = 0u;
    __syncthreads();
    XcdBarrier bar = xcd_barrier_post((unsigned*)ctl + CW_BAR + args.li * XCD_BAR_WORDS, MISC);
    const int lo = args.ph_lo, hi = args.ph_hi;
#define IN(k) (lo <= (k) && (k) < hi)
#define SEAM(k) do { if (IN(k) && IN((k) + 1)) xcd_barrier(bar); } while (0)

    if (IN(0)) { p0_prologue(args, lds, vcu, G, wave, lane); SEAM(0); }

    if (IN(1)) {
        pg8::StaticSched Sc; Sc.init(ws + WS_WIN, T, INW, G, bx);
        pg8::EpiInProj E{(bf16_t*)(ws + WS_Q), (bf16_t*)(ws + WS_K), (bf16_t*)(ws + WS_V), (bf16_t*)(ws + WS_LX), (bf16_t*)(ws + WS_LG), args.in[3], args.in[4], (const float*)(ws + WS_ROPE)};
        pg8::gemm_phase<pg8::EpiInProj, pg8::StaticSched>(lds + RING_OFF, (const char*)(ws + WS_XN), Sc, E);
        { pg8::GUnit u2; const int nidle = 2 * G - 448;
          if (G == 256 && !Sc.next(1, u2)) { int j = 0, my = -1; for (int c2 = 0; c2 < G; ++c2) { pg8::StaticSched S2 = Sc; S2.c = c2; pg8::GUnit t2; if (!S2.next(1, t2)) { if (c2 == bx) my = j; ++j; } }
              (void)nidle; if (my >= 0) convert_expert_items(args, (LAS float*)(lds + RING_OFF + wave * 16384), lane, my * NWAVES + wave, j * NWAVES, EXP_N0, EXP_N1); } }
        SEAM(1);
    }
    const lru::Params LP{(const bf16_t*)(ws + WS_LX), (const bf16_t*)(ws + WS_LG), args.in[5], args.in[6], args.in[8], args.in[10], args.in[11], args.in[13], (const bf16_t*)(ws + WS_WL),
                         (lru::f32x2*)(ws + WS_SUMS), (bf16_t*)(ws + WS_MIX), (unsigned*)(ws + WS_X1)};
    if (IN(2)) {
        if (args.flags & FL_LRU) for (int task = bx; task < NB * NCH; task += G) lru::lru_summaries(LP, lds, task / NCH, task % NCH);
        SEAM(2);
    }
    if (IN(3)) {
        const bool lru_first = (vcu & 1) == 0;
        if ((args.flags & FL_LRU) && lru_first) { __syncthreads(); for (int task = bx; task < NB * NCH; task += G) lru::lru_apply(LP, lds, task / NCH, task % NCH); __syncthreads(); }
        if (args.flags & FL_ATTN) {
            float gq = 0.f, gk = 0.f; { const float a0 = fabsf(args.in[3][lane]), a1 = fabsf(args.in[4][lane]); gq = a0; gk = a1;
#pragma unroll
                for (int o = 1; o < 64; o <<= 1) { gq = fmaxf(gq, __shfl_xor(gq, o)); gk = fmaxf(gk, __shfl_xor(gk, o)); } }
            const float smax = 8.0f * 1.4426950408889634f * gq * gk * 1.01f; const bool fixref = __builtin_amdgcn_readfirstlane(smax < 40.0f ? 1 : 0) != 0;
            for (int L = vcu; L < NB * 8 * (S / 256); L += G) {
                const int per = 64;
                const int grp = L / per, r = L % per;
                const int b = grp >> 2, kvh = (grp >> 1) & 1, hp = grp & 1, hg = 2 * hp + (r >> 5), qb = r & 31;
                if (fixref) attn_body::attn_unit<8, true>(b, kvh * 4 + hg, qb, (const attn_body::bf16*)(ws + WS_Q), (const attn_body::bf16*)(ws + WS_K), (const attn_body::bf16*)(ws + WS_V),
                                        (attn_body::bf16*)(ws + WS_MIX), (float*)(ws + WS_SSQ), (char*)lds_raw + RING_OFF, smax - 20.0f);
                else attn_body::attn_unit<8, false>(b, kvh * 4 + hg, qb, (const attn_body::bf16*)(ws + WS_Q), (const attn_body::bf16*)(ws + WS_K), (const attn_body::bf16*)(ws + WS_V),
                                        (attn_body::bf16*)(ws + WS_MIX), (float*)(ws + WS_SSQ), (char*)lds_raw + RING_OFF, 0.0f);
            }
        }
        if ((args.flags & FL_LRU) && !lru_first) { __syncthreads(); for (int task = bx; task < NB * NCH; task += G) lru::lru_apply(LP, lds, task / NCH, task % NCH); __syncthreads(); }
        SEAM(3);
    }
    if (IN(4)) {
        pg8::StaticSched Sc; Sc.init(ws + WS_WOUT, T, D, G, bx);
        pg8::EpiOut E{args.in[0], (const float*)(ws + WS_SSQ), (float*)(ws + WS_X1), ws + WS_X1B};
        pg8::gemm_phase<pg8::EpiOut, pg8::StaticSched>(lds + RING_OFF, (const char*)(ws + WS_MIX), Sc, E);
        SEAM(4);
    }
    if (IN(5)) { p5_route(args, lds, G); SEAM(5); }
    if (IN(6) || IN(7)) {
        __syncthreads();
        if (tid < 64) { const unsigned c = (tid < NE) ? __hip_atomic_load(ctl + CW_CNT + tid * CNT_STRIDE, RLX_AGENT) : 0u; unsigned tl = (c + 255u) >> 8, s = tl;
#pragma unroll
            for (int o = 1; o < 32; o <<= 1) { const unsigned v = __shfl_up(s, o); if ((tid & 31) >= o) s += v; }
            if (tid < NE) { MISC[16 + tid + 1] = s; MISC[64 + tid] = c; if (tid == 0) MISC[16] = 0u; } }
        __syncthreads();
        if (tid < 320) { int e = 0; for (int k = 1; k < NE; ++k) e += (MISC[16 + k] <= (unsigned)tid) ? 1 : 0; ((volatile LAS unsigned char*)(lds + MISC_OFF + 512))[tid] = (unsigned char)e; }
        __syncthreads();
    }
    const LAS unsigned* Pl = (const LAS unsigned*)(lds + MISC_OFF + 64); const LAS unsigned* Cl = (const LAS unsigned*)(lds + MISC_OFF + 256); const LAS unsigned char* Te = (const LAS unsigned char*)(lds + MISC_OFF + 512);
#if MOE_MERGE
    if (IN(6)) {
        pg8::MoeSchedM Sc{Pl, Cl, Te, (const int*)(ws + WS_LIST), (unsigned*)ctl + CW_READY, (unsigned*)ctl + CW_TMO, ws, G, vcu};
        pg8::EpiMoeM E{pg8::EpiMoe1{Cl, (const float*)(ws + WS_LISTR), args.in[19], args.in[21], ws + WS_H}, pg8::EpiMoe2{Cl, (const int*)(ws + WS_LIST), (const float*)(ws + WS_LISTG), args.in[23], ws + WS_Y}};
        pg8::gemm_phase<pg8::EpiMoeM, pg8::MoeSchedM, true>(lds + RING_OFF, (const char*)ws, Sc, E);
        if (IN(8)) xcd_barrier(bar);
    }
#else
    if (IN(6)) {
        pg8::MoeSched Sc{Pl, Cl, Te, (const int*)(ws + WS_LIST), (const char*)(ws + WS_BT1), (size_t)2048 * 1024, 8, G, vcu, true};
        pg8::EpiMoe1 E{Cl, (const float*)(ws + WS_LISTR), args.in[19], args.in[21], ws + WS_H};
        pg8::gemm_phase<pg8::EpiMoe1, pg8::MoeSched, true>(lds + RING_OFF, (const char*)(ws + WS_X1B), Sc, E);
        for (;;) {
            __syncthreads();
            if (tid == 0) MISC[8] = __hip_atomic_fetch_add(ctl + 3, 8u, RLX_AGENT);
            __syncthreads();
            const unsigned base = MISC[8];
            if (base >= (unsigned)EXP_STEAL) break;
            convert_expert_items(args, (LAS float*)(lds + RING_OFF + wave * 16384), lane, (int)base + wave, EXP_STEAL, EXP_N1, EXP_ITEMS);
        }
        SEAM(6);
    }
    if (IN(7)) {
        pg8::MoeSched Sc{Pl, Cl, Te, (const int*)(ws + WS_LIST), (const char*)(ws + WS_BT2), (size_t)1024 * 1024, 4, G, vcu, false};
        pg8::EpiMoe2 E{Cl, (const int*)(ws + WS_LIST), (const float*)(ws + WS_LISTG), args.in[23], ws + WS_Y};
        pg8::gemm_phase<pg8::EpiMoe2, pg8::MoeSched, true>(lds + RING_OFF, (const char*)(ws + WS_H), Sc, E);
        SEAM(7);
    }
#endif
    if (IN(8)) p8_final(args, vcu, G, wave, lane);
#undef IN
#undef SEAM
}

static int g_grid = 0;
static bool mk_setup() {
    if (g_grid == 0) {
        int dev = 0, cus = 0, per_cu = 0;
        if (hipGetDevice(&dev) != hipSuccess || hipDeviceGetAttribute(&cus, hipDeviceAttributeMultiprocessorCount, dev) != hipSuccess) { g_grid = -1; return false; }
        if (hipFuncSetAttribute((const void*)mk_fwd, hipFuncAttributeMaxDynamicSharedMemorySize, LDS_BYTES) != hipSuccess) { fprintf(stderr, "kernel_launch: hipFuncSetAttribute failed\n"); g_grid = -1; return false; }
        if (hipOccupancyMaxActiveBlocksPerMultiprocessor(&per_cu, (const void*)mk_fwd, NWAVES * 64, LDS_BYTES) != hipSuccess || per_cu < 1) { fprintf(stderr, "kernel_launch: occupancy query says %d blocks per CU\n", per_cu); g_grid = -1; return false; }
        (void)hipGetLastError();
        g_grid = cus;
    }
    return g_grid > 0;
}
static void mk_launch(void* const* d_in, float* out, void* ws, int lo, int hi, int flags, int li, hipStream_t st) {
    if (!mk_setup()) return;
    Args a{};
    for (int i = 0; i < 25; ++i) a.in[i] = (const float*)d_in[i];
    a.out = out; a.ws = (unsigned char*)ws; a.ph_lo = lo; a.ph_hi = hi; a.flags = flags; a.li = li;
    hipLaunchKernelGGL(mk_fwd, dim3(g_grid), dim3(NWAVES * 64), LDS_BYTES, st, a);
}
}
extern "C" void kernel_launch(void* const* d_in, const int* in_sizes, int n_in, void* d_out, int out_size, void* d_ws, size_t ws_size, hipStream_t stream) {
    if (n_in != 25 || ws_size < (size_t)mk::WS_END || out_size != mk::T * mk::D) { fprintf(stderr, "kernel_launch: unexpected n_in %d / ws_size %zu / out_size %d\n", n_in, ws_size, out_size); return; }
    (void)hipMemsetAsync((char*)d_ws + mk::WS_CTL, 0, mk::CTL_ZERO_BYTES, stream);
    mkf::mk_launch(d_in, (float*)d_out, d_ws, 0, 9, mkf::FL_LRU | mkf::FL_ATTN, 0, stream);
}
```

```cpp
#define ONE_LAUNCH 1
#include <hip/hip_runtime.h>
#include <hip/hip_bf16.h>
#include <stdint.h>
#include <math.h>
#include <cstdio>

#ifndef MOE_MERGE
#define MOE_MERGE 0
#endif
namespace mk {
constexpr int NB = 2, S = 8192, T = NB * S, D = 1024, INW = 1792, NE = 32, LW = 512;
constexpr float C2 = 0.125f * 1.4426950408889634f;
constexpr int LC = 64, NCH = S / LC;
constexpr size_t MiB = 1u << 20;
constexpr size_t WS_CTL = 0, CTL_ZERO_BYTES = MOE_MERGE ? 1 * MiB : 32 * 1024;
constexpr size_t WS_ROPE = 1 * MiB;
constexpr size_t WS_WL = 1 * MiB + 64 * 1024;
constexpr size_t WS_RTR = 1 * MiB + 512 * 1024;
constexpr size_t WS_SUMS = 2 * MiB;
constexpr size_t WS_SSQ = 4 * MiB;
constexpr size_t WS_RSTD = 4 * MiB + 512 * 1024;
constexpr size_t WS_GATEV = 4 * MiB + 768 * 1024;
constexpr size_t WS_LIST = 5 * MiB;
constexpr size_t WS_WIN = 8 * MiB, WS_WOUT = 12 * MiB, WS_BT1 = 14 * MiB, WS_BT2 = 142 * MiB, WS_XN = 206 * MiB, WS_X1 = 238 * MiB;
constexpr size_t WS_Q = 302 * MiB, WS_K = 318 * MiB, WS_V = 322 * MiB, WS_LX = 326 * MiB, WS_LG = 342 * MiB, WS_MIX = 358 * MiB;
constexpr size_t WS_H = 302 * MiB, WS_Y = 14 * MiB, WS_X1B = 206 * MiB, WS_END = 446 * MiB;
constexpr size_t WS_LISTR = 2 * MiB;
constexpr size_t WS_LISTG = 224 * MiB;
constexpr size_t WS_SCR = 390 * MiB;
constexpr int CW_READY = 65536;
constexpr int CW_TMO = 0, CW_CODE = 1, CW_CNT = 64, CNT_STRIDE = 64, CW_BAR = 4096;

typedef unsigned short bf16_t;
__host__ __device__ __forceinline__ unsigned f2bf(float f) { unsigned u = __builtin_bit_cast(unsigned, f); return (u + 0x7fffu + ((u >> 16) & 1u)) >> 16; }
__host__ __device__ __forceinline__ float bf2f(unsigned h) { return __builtin_bit_cast(float, (h & 0xffffu) << 16); }
__host__ __device__ __forceinline__ unsigned pk2(float lo, float hi) { return f2bf(lo) | (f2bf(hi) << 16); }

typedef unsigned u32x4_t __attribute__((ext_vector_type(4)));
#ifndef WT_STORES
#define WT_STORES 1
#endif
template <int ON = 1> __device__ __forceinline__ void st16_wt(void* p, u32x4_t v) {
  if constexpr (ON) {
#if WT_STORES
    asm volatile("global_store_dwordx4 %0, %1, off sc1\n\ts_nop 1" :: "v"(p), "v"(v) : "memory");
#else
    *(u32x4_t*)p = v;
#endif
  } else *(u32x4_t*)p = v;
}
#ifndef WT_P0
#define WT_P0 0
#endif
#ifndef WT_EPI
#define WT_EPI 0
#endif
__host__ __device__ __forceinline__ int perm_cl(int o) { const int fq = o >> 3, n = (o >> 2) & 1, e = o & 3; return 16 * n + 4 * fq + e; }
__host__ __device__ __forceinline__ int perm256_dst(int c) { const int pn = c >> 8, cp = c & 255, bj = cp >> 7, wc = (cp >> 5) & 3; return 256 * pn + 128 * bj + 32 * wc + perm_cl(cp & 31); }
__host__ __device__ __forceinline__ int win_dst(int c) {
    if (c < 768) { const int pn = c >> 8, cp = c & 255, wc = cp >> 6, bj = (cp >> 5) & 1, j = cp & 31; return 256 * pn + 128 * bj + 32 * wc + j; }
    return perm256_dst(c);
}
__host__ __device__ __forceinline__ int down_dst(int c) { const int pn = c >> 8, cp = c & 255, wc = cp >> 6, fq = (cp >> 4) & 3, bj = (cp >> 3) & 1, n = (cp >> 2) & 1, e = cp & 3; return 256 * pn + 128 * bj + 32 * wc + 16 * n + 4 * fq + e; }
__host__ __device__ __forceinline__ int gu_dst(int hc, int half) { const int j = hc >> 7, wc = (hc >> 5) & 3; return 256 * j + 128 * half + 32 * wc + perm_cl(hc & 31); }
}
namespace nv {
using namespace mk;
__device__ __forceinline__ void tbl_rope(int idx, float* rope) {
    const int pos = idx >> 4, i = idx & 15; const float ang = (float)pos * powf(10000.0f, -(float)i / 16.0f);
    rope[idx] = cosf(ang); rope[2048 + idx] = sinf(ang);
}
__device__ __forceinline__ void tbl_wl(int idx, const float* wa, const float* wi, bf16_t* WL) {
    const int j = idx & 7, lane = (idx >> 3) & 63, ks = (idx >> 9) & 3, nh = (idx >> 11) & 1, mat = (idx >> 12) & 3, n = idx >> 14;
    const int r32 = lane & 31, hi = lane >> 5, i = 16 * ks + 8 * hi + j, jc = 32 * nh + r32, dir = mat >> 1;
    const float* W = (mat & 1) ? wi : wa;
    WL[idx] = (bf16_t)f2bf(W[((size_t)(dir * 8 + n) * 64 + i) * 64 + jc]);
}
__device__ __forceinline__ void tbl_rtr(int idx, const float* wr, const float* n2g, bf16_t* RT) {
    const int j = idx & 7, lane = (idx >> 3) & 63, ks = idx >> 9; const int e = lane & 31, hi = lane >> 5, k = 16 * ks + 8 * hi + j;
    const float w = n2g[k] * wr[(size_t)k * NE + e]; const unsigned h = f2bf(w);
    RT[idx] = (bf16_t)h; RT[32768 + idx] = (bf16_t)f2bf(w - bf2f(h));
}
}
namespace pg8 {
using mk::bf16_t;
#define PG8_LAS __attribute__((address_space(3)))
typedef short bf16x8 __attribute__((ext_vector_type(8)));
typedef float f32x4 __attribute__((ext_vector_type(4)));
typedef unsigned u32x4 __attribute__((ext_vector_type(4)));
typedef unsigned u32x2 __attribute__((ext_vector_type(2)));
typedef int v8i __attribute__((ext_vector_type(8)));
typedef int v4i __attribute__((ext_vector_type(4)));
constexpr int BM = 256, BK = 64, HALF = 128, HTB = HALF * BK * 2, STAGE_BYTES = 8 * HTB, NXCD = 8, WGM = 8, KD = 1024;

__host__ __device__ __forceinline__ int lds_byte(int r, int c) { const int st = (r >> 4) * 2 + (c >> 5), rr = r & 15, cc = c & 31, ob = rr * 64 + cc * 2; return st * 1024 + (ob ^ (((ob >> 9) & 1) << 5)); }
__host__ __device__ __forceinline__ void stage_rc(int b, int& R, int& C) { const int st = b / 1024, sb = b % 1024, swz = sb ^ (((sb >> 9) & 1) << 5); R = (st >> 1) * 16 + swz / 64; C = (st & 1) * 32 + (swz % 64) / 2; }

struct GUnit { int pm, pn, e, lt, kind; };

struct StaticSched {
    const char* Bt; int nM, nN, nwg, G, c;
    __device__ void init(const void* Bt_, int M, int N, int G_, int c_) { Bt = (const char*)Bt_; nM = M / BM; nN = N / BM; nwg = nM * nN; G = G_; c = c_; }
    __device__ __forceinline__ bool next(int i, GUnit& u) const {
        const long L = (long)i * G + c; if (L >= nwg) return false;
        int wgid = (int)L; { const int q = nwg / NXCD, r = nwg % NXCD, xcd = wgid % NXCD, off = wgid / NXCD; wgid = (xcd < r ? xcd * (q + 1) : r * (q + 1) + (xcd - r) * q) + off; }
        const int nig = WGM * nN, gid = wgid / nig, fm = gid * WGM, gsz = (nM - fm) < WGM ? (nM - fm) : WGM;
        u.pm = fm + ((wgid % nig) % gsz); u.pn = (wgid % nig) / gsz; u.e = 0; u.lt = 0; u.kind = 0; return true;
    }
    __device__ __forceinline__ void aoffs_issue(const GUnit& u, int tid, unsigned (&raw)[2][2]) const {
#pragma unroll
        for (int i = 0; i < 2; ++i) { int R, C; stage_rc(tid * 16 + i * 8192, R, C);
#pragma unroll
            for (int h = 0; h < 2; ++h) raw[h][i] = (unsigned)((u.pm * BM + h * HALF + R) * KD + C) * 2u; }
    }
    __device__ __forceinline__ void aoffs_finish(const GUnit&, int, const unsigned (&raw)[2][2], unsigned (&ao)[2][2]) const {
#pragma unroll
        for (int h = 0; h < 2; ++h)
#pragma unroll
            for (int i = 0; i < 2; ++i) ao[h][i] = raw[h][i];
    }
    __device__ __forceinline__ const char* bbase(const GUnit& u) const { return Bt + (size_t)u.pn * BM * KD * 2; }
    static constexpr int A_AUX = 0;
    __device__ __forceinline__ void wait_ready(const GUnit&, int) const {}
    __device__ __forceinline__ void publish(const GUnit&, int) const {}
};

template <class Epi, class Sched, bool F8 = false>
__device__ __forceinline__ void gemm_phase(PG8_LAS unsigned char* lds, const char* Abase, const Sched& S, const Epi& E) {
    int tid_ = threadIdx.x; asm volatile("" : "+v"(tid_));
    const int tid = tid_, wid = __builtin_amdgcn_readfirstlane(tid >> 6), lane = tid & 63, wr = wid >> 2, wc = wid & 3, fr = lane & 15, fq = lane >> 4;
    constexpr int K = KD, nt = F8 ? K / 128 : K / BK; constexpr unsigned ROWB = F8 ? 1024u : 2048u;
    unsigned voffB[2];
#pragma unroll
    for (int i = 0; i < 2; ++i) { int R, C; stage_rc(tid * 16 + i * 8192, R, C); voffB[i] = (unsigned)R * ROWB + 2u * (unsigned)C; }
    PG8_LAS u32x4* aon = (PG8_LAS u32x4*)(lds + STAGE_BYTES) + tid;
    constexpr unsigned kstep = BK * 2;
    constexpr size_t hstep = (size_t)HALF * ROWB;
    const unsigned ldsw = (unsigned)wid * 1024u;
    const int aoff = lds_byte(wr * 64 + fr, fq * 8), boff = lds_byte(wc * 32 + fr, fq * 8);
#define PG8_SA(b, h) (((b) * 2 + (h)) * HTB)
#define PG8_SB(b, h) ((4 + (b) * 2 + (h)) * HTB)
#define PG8_STAGE_B(bufoff, gbase) do { _Pragma("unroll") for (int _i = 0; _i < 2; ++_i) \
        __builtin_amdgcn_global_load_lds((const unsigned*)((const char*)(gbase) + voffB[_i]), (PG8_LAS unsigned*)(lds + (bufoff) + ldsw + _i * 8192), 16, 0, 0); } while (0)
#define PG8_STAGE_A(bufoff, o0, o1) do { \
        __builtin_amdgcn_global_load_lds((const unsigned*)(Abase + (o0)), (PG8_LAS unsigned*)(lds + (bufoff) + ldsw), 16, 0, Sched::A_AUX); \
        __builtin_amdgcn_global_load_lds((const unsigned*)(Abase + (o1)), (PG8_LAS unsigned*)(lds + (bufoff) + ldsw + 8192), 16, 0, Sched::A_AUX); } while (0)
#define PG8_LD2(p) __builtin_shufflevector(*(const PG8_LAS v4i*)(p), *(const PG8_LAS v4i*)((p) + 1024), 0, 1, 2, 3, 4, 5, 6, 7)
#define PG8_LDA(dst, b, h) do { _Pragma("unroll") for (int m = 0; m < 4; ++m) dst[m] = PG8_LD2(lds + PG8_SA(b, h) + aoff + m * 2048); } while (0)
#define PG8_LDB(dst, b, h) do { _Pragma("unroll") for (int n = 0; n < 2; ++n) dst[n] = PG8_LD2(lds + PG8_SB(b, h) + boff + n * 2048); } while (0)
#define PG8_HALF(v, k) __builtin_bit_cast(bf16x8, (v4i){(v)[4 * (k)], (v)[4 * (k) + 1], (v)[4 * (k) + 2], (v)[4 * (k) + 3]})
#define PG8_MMA(ai, bj, At, Bt) do { __builtin_amdgcn_s_setprio(1); \
        if constexpr (F8) { _Pragma("unroll") for (int m = 0; m < 4; ++m) _Pragma("unroll") for (int n = 0; n < 2; ++n) \
            asm volatile("v_mfma_scale_f32_16x16x128_f8f6f4 %0, %1, %2, %0, %3, %4 op_sel_hi:[0,0,0]" : "+v"(acc[ai][bj][m][n]) : "v"(Bt[n]), "v"(At[m]), "v"(scw), "v"(sca)); } \
        else { _Pragma("unroll") for (int m = 0; m < 4; ++m) _Pragma("unroll") for (int n = 0; n < 2; ++n) _Pragma("unroll") for (int k = 0; k < 2; ++k) \
            acc[ai][bj][m][n] = __builtin_amdgcn_mfma_f32_16x16x32_bf16(PG8_HALF(Bt[n], k), PG8_HALF(At[m], k), acc[ai][bj][m][n], 0, 0, 0); } \
        __builtin_amdgcn_s_setprio(0); } while (0)
#define PG8_WAIT_V(n) asm volatile("s_waitcnt vmcnt(" #n ")" ::: "memory")
#define PG8_WAIT_L(n) asm volatile("s_waitcnt lgkmcnt(" #n ")" ::: "memory")
#define PG8_BAR __builtin_amdgcn_s_barrier()
#define PG8_SCHED __builtin_amdgcn_sched_barrier(0)
    GUnit cur, nxt, nn; int ui = 0;
    if (!S.next(0, cur)) return;
    f32x4 acc[2][2][4][2];
#pragma unroll
    for (int a = 0; a < 2; ++a)
#pragma unroll
        for (int b = 0; b < 2; ++b)
#pragma unroll
            for (int m = 0; m < 4; ++m)
#pragma unroll
                for (int n = 0; n < 2; ++n) acc[a][b][m][n] = (f32x4){0.f, 0.f, 0.f, 0.f};
    v8i At[4], B0[2], B1[2];
    int scw = Epi::SC_W, sca = E.sc_a(cur); if constexpr (F8) asm volatile("" : "+v"(scw), "+v"(sca));
    unsigned aoC[2][2], rawN[2][2];
    S.wait_ready(cur, lane);
    { unsigned raw0[2][2]; S.aoffs_issue(cur, tid, raw0); S.aoffs_finish(cur, tid, raw0, aoC); }
    GUnit prv = cur; bool have_prv = false;
    bool has_next = S.next(1, nxt);
    if (has_next) S.aoffs_issue(nxt, tid, rawN);
    const char* cB = S.bbase(cur);
    PG8_STAGE_B(PG8_SB(0, 0), cB); PG8_STAGE_B(PG8_SB(0, 1), cB + hstep); PG8_STAGE_A(PG8_SA(0, 0), aoC[0][0], aoC[0][1]); PG8_STAGE_A(PG8_SA(0, 1), aoC[1][0], aoC[1][1]);
    if (wr == 1) PG8_BAR;
    PG8_WAIT_V(2); PG8_BAR;
    PG8_STAGE_B(PG8_SB(1, 0), cB + kstep); PG8_STAGE_A(PG8_SA(1, 0), aoC[0][0] + kstep, aoC[0][1] + kstep); PG8_STAGE_B(PG8_SB(1, 1), cB + hstep + kstep);
    PG8_WAIT_V(6); PG8_BAR;
    for (;;) {
        const bool has_nn = has_next && S.next(ui + 2, nn);
        if (has_next && nxt.kind && have_prv) { PG8_WAIT_V(0); S.publish(prv, lane); have_prv = false; }
        if (has_next) S.wait_ready(nxt, lane);
        const char* nB = cB;
        { unsigned aoN[2][2];
          if (has_next) { S.aoffs_finish(nxt, tid, rawN, aoN); nB = S.bbase(nxt); }
          else {
#pragma unroll
            for (int h = 0; h < 2; ++h)
#pragma unroll
                for (int i = 0; i < 2; ++i) aoN[h][i] = aoC[h][i];
          }
          *aon = (u32x4){aoN[0][0], aoN[0][1], aoN[1][0], aoN[1][1]}; }
        if (has_nn) S.aoffs_issue(nn, tid, rawN);
#pragma unroll 1
        for (int t = 0; t < nt; t += 2) {
            const bool last = (t == nt - 2);
            if constexpr (Epi::MID) { if (t == nt / 2) E.mid(acc, cur, wr, fr); }
            if (t == 2 && have_prv) { S.publish(prv, lane); have_prv = false; }
            if (last) E.prefetch(lds, cur, wid, lane);
            const unsigned k1 = (unsigned)(t + 1) * kstep;
            unsigned a2_00 = aoC[0][0] + (unsigned)(t + 2) * kstep, a2_01 = aoC[0][1] + (unsigned)(t + 2) * kstep, a2_10 = aoC[1][0] + (unsigned)(t + 2) * kstep, a2_11 = aoC[1][1] + (unsigned)(t + 2) * kstep;
            if (last) { const u32x4 v = *aon; a2_00 = v.x; a2_01 = v.y; a2_10 = v.z; a2_11 = v.w; }
            const char* b2 = last ? nB : cB + (size_t)(t + 2) * kstep; const char* b3 = b2 + kstep;
            PG8_LDB(B0, 0, 0); PG8_LDB(B1, 0, 1); PG8_SCHED; PG8_LDA(At, 0, 0); PG8_STAGE_A(PG8_SA(1, 1), aoC[1][0] + k1, aoC[1][1] + k1);
            PG8_WAIT_V(8); PG8_WAIT_L(0); PG8_BAR; PG8_MMA(0, 0, At, B0); PG8_MMA(0, 1, At, B1); PG8_BAR; PG8_SCHED;
            PG8_LDA(At, 0, 1); PG8_STAGE_B(PG8_SB(0, 0), b2); PG8_STAGE_B(PG8_SB(0, 1), b2 + hstep); PG8_STAGE_A(PG8_SA(0, 0), a2_00, a2_01);
            PG8_WAIT_V(8); PG8_WAIT_L(0); PG8_BAR; PG8_MMA(1, 0, At, B0); PG8_MMA(1, 1, At, B1); PG8_BAR; PG8_SCHED;
            PG8_LDB(B0, 1, 0); PG8_LDB(B1, 1, 1); PG8_SCHED; PG8_LDA(At, 1, 0); PG8_STAGE_A(PG8_SA(0, 1), a2_10, a2_11);
            PG8_WAIT_V(8); PG8_WAIT_L(0); PG8_BAR; PG8_MMA(0, 0, At, B0); PG8_MMA(0, 1, At, B1); PG8_BAR; PG8_SCHED;
            PG8_LDA(At, 1, 1); PG8_STAGE_B(PG8_SB(1, 0), b3); PG8_STAGE_B(PG8_SB(1, 1), b3 + hstep); PG8_STAGE_A(PG8_SA(1, 0), a2_00 + kstep, a2_01 + kstep);
            PG8_WAIT_V(8); PG8_WAIT_L(0); PG8_BAR; PG8_MMA(1, 0, At, B0); PG8_MMA(1, 1, At, B1); PG8_BAR; PG8_SCHED;
        }
        if constexpr (F8) asm volatile("s_nop 15\n\ts_nop 15" ::: "memory");
        if (wr == 0) PG8_BAR;
        E(acc, cur, lds, wr, wc, fr, fq);
        prv = cur; have_prv = true;
        if (!has_next) break;
#pragma unroll
        for (int a = 0; a < 2; ++a)
#pragma unroll
            for (int b = 0; b < 2; ++b)
#pragma unroll
                for (int m = 0; m < 4; ++m)
#pragma unroll
                    for (int n = 0; n < 2; ++n) acc[a][b][m][n] = (f32x4){0.f, 0.f, 0.f, 0.f};
        cur = nxt; nxt = nn; has_next = has_nn; cB = nB; ++ui;
        if constexpr (F8) { sca = E.sc_a(cur); asm volatile("" : "+v"(sca)); }
        { const u32x4 v = *aon; aoC[0][0] = v.x; aoC[0][1] = v.y; aoC[1][0] = v.z; aoC[1][1] = v.w; }
        if (wr == 1) PG8_BAR;
    }
    PG8_WAIT_V(0);
    if (have_prv) S.publish(prv, lane);
    PG8_BAR;
#undef PG8_SA
#undef PG8_SB
#undef PG8_STAGE_A
#undef PG8_STAGE_B
#undef PG8_LDA
#undef PG8_LDB
#undef PG8_MMA
#undef PG8_LD2
#undef PG8_HALF
#undef PG8_WAIT_V
#undef PG8_WAIT_L
#undef PG8_BAR
#undef PG8_SCHED
}
}
namespace pg8 {
using namespace mk;
__device__ __forceinline__ unsigned cvt_pk_bf16(float lo, float hi) { unsigned r; asm volatile("v_cvt_pk_bf16_f32 %0, %1, %2" : "=v"(r) : "v"(lo), "v"(hi)); return r; }

struct EpiInProj {
    static constexpr bool MID = false; static constexpr int SC_W = 0x7F7F7F7F, SC_A = 0x7F7F7F7F;
    __device__ __forceinline__ void prefetch(PG8_LAS unsigned char*, const GUnit&, int, int) const {}
    __device__ __forceinline__ int sc_a(const GUnit&) const { return SC_A; }
    bf16_t *Q, *Kb, *V, *LX, *LG; const float *qg, *kg, *rope;
    __device__ __forceinline__ void operator()(const f32x4 (&acc)[2][2][4][2], const GUnit& u, PG8_LAS unsigned char* lds, int wr, int wc, int fr_, int fq_) const {
        int fr = fr_, fq = fq_; asm volatile("" : "+v"(fr), "+v"(fq));
        const int row0 = u.pm * BM + wr * 64 + fr;
        if (u.pn >= 3) {
            bf16_t* base = (u.pn < 5) ? LX : LG; const int col0 = ((u.pn - 3) & 1) * 256 + wc * 32 + 8 * fq;
#pragma unroll
            for (int ai = 0; ai < 2; ++ai)
#pragma unroll
                for (int m = 0; m < 4; ++m) { bf16_t* rowp = base + (size_t)(row0 + ai * HALF + m * 16) * 512 + col0;
#pragma unroll
                    for (int bj = 0; bj < 2; ++bj) { const f32x4 v0 = acc[ai][bj][m][0], v1 = acc[ai][bj][m][1];
                        u32x4 w; w.x = cvt_pk_bf16(v0[0], v0[1]); w.y = cvt_pk_bf16(v0[2], v0[3]); w.z = cvt_pk_bf16(v1[0], v1[1]); w.w = cvt_pk_bf16(v1[2], v1[3]);
                        st16_wt<WT_EPI>(rowp + bj * HALF, w); } }
            return;
        }
        if (u.pn == 2 && wc >= 2) {
#pragma unroll
            for (int ai = 0; ai < 2; ++ai)
#pragma unroll
                for (int m = 0; m < 4; ++m) { bf16_t* rowp = V + (size_t)(row0 + ai * HALF + m * 16) * 128 + 64 * (wc - 2) + 4 * fq;
#pragma unroll
                    for (int bj = 0; bj < 2; ++bj)
#pragma unroll
                        for (int n = 0; n < 2; ++n) { const f32x4 v = acc[ai][bj][m][n]; u32x2 w; w.x = cvt_pk_bf16(v[0], v[1]); w.y = cvt_pk_bf16(v[2], v[3]); *(u32x2*)(rowp + 32 * bj + 16 * n) = w; } }
            return;
        }
        const bool isq = u.pn < 2; const float* gp = (isq ? qg : kg) + 4 * fq; const float osc = isq ? C2 : 1.0f;
#pragma unroll
        for (int ai = 0; ai < 2; ++ai)
#pragma unroll
            for (int m = 0; m < 4; ++m) {
                const int t = row0 + ai * HALF + m * 16;
                float ss = 0.f;
#pragma unroll
                for (int bj = 0; bj < 2; ++bj)
#pragma unroll
                    for (int n = 0; n < 2; ++n) { const f32x4 v = acc[ai][bj][m][n]; ss += (v[0] * v[0] + v[1] * v[1]) + (v[2] * v[2] + v[3] * v[3]); }
                ss += __shfl_xor(ss, 16); ss += __shfl_xor(ss, 32);
                const float rs = osc / sqrtf(ss * (1.0f / 64.0f) + 1e-6f);
                const int s = t & (S - 1), posr = s >> 6, posc = s & 63;
                bf16_t* rowp = isq ? Q + (size_t)t * 512 + 64 * (4 * u.pn + wc) + 4 * fq : Kb + (size_t)t * 128 + 64 * wc + 4 * fq;
#pragma unroll
                for (int bj = 0; bj < 2; ++bj) {
                    const int pos = bj ? posc : posr;
                    const f32x4 c4 = *(const f32x4*)(rope + pos * 16 + 4 * fq), s4 = *(const f32x4*)(rope + 2048 + pos * 16 + 4 * fq);
                    const f32x4 g0 = *(const f32x4*)(gp + 32 * bj), g1 = *(const f32x4*)(gp + 32 * bj + 16);
                    const f32x4 x1 = acc[ai][bj][m][0] * g0 * rs, x2 = acc[ai][bj][m][1] * g1 * rs;
                    const f32x4 o1 = x1 * c4 - x2 * s4, o2 = x2 * c4 + x1 * s4;
                    u32x2 w1, w2; w1.x = cvt_pk_bf16(o1[0], o1[1]); w1.y = cvt_pk_bf16(o1[2], o1[3]); w2.x = cvt_pk_bf16(o2[0], o2[1]); w2.y = cvt_pk_bf16(o2[2], o2[3]);
                    *(u32x2*)(rowp + 32 * bj) = w1; *(u32x2*)(rowp + 32 * bj + 16) = w2;
                }
                asm volatile("" ::: "memory");
            }
    }
};

struct EpiOut {
    static constexpr bool MID = true; static constexpr int SC_W = 0x7F7F7F7F, SC_A = 0x7F7F7F7F;
    __device__ __forceinline__ void prefetch(PG8_LAS unsigned char*, const GUnit&, int, int) const {}
    __device__ __forceinline__ int sc_a(const GUnit&) const { return SC_A; }
    const float* x; const float* SSQ; float* X1; unsigned char* X1F8; const float* g2;
    __device__ __forceinline__ void mid(f32x4 (&acc)[2][2][4][2], const GUnit& u, int wr, int fr_) const {
        int fr = fr_; asm volatile("" : "+v"(fr));
#pragma unroll
        for (int ai = 0; ai < 2; ++ai)
#pragma unroll
            for (int m = 0; m < 4; ++m) {
                const float* p = SSQ + (size_t)(u.pm * BM + ai * HALF + wr * 64 + m * 16 + fr) * 8;
                const f32x4 a = *(const f32x4*)p, b = *(const f32x4*)(p + 4);
                const float s = ((a[0] + a[1]) + (a[2] + a[3])) + ((b[0] + b[1]) + (b[2] + b[3]));
                const float sa = 1.0f / sqrtf(s * (1.0f / 512.0f) + 1e-5f);
#pragma unroll
                for (int bj = 0; bj < 2; ++bj)
#pragma unroll
                    for (int n = 0; n < 2; ++n) acc[ai][bj][m][n] *= sa;
            }
    }
    __device__ __forceinline__ void operator()(const f32x4 (&acc)[2][2][4][2], const GUnit& u, PG8_LAS unsigned char* lds, int wr, int wc, int fr_, int fq_) const {
        int fr = fr_, fq = fq_; asm volatile("" : "+v"(fr), "+v"(fq));
        const int row0 = u.pm * BM + wr * 64 + fr, col0 = u.pn * BM + wc * 32 + 8 * fq;
        f32x4 gg[2][2];
#pragma unroll
        for (int bj = 0; bj < 2; ++bj) { gg[bj][0] = *(const f32x4*)(g2 + col0 + bj * HALF); gg[bj][1] = *(const f32x4*)(g2 + col0 + bj * HALF + 4); }
#pragma unroll
        for (int ai = 0; ai < 2; ++ai)
#pragma unroll
            for (int m = 0; m < 4; ++m) { const size_t off = (size_t)(row0 + ai * HALF + m * 16) * D + col0;
#pragma unroll
                for (int bj = 0; bj < 2; ++bj) {
                    const f32x4 v0 = __builtin_nontemporal_load((const f32x4*)(x + off + bj * HALF)) + acc[ai][bj][m][0], v1 = __builtin_nontemporal_load((const f32x4*)(x + off + bj * HALF + 4)) + acc[ai][bj][m][1];
                    { u32x4 xb; xb.x = cvt_pk_bf16(v0[0], v0[1]); xb.y = cvt_pk_bf16(v0[2], v0[3]); xb.z = cvt_pk_bf16(v1[0], v1[1]); xb.w = cvt_pk_bf16(v1[2], v1[3]); st16_wt<WT_EPI>((bf16_t*)X1 + off + bj * HALF, xb); }
                    const f32x4 s0 = v0 * gg[bj][0], s1 = v1 * gg[bj][1];
                    int w0 = 0, w1 = 0; w0 = __builtin_amdgcn_cvt_pk_fp8_f32(s0[0], s0[1], w0, false); w0 = __builtin_amdgcn_cvt_pk_fp8_f32(s0[2], s0[3], w0, true);
                    w1 = __builtin_amdgcn_cvt_pk_fp8_f32(s1[0], s1[1], w1, false); w1 = __builtin_amdgcn_cvt_pk_fp8_f32(s1[2], s1[3], w1, true);
                    *(u32x2*)(X1F8 + off + bj * HALF) = (u32x2){(unsigned)w0, (unsigned)w1}; }
                if (m & 1) asm volatile("" ::: "memory"); }
    }
};

struct MoeSched {
    const PG8_LAS unsigned* P;
    const PG8_LAS unsigned* cntl;
    const PG8_LAS unsigned char* te;
    const int* list; const char* Bt; size_t estride; int ntn, G, vcu; bool gather;
    __device__ __forceinline__ bool next(int i, GUnit& u) const {
        const unsigned L = (unsigned)i * (unsigned)G + (unsigned)vcu; const unsigned mt = L / (unsigned)ntn;
        const unsigned tot = (unsigned)__builtin_amdgcn_readfirstlane((int)P[NE]);
        if (mt >= tot) return false;
        const int e = __builtin_amdgcn_readfirstlane((int)te[mt]);
        u.kind = 0; u.pm = (int)mt; u.pn = (int)(L % (unsigned)ntn); u.e = e; u.lt = (int)(mt - (unsigned)__builtin_amdgcn_readfirstlane((int)P[e])); return true;
    }
    __device__ __forceinline__ void aoffs_issue(const GUnit& u, int tid, unsigned (&raw)[2][2]) const {
        const int n = (int)cntl[u.e] - u.lt * BM;
#pragma unroll
        for (int i = 0; i < 2; ++i) { int R, C; stage_rc(tid * 16 + i * 8192, R, C);
#pragma unroll
            for (int h = 0; h < 2; ++h) {
                const int rr = h * HALF + R;
                if (gather) { raw[h][i] = 0u; if (rr < n) raw[h][i] = (unsigned)list[(size_t)u.e * T + u.lt * BM + rr]; }
                else raw[h][i] = (unsigned)(u.pm * BM + rr);
            } }
    }
    __device__ __forceinline__ void aoffs_finish(const GUnit&, int tid, const unsigned (&raw)[2][2], unsigned (&ao)[2][2]) const {
#pragma unroll
        for (int i = 0; i < 2; ++i) { int R, C; stage_rc(tid * 16 + i * 8192, R, C);
#pragma unroll
            for (int h = 0; h < 2; ++h) ao[h][i] = (gather ? (raw[h][i] >> 2) : raw[h][i]) * 1024u + 2u * (unsigned)C; }
    }
    __device__ __forceinline__ const char* bbase(const GUnit& u) const { return Bt + (size_t)u.e * estride + (size_t)u.pn * BM * 1024; }
    static constexpr int A_AUX = 0;
    __device__ __forceinline__ void wait_ready(const GUnit&, int) const {}
    __device__ __forceinline__ void publish(const GUnit&, int) const {}
};

struct EpiMoe1 {
    static constexpr bool MID = false; static constexpr int SC_W = 0x7A7A7A7A, SC_A = 0x7F7F7F7F;
    const PG8_LAS unsigned* cntl; const float* listr; const float* bg; const float* bu; unsigned char* H;
    __device__ __forceinline__ int sc_a(const GUnit&) const { return SC_A; }
    static constexpr int PRE_OFF = STAGE_BYTES + 8192;
    __device__ __forceinline__ void prefetch(PG8_LAS unsigned char* lds, const GUnit& u, int wid, int lane) const {
        if (wid < 4) { const int nvalid = (int)cntl[u.e] - u.lt * BM; int r = wid * 64 + lane; r = r < nvalid ? r : 0;
            __builtin_amdgcn_global_load_lds((const unsigned*)(listr + (size_t)u.e * T + u.lt * BM + r), (PG8_LAS unsigned*)(lds + PRE_OFF + wid * 256), 4, 0, 0); }
    }
    __device__ __forceinline__ void operator()(const f32x4 (&acc)[2][2][4][2], const GUnit& u, PG8_LAS unsigned char* lds, int wr, int wc, int fr_, int fq_) const {
        int fr = fr_, fq = fq_; asm volatile("" : "+v"(fr), "+v"(fq));
        const int nvalid = (int)cntl[u.e] - u.lt * BM; const int hc0 = u.pn * HALF + wc * 32 + 8 * fq;
        f32x4 bgv[2], buv[2];
#pragma unroll
        for (int n = 0; n < 2; ++n) { bgv[n] = *(const f32x4*)(bg + u.e * D + hc0 + 4 * n); buv[n] = *(const f32x4*)(bu + u.e * D + hc0 + 4 * n); }
#pragma unroll
        for (int ai = 0; ai < 2; ++ai)
#pragma unroll
            for (int m = 0; m < 4; ++m) {
                const int rl = ai * HALF + wr * 64 + m * 16 + fr;
                {
                    const float rs = *(const PG8_LAS float*)(lds + PRE_OFF + rl * 4);
                    int w[2] = {0, 0};
                    typedef float f2_ __attribute__((ext_vector_type(2)));
                    const f2_ rs2 = (f2_){rs, rs};
#pragma unroll
                    for (int n = 0; n < 2; ++n) {
                        const f32x4 ga = acc[ai][0][m][n], ua = acc[ai][1][m][n];
#pragma unroll
                        for (int p = 0; p < 2; ++p) {
                            const f2_ g = (f2_){ga[2 * p], ga[2 * p + 1]} * rs2 + (f2_){bgv[n][2 * p], bgv[n][2 * p + 1]};
                            const f2_ uu = (f2_){ua[2 * p], ua[2 * p + 1]} * rs2 + (f2_){buv[n][2 * p], buv[n][2 * p + 1]};
                            const f2_ gc = (f2_){fminf(g[0], 7.0f), fminf(g[1], 7.0f)}, uc = (f2_){fminf(fmaxf(uu[0], -7.0f), 7.0f), fminf(fmaxf(uu[1], -7.0f), 7.0f)};
                            const f2_ tt = gc * (f2_){-1.702f * 1.4426950408889634f, -1.702f * 1.4426950408889634f};
                            const f2_ dd = (f2_){__builtin_amdgcn_exp2f(tt[0]), __builtin_amdgcn_exp2f(tt[1])} + (f2_){1.0f, 1.0f};
                            const f2_ sg = (f2_){__builtin_amdgcn_rcpf(dd[0]), __builtin_amdgcn_rcpf(dd[1])};
                            const f2_ hv = (uc * (f2_){4.0f, 4.0f} + (f2_){4.0f, 4.0f}) * (gc * sg);
                            if (p == 0) w[n] = __builtin_amdgcn_cvt_pk_fp8_f32(hv[0], hv[1], w[n], false); else w[n] = __builtin_amdgcn_cvt_pk_fp8_f32(hv[0], hv[1], w[n], true);
                        }
                    }
#if MOE_MERGE
                    __hip_atomic_store((unsigned long long*)(H + (size_t)(u.pm * BM + rl) * 1024 + hc0), (unsigned long long)(unsigned)w[0] | ((unsigned long long)(unsigned)w[1] << 32), __ATOMIC_RELAXED, __HIP_MEMORY_SCOPE_AGENT);
#else
                    if (rl < nvalid) *(u32x2*)(H + (size_t)(u.pm * BM + rl) * 1024 + hc0) = (u32x2){(unsigned)w[0], (unsigned)w[1]};
#endif
                }
            }
    }
};
struct EpiMoe2 {
    static constexpr bool MID = false; static constexpr int SC_W = 0x7A7A7A7A, SC_A = 0x7D7D7D7D;
    const PG8_LAS unsigned* cntl; const int* list; const float* listg; const float* bd; unsigned char* Y;
    __device__ __forceinline__ int sc_a(const GUnit&) const { return SC_A; }
    static constexpr int PRE_OFF = STAGE_BYTES + 8192;
    __device__ __forceinline__ void prefetch(PG8_LAS unsigned char* lds, const GUnit& u, int wid, int lane) const {
        const int nvalid = (int)cntl[u.e] - u.lt * BM; int r = (wid & 3) * 64 + lane; r = r < nvalid ? r : 0;
        const size_t pos = (size_t)u.e * T + u.lt * BM + r;
        const unsigned* src = (wid < 4) ? (const unsigned*)(list + pos) : (const unsigned*)(listg + pos);
        __builtin_amdgcn_global_load_lds(src, (PG8_LAS unsigned*)(lds + PRE_OFF + (wid >> 2) * 1024 + (wid & 3) * 256), 4, 0, 0);
    }
    __device__ __forceinline__ void operator()(const f32x4 (&acc)[2][2][4][2], const GUnit& u, PG8_LAS unsigned char* lds, int wr, int wc, int fr_, int fq_) const {
        int fr = fr_, fq = fq_; asm volatile("" : "+v"(fr), "+v"(fq));
        const int nvalid = (int)cntl[u.e] - u.lt * BM; const int c0 = u.pn * BM + wc * 64 + 16 * fq;
        f32x4 bv[2][2];
#pragma unroll
        for (int bj = 0; bj < 2; ++bj)
#pragma unroll
            for (int n = 0; n < 2; ++n) bv[bj][n] = *(const f32x4*)(bd + u.e * D + c0 + 8 * bj + 4 * n);
#pragma unroll
        for (int ai = 0; ai < 2; ++ai)
#pragma unroll
            for (int m = 0; m < 4; ++m) {
                const int rl = ai * HALF + wr * 64 + m * 16 + fr;
                {
                    const int id = *(const PG8_LAS int*)(lds + PRE_OFF + rl * 4); const float gv = 16.0f * *(const PG8_LAS float*)(lds + PRE_OFF + 1024 + rl * 4);
                    int w[4];
#pragma unroll
                    for (int bj = 0; bj < 2; ++bj)
#pragma unroll
                        for (int n = 0; n < 2; ++n) { const f32x4 v = (acc[ai][bj][m][n] + bv[bj][n]) * gv; int t = 0;
                            t = __builtin_amdgcn_cvt_pk_fp8_f32(v[0], v[1], t, false); t = __builtin_amdgcn_cvt_pk_fp8_f32(v[2], v[3], t, true); w[2 * bj + n] = t; }
                    if (rl < nvalid) st16_wt<WT_EPI>(Y + (size_t)id * D + c0, (u32x4){(unsigned)w[0], (unsigned)w[1], (unsigned)w[2], (unsigned)w[3]});
                }
            }
    }
};

struct MoeSchedM {
    const PG8_LAS unsigned* P; const PG8_LAS unsigned* cntl; const PG8_LAS unsigned char* te;
    const int* list; unsigned* ready; unsigned* tmo; unsigned char* ws; int G, vcu;
    static constexpr int A_AUX = 16;
    __device__ __forceinline__ bool next(int i, GUnit& u) const {
        const unsigned L = (unsigned)i * (unsigned)G + (unsigned)vcu; const unsigned tot = (unsigned)__builtin_amdgcn_readfirstlane((int)P[NE]);
        unsigned mt;
        if (L < tot * 8u) { u.kind = 0; mt = L >> 3; u.pn = (int)(L & 7u); }
        else { const unsigned L2 = L - tot * 8u; if (L2 >= tot * 4u) return false; u.kind = 1; mt = L2 >> 2; u.pn = (int)(L2 & 3u); }
        const int e = __builtin_amdgcn_readfirstlane((int)te[mt]);
        u.pm = (int)mt; u.e = e; u.lt = (int)(mt - (unsigned)__builtin_amdgcn_readfirstlane((int)P[e])); return true;
    }
    __device__ __forceinline__ void aoffs_issue(const GUnit& u, int tid, unsigned (&raw)[2][2]) const {
        const int n = (int)cntl[u.e] - u.lt * BM;
#pragma unroll
        for (int i = 0; i < 2; ++i) { int R, C; stage_rc(tid * 16 + i * 8192, R, C);
#pragma unroll
            for (int h = 0; h < 2; ++h) { const int rr = h * HALF + R;
                if (u.kind == 0) { raw[h][i] = 0u; if (rr < n) raw[h][i] = (unsigned)list[(size_t)u.e * T + u.lt * BM + rr]; }
                else raw[h][i] = (unsigned)(u.pm * BM + rr); } }
    }
    __device__ __forceinline__ void aoffs_finish(const GUnit& u, int tid, const unsigned (&raw)[2][2], unsigned (&ao)[2][2]) const {
#pragma unroll
        for (int i = 0; i < 2; ++i) { int R, C; stage_rc(tid * 16 + i * 8192, R, C);
#pragma unroll
            for (int h = 0; h < 2; ++h) ao[h][i] = (u.kind == 0 ? (unsigned)WS_X1B + (raw[h][i] >> 2) * 1024u : (unsigned)WS_H + raw[h][i] * 1024u) + 2u * (unsigned)C; }
    }
    __device__ __forceinline__ const char* bbase(const GUnit& u) const {
        return (const char*)ws + (u.kind == 0 ? WS_BT1 + (size_t)u.e * 2048 * 1024 : WS_BT2 + (size_t)u.e * 1024 * 1024) + (size_t)u.pn * BM * 1024; }
    __device__ __forceinline__ void wait_ready(const GUnit& u, int lane) const {
        if (u.kind == 0) return;
        unsigned* p = ready + 64 * u.pm; unsigned sp = 0;
        while ((unsigned)__builtin_amdgcn_readfirstlane((int)__hip_atomic_load(p, __ATOMIC_RELAXED, __HIP_MEMORY_SCOPE_AGENT)) < 64u) {
            __builtin_amdgcn_s_sleep(2);
            if (++sp > (1u << 20)) { if (lane == 0) __hip_atomic_store(tmo, 0x6000u | (unsigned)u.pm, __ATOMIC_RELAXED, __HIP_MEMORY_SCOPE_AGENT); break; }
        }
    }
    __device__ __forceinline__ void publish(const GUnit& u, int lane) const {
        if (u.kind == 0 && lane == 0) __hip_atomic_fetch_add(ready + 64 * u.pm, 1u, __ATOMIC_RELAXED, __HIP_MEMORY_SCOPE_AGENT);
    }
};
struct EpiMoeM {
    static constexpr bool MID = false; static constexpr int SC_W = 0x7A7A7A7A, SC_A = 0x7F7F7F7F;
    EpiMoe1 e1; EpiMoe2 e2;
    __device__ __forceinline__ int sc_a(const GUnit& u) const { return u.kind ? EpiMoe2::SC_A : EpiMoe1::SC_A; }
    __device__ __forceinline__ void prefetch(PG8_LAS unsigned char* lds, const GUnit& u, int wid, int lane) const { if (u.kind) e2.prefetch(lds, u, wid, lane); else e1.prefetch(lds, u, wid, lane); }
    __device__ __forceinline__ void operator()(const f32x4 (&acc)[2][2][4][2], const GUnit& u, PG8_LAS unsigned char* lds, int wr, int wc, int fr, int fq) const {
        if (u.kind) e2(acc, u, lds, wr, wc, fr, fq); else e1(acc, u, lds, wr, wc, fr, fq);
    }
};
}
namespace attn_body {
using bf16 = __hip_bfloat16;
using bf16x8 = __attribute__((ext_vector_type(8))) short;
using s16x4 = __attribute__((ext_vector_type(4))) short;
using f32x16 = __attribute__((ext_vector_type(16))) float;
using u32x4 = __attribute__((ext_vector_type(4))) unsigned;
using u32x2 = __attribute__((ext_vector_type(2))) unsigned;
constexpr int SEQ = mk::S, D = 64, QP = 512, KP = 128, OP = 1024;
constexpr int NW = 8, QBLK = 32, QB = QBLK * NW, KVBLK = 64, NT = SEQ / KVBLK;
__device__ __forceinline__ int crow(int r, int hi) { return (r & 3) + 8 * (r >> 2) + 4 * hi; }
#define SBAR() __builtin_amdgcn_sched_barrier(0)
constexpr int NSLOT = 3, SLOTB = 8192;
constexpr int LDS_K = 0, LDS_V = NSLOT * SLOTB, LDS_WS = 2 * NSLOT * SLOTB, LDS_OST = LDS_WS + NW * 64 * 4, OST_WAVE_B = 4608, LDS_BYTES = LDS_OST + NW * OST_WAVE_B;
#ifndef CV_SCALE
#define CV_SCALE 0.03125f
#endif
constexpr int CV_PER_WAVE = 40, CV_STAGE_OFF = LDS_BYTES, LDS_TOTAL = CV_STAGE_OFF + NW * 4096;
struct Conv { const float* wg; const float* wu; const float* wd; unsigned char* bt1; unsigned char* bt2; int first, count; };
__device__ __forceinline__ void cv_decode(const Conv& cv, int r, const float*& src, unsigned char*& dst, int& isdown) {
    int e, q, ii;
    if (r < 32768) { e = r >> 10; q = (r >> 9) & 1; ii = r & 511; } else { const int rd = r - 32768; e = rd >> 9; q = 2; ii = rd & 511; }
    const int k0 = 64 * (ii & 15), m5 = ii >> 4, n0 = 32 * m5;
    src = (q == 0 ? cv.wg : (q == 1 ? cv.wu : cv.wd)) + (size_t)e * 1048576 + (size_t)k0 * 1024 + n0;
    if (q < 2) dst = cv.bt1 + ((size_t)(e * 2048 + 256 * (n0 >> 7) + 128 * q + 32 * ((n0 >> 5) & 3)) * 1024 + k0);
    else dst = cv.bt2 + ((size_t)(e * 1024 + 256 * (m5 >> 3) + 32 * ((m5 & 7) >> 1) + 8 * (m5 & 1)) * 1024 + k0);
    isdown = (q == 2) ? 1 : 0;
}
__device__ __forceinline__ void glds16s(const void* sbase, unsigned voff, unsigned lds_dst) { unsigned keep;
    asm volatile("s_mov_b32 %0, m0\n\ts_mov_b32 m0, %3\n\ts_nop 0\n\tglobal_load_lds_dwordx4 %1, %2 nt\n\ts_mov_b32 m0, %0" : "=&s"(keep) : "v"(voff), "s"(sbase), "s"(lds_dst) : "memory"); }
__device__ __forceinline__ void glds16(const void* gsrc, unsigned lds_dst) { unsigned keep;
    asm volatile("s_mov_b32 %0, m0\n\ts_mov_b32 m0, %2\n\ts_nop 0\n\tglobal_load_lds_dwordx4 %1, off\n\ts_mov_b32 m0, %0" : "=&s"(keep) : "v"(gsrc), "s"(lds_dst) : "memory"); }
__device__ __forceinline__ float max3f(float a, float b, float c) { float r; asm("v_max3_f32 %0, %1, %2, %3" : "=v"(r) : "v"(a), "v"(b), "v"(c)); return r; }
__device__ __forceinline__ float max2f(float a, float b) { float r; asm("v_max_f32_e32 %0, %1, %2" : "=v"(r) : "v"(a), "v"(b)); return r; }
__device__ __forceinline__ float fadd_s(float a, float b) { float r; asm("v_add_f32_e32 %0, %1, %2" : "=v"(r) : "v"(a), "v"(b)); return r; }
__device__ __forceinline__ float fsub_s(float a, float b) { float r; asm("v_sub_f32_e32 %0, %1, %2" : "=v"(r) : "v"(a), "v"(b)); return r; }
typedef float f32x2_t __attribute__((ext_vector_type(2))); typedef __bf16 bf16x2_t __attribute__((ext_vector_type(2)));
__device__ __forceinline__ unsigned cvtpk_s(float lo, float hi) { f32x2_t v = {lo, hi}; bf16x2_t b = __builtin_convertvector(v, bf16x2_t); return __builtin_bit_cast(unsigned, b); }
#define WAIT_BAR(N) asm volatile("s_waitcnt vmcnt(" #N ") lgkmcnt(0)\n\ts_barrier" ::: "memory")

__device__ __forceinline__ void qkt(f32x16& p0, f32x16& p1, const char* Kslot, const bf16x8* qr, const f32x16& negm, int r32, int hi) {
    const char* kb = Kslot + hi * 1024 + r32 * 16;
#pragma unroll
    for (int d0 = 0; d0 < 4; ++d0) {
        const bf16x8 b0 = *reinterpret_cast<const bf16x8*>(kb + d0 * 2048);
        const bf16x8 b1 = *reinterpret_cast<const bf16x8*>(kb + d0 * 2048 + 512);
        if (d0 == 0) { p0 = __builtin_amdgcn_mfma_f32_32x32x16_bf16(b0, qr[0], negm, 0, 0, 0); p1 = __builtin_amdgcn_mfma_f32_32x32x16_bf16(b1, qr[0], negm, 0, 0, 0); }
        else { p0 = __builtin_amdgcn_mfma_f32_32x32x16_bf16(b0, qr[d0], p0, 0, 0, 0); p1 = __builtin_amdgcn_mfma_f32_32x32x16_bf16(b1, qr[d0], p1, 0, 0, 0); } }
}
typedef __attribute__((address_space(3))) const char* lds_cptr;
typedef short v4i16_t __attribute__((ext_vector_type(4)));
__device__ __forceinline__ void kload8(bf16x8* kf, lds_cptr kp) {
    kf[0] = *(const __attribute__((address_space(3))) bf16x8*)(kp);        kf[1] = *(const __attribute__((address_space(3))) bf16x8*)(kp + 512);
    kf[2] = *(const __attribute__((address_space(3))) bf16x8*)(kp + 2048); kf[3] = *(const __attribute__((address_space(3))) bf16x8*)(kp + 2560);
    kf[4] = *(const __attribute__((address_space(3))) bf16x8*)(kp + 4096); kf[5] = *(const __attribute__((address_space(3))) bf16x8*)(kp + 4608);
    kf[6] = *(const __attribute__((address_space(3))) bf16x8*)(kp + 6144); kf[7] = *(const __attribute__((address_space(3))) bf16x8*)(kp + 6656);
}
__device__ __forceinline__ void kload2(bf16x8* kf, lds_cptr kp, int j) { kf[2 * j] = *(const __attribute__((address_space(3))) bf16x8*)(kp + j * 2048); kf[2 * j + 1] = *(const __attribute__((address_space(3))) bf16x8*)(kp + j * 2048 + 512); }
__device__ __forceinline__ s16x4 vtr(lds_cptr p) { return __builtin_bit_cast(s16x4, __builtin_amdgcn_ds_read_tr16_b64_v4i16((__attribute__((address_space(3))) v4i16_t*)p)); }
__device__ __forceinline__ float rowmax(const f32x16& p0, const f32x16& p1) {
    float a = max3f(p0[0], p0[1], p1[0]), b = max3f(p0[2], p0[3], p1[1]); a = max3f(a, p1[2], p1[3]);
#pragma unroll
    for (int r = 4; r < 16; r += 4) { a = max3f(a, p0[r], p0[r + 1]); b = max3f(b, p0[r + 2], p0[r + 3]); a = max3f(a, p1[r], p1[r + 1]); b = max3f(b, p1[r + 2], p1[r + 3]); }
    const float m = max2f(a, b);
    auto rr = __builtin_amdgcn_permlane32_swap(__float_as_uint(m), __float_as_uint(m), false, false);
    return max2f(__uint_as_float(rr[0]), __uint_as_float(rr[1]));
}
__device__ __forceinline__ void pv(f32x16* o, int vb, bf16x8 pa0, bf16x8 pa1, bf16x8 pa2, bf16x8 pa3) {
#pragma unroll
    for (int d0 = 0; d0 < 2; ++d0) { s16x4 lo[4], hi[4];
#pragma unroll
        for (int ks = 0; ks < 4; ++ks) {
            asm volatile("ds_read_b64_tr_b16 %0,%1 offset:%c2" : "=&v"(lo[ks]) : "v"(vb), "i"(d0 * 4096 + ks * 1024) : "memory");
            asm volatile("ds_read_b64_tr_b16 %0,%1 offset:%c2" : "=&v"(hi[ks]) : "v"(vb), "i"(d0 * 4096 + ks * 1024 + 512) : "memory"); }
        asm volatile("s_waitcnt lgkmcnt(0)" ::: "memory"); SBAR();
#define PK(k) (bf16x8){lo[k][0], lo[k][1], lo[k][2], lo[k][3], hi[k][0], hi[k][1], hi[k][2], hi[k][3]}
        o[d0] = __builtin_amdgcn_mfma_f32_32x32x16_bf16(pa0, PK(0), o[d0], 0, 0, 0);
        o[d0] = __builtin_amdgcn_mfma_f32_32x32x16_bf16(pa1, PK(1), o[d0], 0, 0, 0);
        o[d0] = __builtin_amdgcn_mfma_f32_32x32x16_bf16(pa2, PK(2), o[d0], 0, 0, 0);
        o[d0] = __builtin_amdgcn_mfma_f32_32x32x16_bf16(pa3, PK(3), o[d0], 0, 0, 0);
#undef PK
    }
}

template <int THRL, bool FIXREF> __device__ __forceinline__ void attn_unit(int b, int h, int qb, const bf16* Q, const bf16* __restrict__ K, const bf16* __restrict__ V, bf16* O, float* SSQ, char* shm, float mref, const Conv& cv) {
    int tid_ = threadIdx.x; asm volatile("" : "+v"(tid_));
    const int tid = tid_, lane = tid & 63, r32 = lane & 31, hi = lane >> 5; const int wid = __builtin_amdgcn_readfirstlane(tid >> 6);
    const long rowbase = (long)b * SEQ; const int q0 = qb * QB; const int kvh = h >> 2;
    const bf16* Qw = Q + (rowbase + q0 + wid * QBLK) * QP + h * D;
    const bf16 *Kh = K + rowbase * KP + kvh * D, *Vh = V + rowbase * KP + kvh * D;
    const unsigned lds0 = (unsigned)(uintptr_t)shm;
    float* wsf = (float*)(shm + LDS_WS) + wid * 64;
    const bf16* ksrc = Kh + (long)lane * KP + wid * 8;
    const bf16* vsrc = Vh + (long)(16 * (wid & 3) + (lane >> 2)) * KP + (wid >> 2) * 32 + (lane & 3) * 8;
    const unsigned kdst = lds0 + LDS_K + wid * 1024, vdst = lds0 + LDS_V + wid * 1024;
#define DMA_K(t, slot) glds16(ksrc + (long)(t) * KVBLK * KP, (unsigned)__builtin_amdgcn_readfirstlane(kdst + (slot)))
#define DMA_V(t, slot) glds16(vsrc + (long)(t) * KVBLK * KP, (unsigned)__builtin_amdgcn_readfirstlane(vdst + (slot)))
    const int vb0 = (int)(lds0 + LDS_V) + ((lane >> 4) & 1) * 32 + (lane & 3) * 8 + (4 * hi + ((lane & 15) >> 2)) * 64;
    const char* Kbase = shm + LDS_K; bf16x8 kf[8];
    const lds_cptr shm3 = (lds_cptr)shm; const lds_cptr kp0 = shm3 + LDS_K + hi * 1024 + r32 * 16; const lds_cptr vp0 = shm3 + LDS_V + ((lane >> 4) & 1) * 32 + (lane & 3) * 8 + (4 * hi + ((lane & 15) >> 2)) * 64;
    const int cvn = __builtin_amdgcn_readfirstlane(cv.count), cvf = __builtin_amdgcn_readfirstlane(cv.first);
    const unsigned cv_ldo = (unsigned)(((lane >> 3) * 1024 + 4 * (lane & 7)) * 4);
    const unsigned cv_stage = (unsigned)__builtin_amdgcn_readfirstlane((int)(lds0 + CV_STAGE_OFF + wid * 4096));
    const lds_cptr cv_rd = shm3 + CV_STAGE_OFF + wid * 4096 + hi * 1024 + r32 * 4;
    const lds_cptr cv_ow = shm3 + LDS_OST + wid * OST_WAVE_B + r32 * 144 + hi * 8, cv_or = shm3 + LDS_OST + wid * OST_WAVE_B + (lane >> 3) * 144 + (lane & 7) * 16;
    const unsigned cv_sto = (unsigned)((16 * ((lane >> 5) & 1) + ((lane >> 3) & 3)) * 1024 + (lane & 7) * 16);
    const float* cv_srcI = cv.wg; unsigned char* cv_dstI = cv.bt1; unsigned char* cv_dstP = cv.bt1; int cv_dnI = 0, cv_dnP = 0;
#define DMA_W(t) do { const int pj_ = ((t) - 1) >> 1, pp_ = ((t) - 1) & 1; \
      if (__builtin_expect((((t) - 1) & 7) == 0, 0)) { cv_dstP = cv_dstI; cv_dnP = cv_dnI; if (pj_ < cvn) cv_decode(cv, (cvf + pj_) >> 2, cv_srcI, cv_dstI, cv_dnI); } \
      glds16s(cv_srcI + (pj_ & 3) * 16384 + pp_ * 8192, cv_ldo, cv_stage + (pj_ & 1) * 2048 + pp_ * 1024); } while (0)
    DMA_K(0, 0); DMA_V(0, 0); DMA_K(1, SLOTB);
    bf16x8 qr[4];
#pragma unroll
    for (int d0 = 0; d0 < 4; ++d0) qr[d0] = __builtin_nontemporal_load(reinterpret_cast<const bf16x8*>(&Qw[(long)r32 * QP + d0 * 16 + hi * 8]));
    float mhat = 0.f, l_reg = 0.f; f32x16 o[2]; o[0] = f32x16{}; o[1] = f32x16{}; f32x16 negm = f32x16{}; asm volatile("" : "+v"(negm));
    bool resc = false;
#define START(P0, P1) do { const float rm = FIXREF ? mref : rowmax(P0, P1); resc = false; \
    { const float dl = rm; mhat = fadd_s(mhat, dl); \
      _Pragma("unroll") for (int r = 0; r < 16; ++r) { P0[r] = fsub_s(P0[r], dl); P1[r] = fsub_s(P1[r], dl); } \
      _Pragma("unroll") for (int r = 0; r < 16; ++r) negm[r] = -mhat; asm volatile("" : "+v"(negm)); } \
    _Pragma("unroll") for (int r = 0; r < 16; ++r) P0[r] = __builtin_amdgcn_exp2f(P0[r]); } while (0)
#define RESC() do { if (!FIXREF && resc) { asm volatile("s_waitcnt lgkmcnt(0)" ::: "memory"); \
      _Pragma("unroll") for (int d_ = 0; d_ < 2; ++d_) _Pragma("unroll") for (int r = 0; r < 16; ++r) o[d_][r] *= wsf[crow(r, hi)]; } } while (0)
    f32x16 pA0, pA1, pB0, pB1;
    int sl_prev = 0, sl_cur = 0, sl_next = SLOTB;
#define ROT() do { sl_prev = sl_cur; sl_cur = sl_next; sl_next = (sl_next == (NSLOT - 1) * SLOTB) ? 0 : sl_next + SLOTB; } while (0)
    DMA_K(2, 2 * SLOTB);
    WAIT_BAR(3);
    qkt(pA0, pA1, Kbase, qr, negm, r32, hi); asm volatile("s_nop 15\n\ts_nop 7" : "+v"(pA0), "+v"(pA1));
    START(pA0, pA1);
    _Pragma("unroll") for (int r = 0; r < 16; ++r) pA1[r] = __builtin_amdgcn_exp2f(pA1[r]);
    WAIT_BAR(0);
    DMA_K(3, 0); DMA_V(1, SLOTB);
    glds16s(cv.wg, cv_ldo, cv_stage + 3072);
    ROT();
    kload8(kf, kp0 + sl_cur);
    WAIT_BAR(3);
    s16x4 vlo[8], vhi[8]; u32x4 pw0, pw1, pw2, pw3;
#define PKW(P, B) cvtpk_s(P[B], P[B + 1])
#define PAF(k) __builtin_bit_cast(bf16x8, pw##k)
#define VFR(i) (bf16x8){vlo[i][0], vlo[i][1], vlo[i][2], vlo[i][3], vhi[i][0], vhi[i][1], vhi[i][2], vhi[i][3]}
#define PIN(x) asm volatile("" : "+v"(x))
#define MX3(a, b, c) __builtin_fmaxf(__builtin_fmaxf((a), (b)), (c))
#define GAPA(MF, A0, A1, A2, A3, W0, W1, PW) do { MF; sacc += A0; sacc += A1; sacc += A2; sacc += A3; PIN(sacc); W0; W1; PIN(PW); SBAR(); } while (0)
#define EX(v) __builtin_amdgcn_exp2f(v)
#define GAPB(MF, X, B) do { MF; X[B] = EX(X[B]); X[B + 1] = EX(X[B + 1]); X[B + 2] = EX(X[B + 2]); X[B + 3] = EX(X[B + 3]); PIN(X); SBAR(); } while (0)
#define VRD(i) do { vlo[i] = vtr(vp_ + (((i) >> 2) * 4096 + ((i) & 3) * 1024)); vhi[i] = vtr(vp_ + (((i) >> 2) * 4096 + ((i) & 3) * 1024 + 512)); } while (0)
#define KRD(G, j) do { if (G) { kload2(kf, kp0 + sl_next, j); SBAR(); } } while (0)
#define STEP(C0, C1, P0, P1, t, GK, GV, GL, CVK) do { SBAR(); \
    const lds_cptr vp_ = vp0 + sl_prev; \
    const int jc_ = ((t) - 5) >> 1; const bool cvon_ = CVK && (t) >= 5 && jc_ < cvn; float cvd_[8]; \
    if (cvon_) { const lds_cptr rp_ = cv_rd + (jc_ & 1) * 2048; _Pragma("unroll") for (int kk = 0; kk < 8; ++kk) cvd_[kk] = *(const __attribute__((address_space(3))) float*)(rp_ + kk * 128); } \
    SBAR(); \
    VRD(0); SBAR(); float sacc = (P0[0] + P0[1]); \
    GAPA(C0 = __builtin_amdgcn_mfma_f32_32x32x16_bf16(kf[0], qr[0], negm, 0, 0, 0), P0[2], P0[3], P0[4], P0[5],     pw0[0] = PKW(P0, 0), pw0[1] = PKW(P0, 2), pw0); \
    VRD(4); SBAR(); GAPA(C1 = __builtin_amdgcn_mfma_f32_32x32x16_bf16(kf[1], qr[0], negm, 0, 0, 0), P0[6], P0[7], P0[8], P0[9],     pw0[2] = PKW(P0, 4), pw0[3] = PKW(P0, 6), pw0); \
    VRD(1); SBAR(); GAPA(C0 = __builtin_amdgcn_mfma_f32_32x32x16_bf16(kf[2], qr[1], C0, 0, 0, 0),   P0[10], P0[11], P0[12], P0[13], pw1[0] = PKW(P0, 8), pw1[1] = PKW(P0, 10), pw1); \
    VRD(5); SBAR(); GAPA(C1 = __builtin_amdgcn_mfma_f32_32x32x16_bf16(kf[3], qr[1], C1, 0, 0, 0),   P0[14], P0[15], P1[0], P1[1],   pw1[2] = PKW(P0, 12), pw1[3] = PKW(P0, 14), pw1); \
    VRD(2); SBAR(); GAPA(C0 = __builtin_amdgcn_mfma_f32_32x32x16_bf16(kf[4], qr[2], C0, 0, 0, 0),   P1[2], P1[3], P1[4], P1[5],     pw2[0] = PKW(P1, 0), pw2[1] = PKW(P1, 2), pw2); \
    VRD(6); SBAR(); GAPA(C1 = __builtin_amdgcn_mfma_f32_32x32x16_bf16(kf[5], qr[2], C1, 0, 0, 0),   P1[6], P1[7], P1[8], P1[9],     pw2[2] = PKW(P1, 4), pw2[3] = PKW(P1, 6), pw2); \
    VRD(3); SBAR(); GAPA(C0 = __builtin_amdgcn_mfma_f32_32x32x16_bf16(kf[6], qr[3], C0, 0, 0, 0),   P1[10], P1[11], P1[12], P1[13], pw3[0] = PKW(P1, 8), pw3[1] = PKW(P1, 10), pw3); \
    VRD(7); SBAR(); GAPA(C1 = __builtin_amdgcn_mfma_f32_32x32x16_bf16(kf[7], qr[3], C1, 0, 0, 0),   P1[14], P1[15], 0.f, 0.f,       pw3[2] = PKW(P1, 12), pw3[3] = PKW(P1, 14), pw3); \
    l_reg += sacc; \
    cvst_ = false; \
    if (cvon_) { const bool pv_ = ((jc_ + 1) & 3) == 0; \
      typedef short v2s_ __attribute__((ext_vector_type(2))); v2s_ a_, b_; asm volatile("" : "=v"(a_), "=v"(b_)); \
      a_ = __builtin_amdgcn_cvt_scalef32_pk_fp8_f32(a_, cvd_[0], cvd_[1], CV_SCALE, false); a_ = __builtin_amdgcn_cvt_scalef32_pk_fp8_f32(a_, cvd_[2], cvd_[3], CV_SCALE, true); \
      b_ = __builtin_amdgcn_cvt_scalef32_pk_fp8_f32(b_, cvd_[4], cvd_[5], CV_SCALE, false); b_ = __builtin_amdgcn_cvt_scalef32_pk_fp8_f32(b_, cvd_[6], cvd_[7], CV_SCALE, true); \
      u32x2 w_; w_[0] = __builtin_bit_cast(unsigned, a_); w_[1] = __builtin_bit_cast(unsigned, b_); \
      *(__attribute__((address_space(3))) u32x2*)(cv_ow + (jc_ & 7) * 16) = w_; \
      if ((jc_ & 7) == 7) {     \
        unsigned char* d_ = (pv_ ? cv_dstP : cv_dstI) - 64; const int dn_ = pv_ ? cv_dnP : cv_dnI; \
        _Pragma("unroll") for (int i_ = 0; i_ < 4; ++i_) { const u32x4 q_ = *(const __attribute__((address_space(3))) u32x4*)(cv_or + i_ * (8 * 144)); \
          unsigned char* di_ = d_ + (dn_ ? ((i_ & 1) * 128 + (i_ >> 1) * 4) : 4 * i_) * 1024; \
          asm volatile("global_store_dwordx4 %0, %1, %2\n\ts_nop 1" :: "v"(cv_sto), "v"(q_), "s"(di_) : "memory"); } \
        cvst_ = true; } } \
    if (GK) { DMA_K((t) + 3, sl_cur); } if (GV) { DMA_V((t) + 1, sl_next); } DMA_W(t); \
    if constexpr (!FIXREF) { float a = MX3(C0[0], C0[1], C1[0]), b = MX3(C0[2], C0[3], C1[1]); a = MX3(a, C1[2], C1[3]); \
      _Pragma("unroll") for (int r = 4; r < 16; r += 4) { a = MX3(a, C0[r], C0[r + 1]); b = MX3(b, C0[r + 2], C0[r + 3]); a = MX3(a, C1[r], C1[r + 1]); b = MX3(b, C1[r + 2], C1[r + 3]); } \
      float rm = __builtin_fmaxf(a, b); { auto rr = __builtin_amdgcn_permlane32_swap(__float_as_uint(rm), __float_as_uint(rm), false, false); rm = __builtin_fmaxf(__uint_as_float(rr[0]), __uint_as_float(rr[1])); } \
      resc = false; \
      if (__builtin_expect(__any(rm > (float)THRL), 0)) { const float dl = __builtin_fmaxf(rm, 0.f); mhat += dl; \
        _Pragma("unroll") for (int r = 0; r < 16; ++r) { C0[r] -= dl; C1[r] -= dl; } \
        _Pragma("unroll") for (int r = 0; r < 16; ++r) negm[r] = -mhat; asm volatile("" : "+v"(negm)); \
        const float f = __builtin_amdgcn_exp2f(-dl); l_reg *= f; if (hi == 0) wsf[r32] = f; resc = true; } } \
    SBAR(); \
    GAPB(o[0] = __builtin_amdgcn_mfma_f32_32x32x16_bf16(PAF(0), VFR(0), o[0], 0, 0, 0), C0, 0); \
    GAPB(o[1] = __builtin_amdgcn_mfma_f32_32x32x16_bf16(PAF(0), VFR(4), o[1], 0, 0, 0), C0, 4); \
    KRD(GL, 0); GAPB(o[0] = __builtin_amdgcn_mfma_f32_32x32x16_bf16(PAF(1), VFR(1), o[0], 0, 0, 0), C0, 8); \
    KRD(GL, 1); GAPB(o[1] = __builtin_amdgcn_mfma_f32_32x32x16_bf16(PAF(1), VFR(5), o[1], 0, 0, 0), C0, 12); \
    KRD(GL, 2); GAPB(o[0] = __builtin_amdgcn_mfma_f32_32x32x16_bf16(PAF(2), VFR(2), o[0], 0, 0, 0), C1, 0); \
    KRD(GL, 3); GAPB(o[1] = __builtin_amdgcn_mfma_f32_32x32x16_bf16(PAF(2), VFR(6), o[1], 0, 0, 0), C1, 4); \
    GAPB(o[0] = __builtin_amdgcn_mfma_f32_32x32x16_bf16(PAF(3), VFR(3), o[0], 0, 0, 0), C1, 8); \
    GAPB(o[1] = __builtin_amdgcn_mfma_f32_32x32x16_bf16(PAF(3), VFR(7), o[1], 0, 0, 0), C1, 12); \
    } while (0)
    int t = 1; bool cvst_ = false;
    for (; t + 5 < NT; t += 2) {
        STEP(pB0, pB1, pA0, pA1, t, true, true, true, true);     if (cvst_) { WAIT_BAR(8); } else { WAIT_BAR(4); } RESC(); ROT();
        STEP(pA0, pA1, pB0, pB1, t + 1, true, true, true, false); WAIT_BAR(4); RESC(); ROT();
    }
#define ENDW(tt) do { if ((tt) + 3 < NT) { WAIT_BAR(4); } else if ((tt) + 2 < NT) { WAIT_BAR(3); } else { WAIT_BAR(2); } } while (0)
    for (; t + 1 < NT; t += 2) {
        STEP(pB0, pB1, pA0, pA1, t, (t + 3 < NT), (t + 1 < NT), (t + 1 < NT), false);         ENDW(t);     RESC(); ROT();
        STEP(pA0, pA1, pB0, pB1, t + 1, (t + 4 < NT), (t + 2 < NT), (t + 2 < NT), false);     ENDW(t + 1); RESC(); ROT();
    }
    STEP(pB0, pB1, pA0, pA1, NT - 1, false, false, false, false); RESC();
    asm volatile("s_waitcnt vmcnt(0)" ::: "memory");
    { float sacc = pB0[0] + pB0[1]; _Pragma("unroll") for (int r = 2; r < 16; ++r) sacc += pB0[r]; _Pragma("unroll") for (int r = 0; r < 16; ++r) sacc += pB1[r]; l_reg += sacc;
      pw0 = (u32x4){PKW(pB0, 0), PKW(pB0, 2), PKW(pB0, 4), PKW(pB0, 6)}; pw1 = (u32x4){PKW(pB0, 8), PKW(pB0, 10), PKW(pB0, 12), PKW(pB0, 14)}; pw2 = (u32x4){PKW(pB1, 0), PKW(pB1, 2), PKW(pB1, 4), PKW(pB1, 6)}; pw3 = (u32x4){PKW(pB1, 8), PKW(pB1, 10), PKW(pB1, 12), PKW(pB1, 14)};
      SBAR(); pv(o, vb0 + sl_cur, PAF(0), PAF(1), PAF(2), PAF(3)); }
#undef PKW
#undef PAF
#undef VFR
#undef PIN
#undef MX3
#undef GAPA
#undef GAPB
#undef EX
#undef VRD
#undef KRD
#undef STEP
#undef ENDW
    { auto rr = __builtin_amdgcn_permlane32_swap(__float_as_uint(l_reg), __float_as_uint(l_reg), false, false); l_reg = __uint_as_float(rr[0]) + __uint_as_float(rr[1]); }
    if (hi == 0) wsf[32 + r32] = l_reg; asm volatile("s_waitcnt lgkmcnt(0)" ::: "memory");
    float rli[16];
#pragma unroll
    for (int r = 0; r < 16; ++r) rli[r] = __builtin_amdgcn_rcpf(wsf[32 + crow(r, hi)]);
    const long orow0 = rowbase + q0 + wid * QBLK;
    bf16* Ow = O + orow0 * OP + h * D;
    { bf16* stg = (bf16*)(shm + LDS_OST + wid * OST_WAVE_B);
#pragma unroll
      for (int r = 0; r < 16; ++r) { const int orow = crow(r, hi);
#pragma unroll
          for (int d0 = 0; d0 < 2; ++d0) stg[orow * 64 + d0 * 32 + r32] = __float2bfloat16(o[d0][r] * rli[r]); }
      asm volatile("s_waitcnt lgkmcnt(0)" ::: "memory");
#pragma unroll
      for (int i = 0; i < 4; ++i) { const int row = i * 8 + (lane >> 3), ch = lane & 7; const u32x4 v = *(const u32x4*)(stg + row * 64 + ch * 8); mk::st16_wt<WT_EPI>(Ow + (long)row * OP + ch * 8, v);
          float ss = 0.f;
#pragma unroll
          for (int k = 0; k < 4; ++k) { const float lo = __uint_as_float(v[k] << 16), hi2 = __uint_as_float(v[k] & 0xffff0000u); ss += lo * lo + hi2 * hi2; }
          ss += __shfl_xor(ss, 1); ss += __shfl_xor(ss, 2); ss += __shfl_xor(ss, 4);
          if (ch == 0) SSQ[(orow0 + row) * 8 + h] = ss; } }
    asm volatile("s_waitcnt lgkmcnt(0)\n\ts_barrier" ::: "memory");
#undef DMA_K
#undef DMA_V
#undef DMA_W
#undef START
#undef RESC
#undef ROT
}
#undef SBAR
#undef WAIT_BAR
}
namespace lru {
using namespace mk;
#define LLAS __attribute__((address_space(3)))
typedef short bf16x8 __attribute__((ext_vector_type(8)));
typedef float f32x16 __attribute__((ext_vector_type(16)));
typedef float f32x4 __attribute__((ext_vector_type(4)));
typedef float f32x2 __attribute__((ext_vector_type(2)));
typedef unsigned u32x4 __attribute__((ext_vector_type(4)));
constexpr int XPITCH = 144, HPITCH = 272;
constexpr int WAVE_BYTES = 64 * HPITCH;
constexpr int CW_OFF = 9728;
constexpr int PART_OFF = 8 * WAVE_BYTES;
constexpr int LDS_NEED = PART_OFF + 2048;
constexpr float LOG2E = 1.4426950408889634f, LN2 = 0.6931471805599453f;

struct Params { const bf16_t* LX; const bf16_t* LG; const float *cw, *cb, *ba, *bi, *lam, *gain; const bf16_t* WL; f32x2* SUMS; bf16_t* MIX; unsigned* AB; };

using mk::st16_wt;
__device__ __forceinline__ unsigned cvtpk(float lo, float hi) { unsigned r; asm volatile("v_cvt_pk_bf16_f32 %0, %1, %2" : "=v"(r) : "v"(lo), "v"(hi)); return r; }

__device__ __forceinline__ void build_xc(const Params& P, LLAS unsigned char* wl, int b, int c, int n, int lane, bf16x8 (&xcA)[2][4]) {
    const bf16_t* LXb = P.LX + (size_t)b * S * LW + 64 * n;
#pragma unroll
    for (int it = 0; it < 9; ++it) {
        const int rr = (lane >> 3) + 8 * it;
        if (rr < 67) { const int s = 64 * c - 2 + rr; u32x4 v = (u32x4){0u, 0u, 0u, 0u};
            if (s >= 0 && s < S) v = __builtin_nontemporal_load((const u32x4*)(LXb + (size_t)s * LW + 8 * (lane & 7)));
            *(LLAS u32x4*)(wl + rr * XPITCH + 16 * (lane & 7)) = v; }
    }
    LLAS float* cwl = (LLAS float*)(wl + CW_OFF);
#pragma unroll
    for (int j = 0; j < 4; ++j) cwl[j * 64 + lane] = P.cw[j * LW + 64 * n + lane];
    cwl[4 * 64 + lane] = P.cb[64 * n + lane];
    const int i = lane & 31, hi = lane >> 5;
#pragma unroll
    for (int ks = 0; ks < 4; ++ks) {
        const int cb0 = 16 * ks + 8 * hi;
        f32x4 w[5][2];
#pragma unroll
        for (int j = 0; j < 5; ++j) { w[j][0] = *(const LLAS f32x4*)(cwl + j * 64 + cb0); w[j][1] = *(const LLAS f32x4*)(cwl + j * 64 + cb0 + 4); }
#pragma unroll
        for (int mt = 0; mt < 2; ++mt) {
            f32x4 a0 = w[4][0], a1 = w[4][1];
#pragma unroll
            for (int j = 0; j < 4; ++j) {
                const u32x4 xv = *(const LLAS u32x4*)(wl + (32 * mt + i + j) * XPITCH + cb0 * 2);
                f32x4 x0, x1;
                x0[0] = __uint_as_float(xv[0] << 16); x0[1] = __uint_as_float(xv[0] & 0xffff0000u); x0[2] = __uint_as_float(xv[1] << 16); x0[3] = __uint_as_float(xv[1] & 0xffff0000u);
                x1[0] = __uint_as_float(xv[2] << 16); x1[1] = __uint_as_float(xv[2] & 0xffff0000u); x1[2] = __uint_as_float(xv[3] << 16); x1[3] = __uint_as_float(xv[3] & 0xffff0000u);
                a0 += x0 * w[j][0]; a1 += x1 * w[j][1];
            }
            u32x4 pk; pk[0] = cvtpk(a0[0], a0[1]); pk[1] = cvtpk(a0[2], a0[3]); pk[2] = cvtpk(a1[0], a1[1]); pk[3] = cvtpk(a1[2], a1[3]);
            xcA[mt][ks] = __builtin_bit_cast(bf16x8, pk);
        }
    }
}
__device__ __forceinline__ bf16x8 ident_frag(int ks, int nh, int r32, int hi) {
    const int jj = 32 * nh + r32 - 16 * ks - 8 * hi; bf16x8 f;
#pragma unroll
    for (int j = 0; j < 8; ++j) f[j] = (j == jj) ? (short)0x3F80 : (short)0;
    return f;
}
__device__ __forceinline__ void gate_ab(f32x16& ra, f32x16& ri, const f32x16& xc, float ba, float bi, float c1) {
    const f32x2 nba = (f32x2){-ba * LOG2E, -ba * LOG2E}, nbi = (f32x2){-bi * LOG2E, -bi * LOG2E}, nl = (f32x2){-LOG2E, -LOG2E}, one = (f32x2){1.0f, 1.0f}, c2 = (f32x2){c1, c1};
#pragma unroll
    for (int r = 0; r < 16; r += 2) {
        const f32x2 ea = (f32x2){ra[r], ra[r + 1]} * nl + nba, ei = (f32x2){ri[r], ri[r + 1]} * nl + nbi;
        const f32x2 da = (f32x2){__builtin_amdgcn_exp2f(ea[0]), __builtin_amdgcn_exp2f(ea[1])} + one, di = (f32x2){__builtin_amdgcn_exp2f(ei[0]), __builtin_amdgcn_exp2f(ei[1])} + one;
        const f32x2 rg = (f32x2){__builtin_amdgcn_rcpf(da[0]), __builtin_amdgcn_rcpf(da[1])}, ig = (f32x2){__builtin_amdgcn_rcpf(di[0]), __builtin_amdgcn_rcpf(di[1])};
        const f32x2 la = c2 * rg;
        const f32x2 a = (f32x2){__builtin_amdgcn_exp2f(la[0]), __builtin_amdgcn_exp2f(la[1])};
        const f32x2 em = one - a * a;
        const f32x2 bb = (f32x2){__builtin_amdgcn_sqrtf(em[0]), __builtin_amdgcn_sqrtf(em[1])} * ig * (f32x2){xc[r], xc[r + 1]};
        ra[r] = a[0]; ra[r + 1] = a[1]; ri[r] = bb[0]; ri[r + 1] = bb[1];
    }
}
__device__ __forceinline__ float xhalf(float x, int hi) {
    const auto r = __builtin_amdgcn_permlane32_swap(__float_as_uint(x), __float_as_uint(x), false, false);
    return __uint_as_float(hi ? r[0] : r[1]);
}
template <bool ACC> __device__ __forceinline__ void scan_fwd(const f32x16& a, const f32x16& b, float& h, float& p, f32x16& hs, f32x16& pc, int hi) {
    float Ag[4], Bg[4], pA[4], pB[4];
#pragma unroll
    for (int g = 0; g < 4; ++g) { float A = a[4 * g], B = b[4 * g];
#pragma unroll
        for (int e = 1; e < 4; ++e) { B = fmaf(a[4 * g + e], B, b[4 * g + e]); A *= a[4 * g + e]; }
        Ag[g] = A; Bg[g] = B; pA[g] = xhalf(A, hi); pB[g] = xhalf(B, hi); }
#pragma unroll
    for (int g = 0; g < 4; ++g) {
        const float A1 = hi ? pA[g] : Ag[g], B1 = hi ? pB[g] : Bg[g], A2 = hi ? Ag[g] : pA[g], B2 = hi ? Bg[g] : pB[g];
        const float h1 = fmaf(A1, h, B1), p1 = p * A1; float x = hi ? h1 : h, px = hi ? p1 : p; h = fmaf(A2, h1, B2); p = p1 * A2;
#pragma unroll
        for (int e = 0; e < 4; ++e) { x = fmaf(a[4 * g + e], x, b[4 * g + e]); px *= a[4 * g + e]; hs[4 * g + e] = ACC ? hs[4 * g + e] + x : x; pc[4 * g + e] = px; }
    }
}
template <bool ACC> __device__ __forceinline__ void scan_bwd(const f32x16& a, const f32x16& b, float& h, float& p, f32x16& hs, f32x16& pc, int hi) {
    float Ag[4], Bg[4], pA[4], pB[4];
#pragma unroll
    for (int g = 0; g < 4; ++g) { float A = a[4 * g + 3], B = b[4 * g + 3];
#pragma unroll
        for (int e = 2; e >= 0; --e) { B = fmaf(a[4 * g + e], B, b[4 * g + e]); A *= a[4 * g + e]; }
        Ag[g] = A; Bg[g] = B; pA[g] = xhalf(A, hi); pB[g] = xhalf(B, hi); }
#pragma unroll
    for (int g = 3; g >= 0; --g) {
        const float A1 = hi ? Ag[g] : pA[g], B1 = hi ? Bg[g] : pB[g], A2 = hi ? pA[g] : Ag[g], B2 = hi ? pB[g] : Bg[g];
        const float h1 = fmaf(A1, h, B1), p1 = p * A1; float x = hi ? h : h1, px = hi ? p : p1; h = fmaf(A2, h1, B2); p = p1 * A2;
#pragma unroll
        for (int e = 3; e >= 0; --e) { x = fmaf(a[4 * g + e], x, b[4 * g + e]); px *= a[4 * g + e]; hs[4 * g + e] = ACC ? hs[4 * g + e] + x : x; pc[4 * g + e] = px; }
    }
}
__device__ __forceinline__ void tile_ab(const bf16x8 (&xcA)[4], const bf16x8 (&Bf)[2][4], int nh, int r32, int hi, float ba, float bi, float c1, f32x16& a, f32x16& b) {
    f32x16 ra = f32x16{}, ri = f32x16{}, xc = f32x16{};
#pragma unroll
    for (int ks = 0; ks < 4; ++ks) { ra = __builtin_amdgcn_mfma_f32_32x32x16_bf16(xcA[ks], Bf[0][ks], ra, 0, 0, 0); ri = __builtin_amdgcn_mfma_f32_32x32x16_bf16(xcA[ks], Bf[1][ks], ri, 0, 0, 0); }
    if (nh == 0) { xc = __builtin_amdgcn_mfma_f32_32x32x16_bf16(xcA[0], ident_frag(0, 0, r32, hi), xc, 0, 0, 0); xc = __builtin_amdgcn_mfma_f32_32x32x16_bf16(xcA[1], ident_frag(1, 0, r32, hi), xc, 0, 0, 0); }
    else         { xc = __builtin_amdgcn_mfma_f32_32x32x16_bf16(xcA[2], ident_frag(2, 1, r32, hi), xc, 0, 0, 0); xc = __builtin_amdgcn_mfma_f32_32x32x16_bf16(xcA[3], ident_frag(3, 1, r32, hi), xc, 0, 0, 0); }
    gate_ab(ra, ri, xc, ba, bi, c1);
    a = ra; b = ri;
}
__device__ __forceinline__ void load_bf(const Params& P, int n, int dir, int nh, int lane, bf16x8 (&Bf)[2][4]) {
#pragma unroll
    for (int q = 0; q < 2; ++q)
#pragma unroll
        for (int ks = 0; ks < 4; ++ks) Bf[q][ks] = *(const bf16x8*)(P.WL + ((((size_t)(n * 4 + dir * 2 + q) * 2 + nh) * 4 + ks) * 64 + lane) * 8);
}
__device__ __forceinline__ float softplus_neg(float lam) { const float L = -lam; return (L > 20.f) ? L : log1pf(expf(L)); }

__device__ __forceinline__ u32x4 pack8(const f32x16& v, int half) {
    u32x4 o;
#pragma unroll
    for (int k = 0; k < 4; ++k) o[k] = cvtpk(v[8 * half + 2 * k], v[8 * half + 2 * k + 1]);
    return o;
}
__device__ __forceinline__ void lru_summaries(const Params& P, LLAS unsigned char* lds, int b, int c) {
    int tid_ = threadIdx.x; asm volatile("" : "+v"(tid_));
    const int tid = tid_, lane = tid & 63, r32 = lane & 31, hi = lane >> 5; const int n = __builtin_amdgcn_readfirstlane(tid >> 6);
    LLAS unsigned char* wl = lds + n * WAVE_BYTES;
    bf16x8 xcA[2][4];
    build_xc(P, wl, b, c, n, lane, xcA);
    bf16x8 Bf[2][4]; load_bf(P, n, 0, 0, lane, Bf);
#pragma unroll 1
    for (int nh = 0; nh < 2; ++nh) {
        const int ch = 64 * n + 32 * nh + r32;
        u32x4* abp = (u32x4*)P.AB + ((((size_t)(b * NCH + c) * 8 + n) * 2 + nh) * 12) * 64 + lane;
        f32x16 hs0, hs1;
        {
            const float ba = P.ba[ch], bi = P.bi[ch], c1 = -8.0f * LOG2E * softplus_neg(P.lam[ch]);
            float h = 0.f, p = 1.f;
            { f32x16 a, bb, pc; tile_ab(xcA[0], Bf, nh, r32, hi, ba, bi, c1, a, bb); scan_fwd<false>(a, bb, h, p, hs0, pc, hi); st16_wt(abp + 4 * 64, pack8(pc, 0)); st16_wt(abp + 5 * 64, pack8(pc, 1)); }
            { f32x16 a, bb, pc; tile_ab(xcA[1], Bf, nh, r32, hi, ba, bi, c1, a, bb); load_bf(P, n, 1, nh, lane, Bf);
              scan_fwd<false>(a, bb, h, p, hs1, pc, hi); st16_wt(abp + 6 * 64, pack8(pc, 0)); st16_wt(abp + 7 * 64, pack8(pc, 1)); }
            if (hi == 0) ((unsigned*)P.SUMS)[((size_t)(b * 2 + 0) * NCH + c) * LW + ch] = cvtpk(p, h);
        }
        {
            const float ba = P.ba[LW + ch], bi = P.bi[LW + ch], c1 = -8.0f * LOG2E * softplus_neg(P.lam[LW + ch]);
            float h = 0.f, p = 1.f;
            { f32x16 a, bb, pc; tile_ab(xcA[1], Bf, nh, r32, hi, ba, bi, c1, a, bb); scan_bwd<true>(a, bb, h, p, hs1, pc, hi); st16_wt(abp + 10 * 64, pack8(pc, 0)); st16_wt(abp + 11 * 64, pack8(pc, 1));
              st16_wt(abp + 2 * 64, pack8(hs1, 0)); st16_wt(abp + 3 * 64, pack8(hs1, 1)); }
            { f32x16 a, bb, pc; tile_ab(xcA[0], Bf, nh, r32, hi, ba, bi, c1, a, bb); if (nh == 0) load_bf(P, n, 0, 1, lane, Bf);
              scan_bwd<true>(a, bb, h, p, hs0, pc, hi); st16_wt(abp + 8 * 64, pack8(pc, 0)); st16_wt(abp + 9 * 64, pack8(pc, 1));
              st16_wt(abp + 0 * 64, pack8(hs0, 0)); st16_wt(abp + 1 * 64, pack8(hs0, 1)); }
            if (hi == 0) ((unsigned*)P.SUMS)[((size_t)(b * 2 + 1) * NCH + c) * LW + ch] = cvtpk(p, h);
        }
    }
}
constexpr int CARRY_OFF = 142336;
__device__ __forceinline__ void carries_to_lds(const f32x2* SUMS, LLAS unsigned char* lds, int b, int c, int tid) {
    const f32x2* sf = SUMS + (size_t)(b * 2 + 0) * NCH * LW + tid; const f32x2* sb = SUMS + (size_t)(b * 2 + 1) * NCH * LW + tid;
    float hf = 0.f, hb = 0.f;
    for (int c0 = 0; c0 < c; c0 += 16) { f32x2 v[16];
#pragma unroll
        for (int u = 0; u < 16; ++u) { const int cc = c0 + u; v[u] = sf[(size_t)(cc < c ? cc : c - 1) * LW]; if (cc >= c) v[u] = (f32x2){1.0f, 0.0f}; }
#pragma unroll
        for (int u = 0; u < 16; ++u) hf = fmaf(v[u][0], hf, v[u][1]); }
    for (int c0 = NCH - 1; c0 > c; c0 -= 16) { f32x2 v[16];
#pragma unroll
        for (int u = 0; u < 16; ++u) { const int cc = c0 - u; v[u] = sb[(size_t)(cc > c ? cc : c + 1) * LW]; if (cc <= c) v[u] = (f32x2){1.0f, 0.0f}; }
#pragma unroll
        for (int u = 0; u < 16; ++u) hb = fmaf(v[u][0], hb, v[u][1]); }
    LLAS float* cr = (LLAS float*)(lds + CARRY_OFF);
    cr[tid] = hf; cr[LW + tid] = hb;
}
__device__ __forceinline__ float gelu_tanh(float x) {
    const float u = 0.7978845608028654f * (x + 0.044715f * x * x * x);
    return x * __builtin_amdgcn_rcpf(1.0f + __builtin_amdgcn_exp2f(-2.0f * LOG2E * u));
}
__device__ __forceinline__ void lru_apply(const Params& P, LLAS unsigned char* lds, int b, int c) {
    int tid_ = threadIdx.x; asm volatile("" : "+v"(tid_));
    const int tid = tid_, lane = tid & 63, r32 = lane & 31, hi = lane >> 5; const int n = __builtin_amdgcn_readfirstlane(tid >> 6);
    LLAS unsigned char* wl = lds + n * WAVE_BYTES;
    u32x4 q[2][12];
    const u32x4* abp = (const u32x4*)P.AB + (((size_t)(b * NCH + c) * 8 + n) * 24) * 64 + lane;
    {
        const unsigned* SF = (const unsigned*)P.SUMS + (size_t)(b * 2 + 0) * NCH * LW + 4 * lane; const unsigned* SB = (const unsigned*)P.SUMS + (size_t)(b * 2 + 1) * NCH * LW + 4 * lane;
        const int lo = 16 * n, fe = (c < lo + 16) ? c : lo + 16, nF = (fe > lo) ? (fe - lo + 3) >> 2 : 0;
        const int bt = lo + 15, be = (c > lo - 1) ? c : lo - 1, nB = (bt > be) ? (bt - be + 3) >> 2 : 0;
        f32x2 cfw[8], cbw[8];
#pragma unroll
        for (int k = 0; k < 8; ++k) { cfw[k] = (f32x2){1.0f, 0.0f}; cbw[k] = (f32x2){1.0f, 0.0f}; }
#pragma unroll
        for (int i = 0; i < 5; ++i) {
            f32x2 v[4][8];
            const bool act = i < nF + nB, fwd = i < nF;
            if (act) {
#pragma unroll
                for (int u = 0; u < 4; ++u) { const int cc = fwd ? lo + 4 * i + u : bt - 4 * (i - nF) - u; const bool ok = fwd ? cc < fe : cc > be;
                    const unsigned* src = (fwd ? SF : SB) + (size_t)(ok ? cc : lo) * LW;
#pragma unroll
                    for (int k = 0; k < 2; ++k) { const u32x4 t4 = *(const u32x4*)(src + 256 * k);
#pragma unroll
                        for (int e = 0; e < 4; ++e) v[u][4 * k + e] = ok ? (f32x2){__uint_as_float(t4[e] << 16), __uint_as_float(t4[e] & 0xffff0000u)} : (f32x2){1.0f, 0.0f}; } }
            }
#pragma unroll
            for (int j = 5 * i; j < 5 * i + 5 && j < 24; ++j) q[j / 12][j % 12] = __builtin_nontemporal_load(abp + j * 64);
            if (act) {
                if (fwd) {
#pragma unroll
                    for (int u = 0; u < 4; ++u)
#pragma unroll
                        for (int k = 0; k < 8; ++k) cfw[k] = (f32x2){v[u][k][0] * cfw[k][0], fmaf(v[u][k][0], cfw[k][1], v[u][k][1])};
                } else {
#pragma unroll
                    for (int u = 0; u < 4; ++u)
#pragma unroll
                        for (int k = 0; k < 8; ++k) cbw[k] = (f32x2){v[u][k][0] * cbw[k][0], fmaf(v[u][k][0], cbw[k][1], v[u][k][1])};
                }
            }
        }
        LLAS f32x2* cmpF = (LLAS f32x2*)lds; LLAS f32x2* cmpB = (LLAS f32x2*)(lds + 32768);
#pragma unroll
        for (int k = 0; k < 8; ++k) { const int chn = 4 * lane + (k & 3) + 256 * (k >> 2); cmpF[n * LW + chn] = cfw[k]; cmpB[n * LW + chn] = cbw[k]; }
        __syncthreads();
        float hf = 0.f, hb = 0.f;
#pragma unroll
        for (int w = 0; w < 8; ++w) { const f32x2 a = cmpF[w * LW + tid]; hf = fmaf(a[0], hf, a[1]); }
#pragma unroll
        for (int w = 7; w >= 0; --w) { const f32x2 a = cmpB[w * LW + tid]; hb = fmaf(a[0], hb, a[1]); }
        LLAS float* cr = (LLAS float*)(lds + CARRY_OFF);
        cr[tid] = hf; cr[LW + tid] = hb;
    }
    __syncthreads();
#pragma unroll
    for (int nh = 0; nh < 2; ++nh) {
        const int ch = 64 * n + 32 * nh + r32;
        const float cf = *(const LLAS float*)(lds + CARRY_OFF + ch * 4), cb = *(const LLAS float*)(lds + CARRY_OFF + (LW + ch) * 4);
#pragma unroll
        for (int th = 0; th < 4; ++th) {
            LLAS unsigned char* hc = wl + (32 * nh + r32) * 4 + (th >> 1) * 32 * HPITCH;
#pragma unroll
            for (int k = 0; k < 4; ++k) {
                const unsigned hv = q[nh][th][k], fv = q[nh][4 + th][k], bv = q[nh][8 + th][k];
                const int r = 8 * (th & 1) + 2 * k;
                const float x0 = fmaf(__uint_as_float(bv << 16), cb, fmaf(__uint_as_float(fv << 16), cf, __uint_as_float(hv << 16)));
                const float x1 = fmaf(__uint_as_float(bv & 0xffff0000u), cb, fmaf(__uint_as_float(fv & 0xffff0000u), cf, __uint_as_float(hv & 0xffff0000u)));
                *(LLAS float*)(hc + (8 * (r >> 2) + 4 * hi + (r & 3)) * HPITCH) = x0;
                *(LLAS float*)(hc + (8 * ((r + 1) >> 2) + 4 * hi + ((r + 1) & 3)) * HPITCH) = x1;
            }
        }
    }
    const int ch8 = 8 * (lane & 7);
    const size_t t0 = (size_t)b * S + (size_t)c * 64;
    float v[8][8];
    LLAS float* part = (LLAS float*)(lds + PART_OFF);
#pragma unroll
    for (int it = 0; it < 8; ++it) {
        const int row = (lane >> 3) + 8 * it;
        const f32x4 h0 = *(const LLAS f32x4*)(wl + row * HPITCH + ch8 * 4), h1 = *(const LLAS f32x4*)(wl + row * HPITCH + ch8 * 4 + 16);
        const u32x4 gv = __builtin_nontemporal_load((const u32x4*)(P.LG + (t0 + row) * LW + 64 * n + ch8));
        float ss = 0.f;
#pragma unroll
        for (int q = 0; q < 4; ++q) {
            const float g0 = __uint_as_float(gv[q] << 16), g1 = __uint_as_float(gv[q] & 0xffff0000u);
            const float hA = (q < 2) ? h0[2 * q] : h1[2 * q - 4], hB = (q < 2) ? h0[2 * q + 1] : h1[2 * q - 3];
            v[it][2 * q] = hA * gelu_tanh(g0); v[it][2 * q + 1] = hB * gelu_tanh(g1);
            ss += v[it][2 * q] * v[it][2 * q] + v[it][2 * q + 1] * v[it][2 * q + 1];
        }
        ss += __shfl_xor(ss, 1); ss += __shfl_xor(ss, 2); ss += __shfl_xor(ss, 4);
        if ((lane & 7) == 0) part[n * 64 + row] = ss;
    }
    __syncthreads();
    f32x4 g0 = *(const f32x4*)(P.gain + 64 * n + ch8), g1 = *(const f32x4*)(P.gain + 64 * n + ch8 + 4);
#pragma unroll
    for (int it = 0; it < 8; ++it) {
        const int row = (lane >> 3) + 8 * it;
        float tot = 0.f;
#pragma unroll
        for (int w = 0; w < 8; ++w) tot += part[w * 64 + row];
        const float rs = 1.0f / sqrtf(tot * (1.0f / 512.0f) + 1e-5f);
        u32x4 o; o[0] = cvtpk(v[it][0] * rs * g0[0], v[it][1] * rs * g0[1]); o[1] = cvtpk(v[it][2] * rs * g0[2], v[it][3] * rs * g0[3]);
        o[2] = cvtpk(v[it][4] * rs * g1[0], v[it][5] * rs * g1[1]); o[3] = cvtpk(v[it][6] * rs * g1[2], v[it][7] * rs * g1[3]);
        st16_wt<WT_EPI>(P.MIX + (t0 + row) * 1024 + 512 + 64 * n + ch8, o);
    }
    __syncthreads();
}
#undef LLAS
}
namespace mkf {
using namespace mk;
#define GAS __attribute__((address_space(1)))
#define LAS __attribute__((address_space(3)))
typedef unsigned v4u __attribute__((ext_vector_type(4)));
typedef float f32x4 __attribute__((ext_vector_type(4)));
typedef float f32x16 __attribute__((ext_vector_type(16)));
typedef short bf16x8 __attribute__((ext_vector_type(8)));
typedef GAS unsigned gu32;
#define RLX_AGENT __ATOMIC_RELAXED, __HIP_MEMORY_SCOPE_AGENT
#define LDS_WAIT() asm volatile("s_waitcnt lgkmcnt(0)" ::: "memory")
constexpr int NWAVES = 8;
constexpr int RING_OFF = 0, RING_BYTES = 131072;
constexpr int LDSCTL_OFF = 141312, MISC_OFF = LDSCTL_OFF;
constexpr int LDS_BYTES = 147456;
static_assert(lru::LDS_NEED <= LDSCTL_OFF && attn_body::LDS_TOTAL <= RING_BYTES && pg8::STAGE_BYTES + 8192 <= LDSCTL_OFF && MISC_OFF + 512 <= lru::CARRY_OFF && lru::CARRY_OFF + 4096 <= LDS_BYTES, "LDS map");

#define XB_TMO      128
#define XB_XCNT(j)  (256  + 64 * (j))
#define XB_XSUB(j)  (1280 + 64 * (j))
#define XB_XGEN(j)  (2304 + 64 * (j))
#define XB_TOP      3328
#define XB_TOPGEN   3392
#define XCD_BAR_WORDS 3456
#define XB_SPIN_CAP (1u << 18)
__device__ __forceinline__ unsigned xb_ld(unsigned* p)              { return __hip_atomic_load(p, __ATOMIC_RELAXED, __HIP_MEMORY_SCOPE_AGENT); }
__device__ __forceinline__ unsigned xb_add(unsigned* p, unsigned v) { return __hip_atomic_fetch_add(p, v, __ATOMIC_RELAXED, __HIP_MEMORY_SCOPE_AGENT); }
__device__ __forceinline__ unsigned xb_xcc_id() { return (unsigned)__builtin_amdgcn_s_getreg((3 << 11) | 20) & 0xFu; }
#define XB_SPIN(cond, bar) do { unsigned _sp = 0; while (cond) { __builtin_amdgcn_s_sleep(1); \
    if ((++_sp & 255u) == 0u) { if (xb_ld(&(bar)[XB_TMO])) break; if (_sp > XB_SPIN_CAP) { atomicAdd(&(bar)[XB_TMO], 1u); break; } } } } while (0)
struct XcdBarrier { unsigned* bar; unsigned x; volatile LAS unsigned* st; };
__device__ __forceinline__ XcdBarrier xcd_barrier_post(unsigned* bar, volatile LAS unsigned* st) {
    XcdBarrier b; b.bar = bar; b.x = xb_xcc_id(); b.st = st;
    if (threadIdx.x == 0) (void)xb_add(&bar[XB_XCNT(b.x)], 1u);
    return b;
}
__device__ __forceinline__ void xcd_barrier_complete(unsigned* bar, unsigned x, unsigned& nloc, unsigned& nx) {
    const unsigned G = gridDim.x * gridDim.y * gridDim.z;
    unsigned sum, cnt, mine, sp = 0u;
    for (;;) {
        sum = 0u; cnt = 0u; mine = 0u;
#pragma unroll
        for (unsigned j = 0; j < 16; ++j) { const unsigned c = xb_ld(&bar[XB_XCNT(j)]); sum += c; cnt += (c > 0u) ? 1u : 0u; mine = (j == x) ? c : mine; }
        if (sum == G) break;
        __builtin_amdgcn_s_sleep(1);
        if ((++sp & 255u) == 0u) { if (xb_ld(&bar[XB_TMO])) break; if (sp > XB_SPIN_CAP) { atomicAdd(&bar[XB_TMO], 1u); break; } }
    }
    nloc = mine > 0u ? mine : 1u; nx = cnt > 0u ? cnt : 1u;
}
__device__ __forceinline__ void xcd_barrier(const XcdBarrier& b) {
    asm volatile("s_waitcnt vmcnt(0)" ::: "memory");
    __syncthreads();
    if (threadIdx.x == 0) {
        unsigned* bar = b.bar;
        __builtin_amdgcn_s_waitcnt(0);
        unsigned nloc = b.st[0], nx = b.st[1];
        if (nloc == 0u) { xcd_barrier_complete(bar, b.x, nloc, nx); b.st[0] = nloc; b.st[1] = nx; }
        const unsigned old = xb_add(&bar[XB_XSUB(b.x)], 1u);
        const unsigned gen = old / nloc;
        if (old + 1u == (gen + 1u) * nloc) {
            __builtin_amdgcn_fence(__ATOMIC_RELEASE, "agent");
            asm volatile("s_waitcnt vmcnt(0)" ::: "memory");
            const unsigned og = xb_add(&bar[XB_TOP], 1u);
            const unsigned tg = og / nx;
            if (og + 1u == (tg + 1u) * nx) xb_add(&bar[XB_TOPGEN], 1u);
            else XB_SPIN(xb_ld(&bar[XB_TOPGEN]) == tg, bar);
            __builtin_amdgcn_fence(__ATOMIC_ACQUIRE, "agent");
            xb_add(&bar[XB_XGEN(b.x)], 1u);
            asm volatile("s_waitcnt vmcnt(0)" ::: "memory");
        } else {
            XB_SPIN(xb_ld(&bar[XB_XGEN(b.x)]) == gen, bar);
            __builtin_amdgcn_fence(__ATOMIC_ACQUIRE, "agent");
            asm volatile("s_waitcnt vmcnt(0)" ::: "memory");
        }
    }
    __syncthreads();
}

struct Args { const float* in[25]; float* out; unsigned char* ws; int ph_lo, ph_hi, flags, li; };
enum { FL_LRU = 1, FL_ATTN = 2 };

__device__ __forceinline__ float wave_sum(float v) {
#pragma unroll
    for (int o = 1; o < 64; o <<= 1) v += __shfl_xor(v, o);
    return v;
}
template <class DST> __device__ __forceinline__ void transpose_item(const float* W, int ldn, const float* gk, bf16_t* WT, const DST& dst, LAS float* scr, int k0, int n0, int lane) {
    f32x4 v[8];
#pragma unroll
    for (int i = 0; i < 8; ++i) v[i] = *(const GAS f32x4*)(W + (size_t)(k0 + 8 * i + (lane >> 3)) * ldn + n0 + 4 * (lane & 7));
#pragma unroll
    for (int i = 0; i < 8; ++i) { const int kk = 8 * i + (lane >> 3); if (gk) v[i] *= gk[k0 + kk]; LAS float* d = scr + kk * 33 + 4 * (lane & 7); d[0] = v[i].x; d[1] = v[i].y; d[2] = v[i].z; d[3] = v[i].w; }
    LDS_WAIT(); asm volatile("" ::: "memory");
    const int c = lane & 7;
#pragma unroll
    for (int j = 0; j < 4; ++j) { const int n = (lane >> 3) + 8 * j; const LAS float* s = scr + (8 * c) * 33 + n;
        v4u o; o.x = pk2(s[0 * 33], s[1 * 33]); o.y = pk2(s[2 * 33], s[3 * 33]); o.z = pk2(s[4 * 33], s[5 * 33]); o.w = pk2(s[6 * 33], s[7 * 33]);
        st16_wt<WT_P0>(WT + (size_t)dst(n0 + n) * D + k0 + 8 * c, o); }
    LDS_WAIT(); asm volatile("" ::: "memory");
}
struct ItemSrc { const float* W; const float* gk; unsigned char* WT; int rowbase, half, kind, k0, n0; };
__device__ __forceinline__ void f8_item_load(const ItemSrc& s, int lane, f32x4 (&v)[8]) {
#pragma unroll
    for (int i = 0; i < 8; ++i) v[i] = __builtin_nontemporal_load((const GAS f32x4*)(s.W + (size_t)(s.k0 + 8 * i + (lane >> 3)) * D + s.n0 + 4 * (lane & 7)));
}
__device__ __forceinline__ void f8_item_store(const ItemSrc& s, int lane, f32x4 (&v)[8], LAS float* scr) {
#pragma unroll
    for (int i = 0; i < 8; ++i) { const int kk = 8 * i + (lane >> 3); float m = 32.0f; if (s.gk) m *= s.gk[s.k0 + kk]; v[i] *= m; LAS float* d = scr + kk * 33 + 4 * (lane & 7); d[0] = v[i].x; d[1] = v[i].y; d[2] = v[i].z; d[3] = v[i].w; }
    LDS_WAIT(); asm volatile("" ::: "memory");
    const int c = lane & 3;
#pragma unroll
    for (int j = 0; j < 2; ++j) { const int n = (lane >> 2) + 16 * j; const LAS float* p = scr + (16 * c) * 33 + n; int o[4];
#pragma unroll
        for (int q = 0; q < 4; ++q) { int w = 0; w = __builtin_amdgcn_cvt_pk_fp8_f32(p[(4 * q) * 33], p[(4 * q + 1) * 33], w, false); w = __builtin_amdgcn_cvt_pk_fp8_f32(p[(4 * q + 2) * 33], p[(4 * q + 3) * 33], w, true); o[q] = w; }
        const int col = s.n0 + n; const int row = s.rowbase + (s.kind == 0 ? gu_dst(col, s.half) : down_dst(col));
        st16_wt<WT_P0>(s.WT + (size_t)row * 1024 + s.k0 + 16 * c, (v4u){(unsigned)o[0], (unsigned)o[1], (unsigned)o[2], (unsigned)o[3]}); }
    LDS_WAIT(); asm volatile("" ::: "memory");
}
struct DstWin { __device__ int operator()(int c) const { return win_dst(c); } };
struct DstNat { __device__ int operator()(int c) const { return c; } };
struct DstPerm { __device__ int operator()(int c) const { return perm256_dst(c); } };
struct DstGU { int base, half; __device__ int operator()(int c) const { return base + gu_dst(c, half); } };
struct DstDown { int base; __device__ int operator()(int c) const { return base + perm256_dst(c); } };

constexpr int EXP_ITEMS = NE * 3 * 16 * 32;
#ifndef P1_ITEMS
#define P1_ITEMS 8
#endif
constexpr int EXP_STEAL = 4096;
constexpr int EXP_N1 = EXP_ITEMS - EXP_STEAL;
constexpr int EXP_N0 = EXP_N1 - 64 * 8 * P1_ITEMS;
static_assert(NB * 8 * (S / 256) * NWAVES * attn_body::CV_PER_WAVE == 4 * EXP_N0, "the attention waves convert exactly the items [0, EXP_N0)");
constexpr int EXP_N0_ = EXP_N0;
__device__ __forceinline__ void convert_expert_items(const Args& a, LAS float* scr, int lane, int first, int stride, int lo, int hi) {
    unsigned char* ws = a.ws; const float* n2g = a.in[15]; constexpr int I_E = 16 * 32;
    auto mkitem = [&](int r) { ItemSrc s; int e, q, ii;
        if (r < NE * 2 * I_E) { e = r / (2 * I_E); q = (r / I_E) & 1; ii = r % I_E; } else { const int rd = r - NE * 2 * I_E; e = rd / I_E; q = 2; ii = rd % I_E; }
        s.k0 = 64 * (ii / 32); s.n0 = 32 * (ii % 32); s.half = q & 1; s.kind = (q == 2);
        s.W = a.in[q == 0 ? 18 : (q == 1 ? 20 : 22)] + (size_t)e * D * D; s.gk = (const float*)nullptr;     s.WT = ws + (q == 2 ? WS_BT2 : WS_BT1); s.rowbase = (q == 2) ? e * 1024 : e * 2048; return s; };
    int r = lo + first; f32x4 va[8], vb[8]; ItemSrc sa, sb;
    if (r < hi) { sa = mkitem(r); f8_item_load(sa, lane, va); }
    while (r < hi) {
        const int r1 = r + stride; if (r1 < hi) { sb = mkitem(r1); f8_item_load(sb, lane, vb); }
        f8_item_store(sa, lane, va, scr);
        if (r1 >= hi) break;
        const int r2 = r1 + stride; if (r2 < hi) { sa = mkitem(r2); f8_item_load(sa, lane, va); }
        f8_item_store(sb, lane, vb, scr);
        r = r2;
    }
}
__device__ __forceinline__ void p0_prologue(const Args& a, LAS unsigned char* lds, int vcu, int G, int wave, int lane) {
    unsigned char* ws = a.ws;
    LAS float* scr = (LAS float*)(lds + RING_OFF + wave * 16384);
    const int gw = vcu * NWAVES + wave, NGW = G * NWAVES;
    constexpr int I_IN = 16 * 56, I_OUT = 16 * 32, I_E = 16 * 32;
    const float* w_in = a.in[2]; const float* w_out = a.in[14]; const float* aog = a.in[12]; const float* n2g = a.in[15];
    for (int r = gw; r < I_IN + I_OUT; r += NGW) {
        if (r < I_IN) transpose_item(w_in, INW, (const float*)nullptr, (bf16_t*)(ws + WS_WIN), DstWin{}, scr, 64 * (r / 56), 32 * (r % 56), lane);
        else { const int q = r - I_IN, k0 = 64 * (q / 32);
            transpose_item(w_out, D, k0 < 512 ? aog : (const float*)nullptr, (bf16_t*)(ws + WS_WOUT), DstPerm{}, scr, k0, 32 * (q % 32), lane); }
    }
    convert_expert_items(a, scr, lane, gw, NGW, EXP_N0, G == 256 ? EXP_N0 : EXP_N1);
    const float* x = a.in[0]; const float* n1g = a.in[1]; bf16_t* XN = (bf16_t*)(ws + WS_XN);
    f32x4 gv[4];
#pragma unroll
    for (int j = 0; j < 4; ++j) gv[j] = *(const f32x4*)(n1g + 4 * lane + 256 * j);
    for (int m0 = 2 * gw; m0 < T; m0 += 2 * NGW) {
        f32x4 v[2][4]; float s[2] = {0.f, 0.f};
#pragma unroll
        for (int r = 0; r < 2; ++r) { const GAS f32x4* xr = (const GAS f32x4*)(x + (size_t)(m0 + r) * D) + lane;
#pragma unroll
            for (int j = 0; j < 4; ++j) v[r][j] = __builtin_nontemporal_load(xr + 64 * j); }
#pragma unroll
        for (int r = 0; r < 2; ++r) {
#pragma unroll
            for (int j = 0; j < 4; ++j) s[r] += (v[r][j].x * v[r][j].x + v[r][j].y * v[r][j].y) + (v[r][j].z * v[r][j].z + v[r][j].w * v[r][j].w);
            const float rs = 1.0f / sqrtf(wave_sum(s[r]) * (1.0f / D) + 1e-5f);
            GAS unsigned long long* o8 = (GAS unsigned long long*)(XN + (size_t)(m0 + r) * D) + lane;
#pragma unroll
            for (int j = 0; j < 4; ++j) o8[64 * j] = (unsigned long long)pk2(v[r][j].x * rs * gv[j].x, v[r][j].y * rs * gv[j].y) | ((unsigned long long)pk2(v[r][j].z * rs * gv[j].z, v[r][j].w * rs * gv[j].w) << 32);
        }
    }
    const int gt = vcu * (NWAVES * 64) + wave * 64 + lane, NGT = G * NWAVES * 64;
    for (int idx = gt; idx < 8 * 4 * 2 * 4 * 64 * 8; idx += NGT) {
        if (idx < 2048) nv::tbl_rope(idx, (float*)(ws + WS_ROPE));
        nv::tbl_wl(idx, a.in[7], a.in[9], (bf16_t*)(ws + WS_WL));
        if (idx < 64 * 64 * 8) nv::tbl_rtr(idx, a.in[16], n2g, (bf16_t*)(ws + WS_RTR));
    }
}
__device__ __forceinline__ void p5_route(const Args& a, LAS unsigned char* lds, int G) {
    unsigned char* ws = a.ws;
    const float* X1 = (const float*)(ws + WS_X1); const bf16_t* RT = (const bf16_t*)(ws + WS_RTR); const float* br = a.in[17];
    float* listr = (float*)(ws + WS_LISTR); float* listg = (float*)(ws + WS_LISTG); int* list = (int*)(ws + WS_LIST); unsigned* cnt = (unsigned*)(ws + WS_CTL) + CW_CNT;
    LAS float* PD = (LAS float*)(lds); LAS float* PS = (LAS float*)(lds + 33792); LAS unsigned* CL = (LAS unsigned*)(lds + 34816); LAS unsigned* BASE = (LAS unsigned*)(lds + 34944);
    int tid_ = threadIdx.x; asm volatile("" : "+v"(tid_));
    const int tid = tid_, lane = tid & 63, i = lane & 31, hi = lane >> 5; const int wid = __builtin_amdgcn_readfirstlane(tid >> 6), tile = wid >> 2, q = wid & 3;
    for (int grp = blockIdx.x; grp < T / 64; grp += G) {
        if (tid < 32) CL[tid] = 0u;
        const int tok0 = grp * 64 + tile * 32;
        f32x16 acc = f32x16{}; float ss = 0.f;
        const bf16_t* xp = (const bf16_t*)X1 + (size_t)(tok0 + i) * D + q * 256 + hi * 8;
#pragma unroll 4
        for (int ks = 0; ks < 16; ++ks) {
            const v4u xv = *(const v4u*)(xp + ks * 16);
#pragma unroll
            for (int p = 0; p < 4; ++p) { const float e0 = __uint_as_float(xv[p] << 16), e1 = __uint_as_float(xv[p] & 0xffff0000u); ss += e0 * e0 + e1 * e1; }
            const bf16x8 ah = __builtin_bit_cast(bf16x8, xv);
            const int ksg = q * 16 + ks;
            const bf16x8 bh = *(const bf16x8*)(RT + ((size_t)ksg * 64 + lane) * 8), bl = *(const bf16x8*)(RT + 32768 + ((size_t)ksg * 64 + lane) * 8);
            acc = __builtin_amdgcn_mfma_f32_32x32x16_bf16(ah, bh, acc, 0, 0, 0);
            acc = __builtin_amdgcn_mfma_f32_32x32x16_bf16(ah, bl, acc, 0, 0, 0);
        }
#pragma unroll
        for (int r = 0; r < 16; ++r) PD[((tile * 4 + q) * 32 + ((r & 3) + 8 * (r >> 2) + 4 * hi)) * 33 + i] = acc[r];
        ss += __shfl_xor(ss, 32);
        if (hi == 0) PS[(tile * 4 + q) * 32 + i] = ss;
        __syncthreads();
        int se[4]; unsigned sp[4]; float sg[4]; float rs_tok = 0.f; const bool sel = (q == 0 && hi == 0); const int tok = tok0 + i;
        if (sel) {
            float lg[32];
            const float sq = (PS[(tile * 4 + 0) * 32 + i] + PS[(tile * 4 + 1) * 32 + i]) + (PS[(tile * 4 + 2) * 32 + i] + PS[(tile * 4 + 3) * 32 + i]);
            const float rs = 1.0f / sqrtf(sq * (1.0f / D) + 1e-5f);
#pragma unroll
            for (int e = 0; e < 32; ++e) { const float v = (PD[((tile * 4 + 0) * 32 + i) * 33 + e] + PD[((tile * 4 + 1) * 32 + i) * 33 + e]) + (PD[((tile * 4 + 2) * 32 + i) * 33 + e] + PD[((tile * 4 + 3) * 32 + i) * 33 + e]); lg[e] = v * rs + br[e]; }
            unsigned taken = 0u; float tv[4];
#pragma unroll
            for (int k = 0; k < 4; ++k) { float best = -INFINITY; int bi = 0;
#pragma unroll
                for (int e = 0; e < 32; ++e) { const bool c = (lg[e] > best) && !((taken >> e) & 1u); best = c ? lg[e] : best; bi = c ? e : bi; }
                taken |= 1u << bi; se[k] = bi; tv[k] = best; }
            float sum = 0.f;
#pragma unroll
            for (int k = 0; k < 4; ++k) { sg[k] = __expf(tv[k] - tv[0]); sum += sg[k]; }
            const float inv = 1.0f / sum;
#pragma unroll
            for (int k = 0; k < 4; ++k) { sg[k] *= inv; sp[k] = __hip_atomic_fetch_add(&CL[se[k]], 1u, __ATOMIC_RELAXED, __HIP_MEMORY_SCOPE_WORKGROUP); }
            rs_tok = rs;
        }
        __syncthreads();
        if (tid < 32) BASE[tid] = __hip_atomic_fetch_add(cnt + tid * CNT_STRIDE, CL[tid], RLX_AGENT);
        __syncthreads();
        if (sel) {
#pragma unroll
            for (int k = 0; k < 4; ++k) { const size_t pos = (size_t)se[k] * T + BASE[se[k]] + sp[k]; list[pos] = tok * 4 + k; listr[pos] = rs_tok; listg[pos] = sg[k]; }
        }
        __syncthreads();
    }
}
__device__ __forceinline__ void p8_final(const Args& a, int vcu, int G, int wave, int lane) {
    const float* X1 = (const float*)(a.ws + WS_X1); const unsigned char* Y = a.ws + WS_Y; const float* fg = a.in[24];
    const int gw = vcu * NWAVES + wave, NGW = G * NWAVES;
    f32x4 gv[4];
#pragma unroll
    for (int j = 0; j < 4; ++j) gv[j] = *(const f32x4*)(fg + 4 * lane + 256 * j);
    for (int m0 = 2 * gw; m0 < T; m0 += 2 * NGW) {
        f32x4 v[2][4]; unsigned yq[2][4][4];
#pragma unroll
        for (int r = 0; r < 2; ++r)
#pragma unroll
            for (int j = 0; j < 4; ++j) { { typedef unsigned u2_ __attribute__((ext_vector_type(2))); const u2_ xb = __builtin_nontemporal_load((const GAS u2_*)((const bf16_t*)X1 + (size_t)(m0 + r) * D) + lane + 64 * j);
                  v[r][j] = (f32x4){__uint_as_float(xb[0] << 16), __uint_as_float(xb[0] & 0xffff0000u), __uint_as_float(xb[1] << 16), __uint_as_float(xb[1] & 0xffff0000u)}; }
#pragma unroll
                for (int k = 0; k < 4; ++k) yq[r][j][k] = __builtin_nontemporal_load((const GAS unsigned*)(Y + ((size_t)(m0 + r) * 4 + k) * D) + lane + 64 * j); }
#pragma unroll
        for (int r = 0; r < 2; ++r) { float s = 0.f;
#pragma unroll
            for (int j = 0; j < 4; ++j) { f32x4 ys = (f32x4){0.f, 0.f, 0.f, 0.f};
#pragma unroll
                for (int k = 0; k < 4; ++k) { const auto lo = __builtin_amdgcn_cvt_pk_f32_fp8((int)yq[r][j][k], false), hi = __builtin_amdgcn_cvt_pk_f32_fp8((int)yq[r][j][k], true); ys.x += lo[0]; ys.y += lo[1]; ys.z += hi[0]; ys.w += hi[1]; }
                v[r][j] += ys * 0.0625f;
                s += (v[r][j].x * v[r][j].x + v[r][j].y * v[r][j].y) + (v[r][j].z * v[r][j].z + v[r][j].w * v[r][j].w); }
            const float rs = 1.0f / sqrtf(wave_sum(s) * (1.0f / D) + 1e-5f);
#pragma unroll
            for (int j = 0; j < 4; ++j) __builtin_nontemporal_store(v[r][j] * gv[j] * rs, (GAS f32x4*)(a.out + (size_t)(m0 + r) * D) + lane + 64 * j); }
    }
}

#define CODE_ANCHOR(N) asm volatile(".p2align 6\n\t.fill %0, 4, 0xBF800000" :: "n"(N) : "memory")
#ifndef PAD_P1
#define PAD_P1 15
#endif
#ifndef PAD_P3
#define PAD_P3 12
#endif
#ifndef PAD_P4
#define PAD_P4 0
#endif
#ifndef PAD_P6
#define PAD_P6 14
#endif
#ifndef PAD_P7
#define PAD_P7 10
#endif
__global__ void __launch_bounds__(NWAVES * 64, 2) mk_fwd(Args args) {
    extern __shared__ __attribute__((aligned(16))) unsigned char lds_raw[];
#ifdef CODE_PAD
    asm volatile(".fill %0, 4, 0xBF800000" :: "n"(CODE_PAD));
#endif
    LAS unsigned char* lds = (LAS unsigned char*)lds_raw;
    volatile LAS unsigned* MISC = (volatile LAS unsigned*)(lds + MISC_OFF);
    const int tid = threadIdx.x, lane = tid & 63, wave = __builtin_amdgcn_readfirstlane(tid >> 6);
    const int G = gridDim.x; const int bx = blockIdx.x; const int vcu = (G % 8 == 0) ? (bx % 8) * (G / 8) + bx / 8 : bx;
    unsigned char* ws = args.ws;
    gu32* ctl = (gu32*)(ws + WS_CTL);
    for (int u = tid; u < 128; u += NWAVES * 64) MISC[u] = 0u;
    __syncthreads();
    XcdBarrier bar = xcd_barrier_post((unsigned*)ctl + CW_BAR + args.li * XCD_BAR_WORDS, MISC);
    const int lo = args.ph_lo, hi = args.ph_hi;
#define IN(k) (lo <= (k) && (k) < hi)
#define SEAM(k) do { if (IN(k) && IN((k) + 1)) xcd_barrier(bar); } while (0)

    if (IN(0)) { p0_prologue(args, lds, vcu, G, wave, lane); SEAM(0); }

    if (IN(1)) {
        pg8::StaticSched Sc; Sc.init(ws + WS_WIN, T, INW, G, bx);
        pg8::EpiInProj E{(bf16_t*)(ws + WS_Q), (bf16_t*)(ws + WS_K), (bf16_t*)(ws + WS_V), (bf16_t*)(ws + WS_LX), (bf16_t*)(ws + WS_LG), args.in[3], args.in[4], (const float*)(ws + WS_ROPE)};
        CODE_ANCHOR(PAD_P1);
        pg8::gemm_phase<pg8::EpiInProj, pg8::StaticSched>(lds + RING_OFF, (const char*)(ws + WS_XN), Sc, E);
        { pg8::GUnit u2; const int nidle = 2 * G - 448;
          if (G == 256 && !Sc.next(1, u2)) { int j = 0, my = -1; for (int c2 = 0; c2 < G; ++c2) { pg8::StaticSched S2 = Sc; S2.c = c2; pg8::GUnit t2; if (!S2.next(1, t2)) { if (c2 == bx) my = j; ++j; } }
              (void)nidle; if (my >= 0) convert_expert_items(args, (LAS float*)(lds + RING_OFF + wave * 16384), lane, my * NWAVES + wave, j * NWAVES, EXP_N0, EXP_N1); } }
        SEAM(1);
    }
    const lru::Params LP{(const bf16_t*)(ws + WS_LX), (const bf16_t*)(ws + WS_LG), args.in[5], args.in[6], args.in[8], args.in[10], args.in[11], args.in[13], (const bf16_t*)(ws + WS_WL),
                         (lru::f32x2*)(ws + WS_SUMS), (bf16_t*)(ws + WS_MIX), (unsigned*)(ws + WS_X1)};
    if (IN(2)) {
#ifndef LRU_REP1
#define LRU_REP1 1
#endif
#ifndef LRU_REP2
#define LRU_REP2 1
#endif
#pragma unroll 1
        for (int rep = 0; rep < LRU_REP1; ++rep)
        if (args.flags & FL_LRU) for (int task = bx; task < NB * NCH; task += G) lru::lru_summaries(LP, lds, task / NCH, task % NCH);
        SEAM(2);
    }
    if (IN(3)) {
        const bool lru_first = (vcu & 1) == 0;
#pragma unroll 1
        for (int rep = 0; rep < LRU_REP2; ++rep)
        if ((args.flags & FL_LRU) && lru_first) { __syncthreads(); for (int task = bx; task < NB * NCH; task += G) lru::lru_apply(LP, lds, task / NCH, task % NCH); __syncthreads(); }
        if (args.flags & FL_ATTN) {
            float gq = 0.f, gk = 0.f; { const float a0 = fabsf(args.in[3][lane]), a1 = fabsf(args.in[4][lane]); gq = a0; gk = a1;
#pragma unroll
                for (int o = 1; o < 64; o <<= 1) { gq = fmaxf(gq, __shfl_xor(gq, o)); gk = fmaxf(gk, __shfl_xor(gk, o)); } }
            const float smax = 8.0f * 1.4426950408889634f * gq * gk * 1.01f; const bool fixref = __builtin_amdgcn_readfirstlane(smax < 40.0f ? 1 : 0) != 0;
#ifndef ATT_REP
#define ATT_REP 1
#endif
#pragma unroll 1
            for (int rep = 0; rep < ATT_REP; ++rep)
            CODE_ANCHOR(PAD_P3);
            for (int L = vcu; L < NB * 8 * (S / 256); L += G) {
                const int per = 64;
                const int grp = L / per, r = L % per;
                const int b = grp >> 2, kvh = (grp >> 1) & 1, hp = grp & 1, hg = 2 * hp + (r >> 5), qb = r & 31;
                const attn_body::Conv cv{args.in[18], args.in[20], args.in[22], ws + WS_BT1, ws + WS_BT2, (L * NWAVES + wave) * attn_body::CV_PER_WAVE, attn_body::CV_PER_WAVE};
                if (fixref) attn_body::attn_unit<8, true>(b, kvh * 4 + hg, qb, (const attn_body::bf16*)(ws + WS_Q), (const attn_body::bf16*)(ws + WS_K), (const attn_body::bf16*)(ws + WS_V),
                                        (attn_body::bf16*)(ws + WS_MIX), (float*)(ws + WS_SSQ), (char*)lds_raw + RING_OFF, smax - 20.0f, cv);
                else attn_body::attn_unit<8, false>(b, kvh * 4 + hg, qb, (const attn_body::bf16*)(ws + WS_Q), (const attn_body::bf16*)(ws + WS_K), (const attn_body::bf16*)(ws + WS_V),
                                        (attn_body::bf16*)(ws + WS_MIX), (float*)(ws + WS_SSQ), (char*)lds_raw + RING_OFF, 0.0f, cv);
            }
        }
#pragma unroll 1
        for (int rep = 0; rep < LRU_REP2; ++rep)
        if ((args.flags & FL_LRU) && !lru_first) { __syncthreads(); for (int task = bx; task < NB * NCH; task += G) lru::lru_apply(LP, lds, task / NCH, task % NCH); __syncthreads(); }
        SEAM(3);
    }
    if (IN(4)) {
        pg8::StaticSched Sc; Sc.init(ws + WS_WOUT, T, D, G, bx);
        pg8::EpiOut E{args.in[0], (const float*)(ws + WS_SSQ), (float*)(ws + WS_X1), ws + WS_X1B, args.in[15]};
        CODE_ANCHOR(PAD_P4);
        pg8::gemm_phase<pg8::EpiOut, pg8::StaticSched>(lds + RING_OFF, (const char*)(ws + WS_MIX), Sc, E);
        SEAM(4);
    }
    if (IN(5)) { p5_route(args, lds, G); SEAM(5); }
    if (IN(6) || IN(7)) {
        __syncthreads();
        if (tid < 64) { const unsigned c = (tid < NE) ? __hip_atomic_load(ctl + CW_CNT + tid * CNT_STRIDE, RLX_AGENT) : 0u; unsigned tl = (c + 255u) >> 8, s = tl;
#pragma unroll
            for (int o = 1; o < 32; o <<= 1) { const unsigned v = __shfl_up(s, o); if ((tid & 31) >= o) s += v; }
            if (tid < NE) { MISC[16 + tid + 1] = s; MISC[64 + tid] = c; if (tid == 0) MISC[16] = 0u; } }
        __syncthreads();
        if (tid < 320) { int e = 0; for (int k = 1; k < NE; ++k) e += (MISC[16 + k] <= (unsigned)tid) ? 1 : 0; ((volatile LAS unsigned char*)(lds + MISC_OFF + 512))[tid] = (unsigned char)e; }
        __syncthreads();
    }
    const LAS unsigned* Pl = (const LAS unsigned*)(lds + MISC_OFF + 64); const LAS unsigned* Cl = (const LAS unsigned*)(lds + MISC_OFF + 256); const LAS unsigned char* Te = (const LAS unsigned char*)(lds + MISC_OFF + 512);
#if MOE_MERGE
    if (IN(6)) {
        pg8::MoeSchedM Sc{Pl, Cl, Te, (const int*)(ws + WS_LIST), (unsigned*)ctl + CW_READY, (unsigned*)ctl + CW_TMO, ws, G, vcu};
        pg8::EpiMoeM E{pg8::EpiMoe1{Cl, (const float*)(ws + WS_LISTR), args.in[19], args.in[21], ws + WS_H}, pg8::EpiMoe2{Cl, (const int*)(ws + WS_LIST), (const float*)(ws + WS_LISTG), args.in[23], ws + WS_Y}};
        pg8::gemm_phase<pg8::EpiMoeM, pg8::MoeSchedM, true>(lds + RING_OFF, (const char*)ws, Sc, E);
        if (IN(8)) xcd_barrier(bar);
    }
#else
    if (IN(6)) {
        pg8::MoeSched Sc{Pl, Cl, Te, (const int*)(ws + WS_LIST), (const char*)(ws + WS_BT1), (size_t)2048 * 1024, 8, G, vcu, true};
        pg8::EpiMoe1 E{Cl, (const float*)(ws + WS_LISTR), args.in[19], args.in[21], ws + WS_H};
        CODE_ANCHOR(PAD_P6);
        pg8::gemm_phase<pg8::EpiMoe1, pg8::MoeSched, true>(lds + RING_OFF, (const char*)(ws + WS_X1B), Sc, E);
        for (;;) {
            __syncthreads();
            if (tid == 0) MISC[8] = __hip_atomic_fetch_add(ctl + 3, 8u, RLX_AGENT);
            __syncthreads();
            const unsigned base = MISC[8];
            if (base >= (unsigned)EXP_STEAL) break;
            convert_expert_items(args, (LAS float*)(lds + RING_OFF + wave * 16384), lane, (int)base + wave, EXP_STEAL, EXP_N1, EXP_ITEMS);
        }
        SEAM(6);
    }
    if (IN(7)) {
        pg8::MoeSched Sc{Pl, Cl, Te, (const int*)(ws + WS_LIST), (const char*)(ws + WS_BT2), (size_t)1024 * 1024, 4, G, vcu, false};
        pg8::EpiMoe2 E{Cl, (const int*)(ws + WS_LIST), (const float*)(ws + WS_LISTG), args.in[23], ws + WS_Y};
        CODE_ANCHOR(PAD_P7);
        pg8::gemm_phase<pg8::EpiMoe2, pg8::MoeSched, true>(lds + RING_OFF, (const char*)(ws + WS_H), Sc, E);
        SEAM(7);
    }
#endif
    if (IN(8)) p8_final(args, vcu, G, wave, lane);
#undef IN
#undef SEAM
}

static int g_grid = 0;
static bool mk_setup() {
    if (g_grid == 0) {
        int dev = 0, cus = 0, per_cu = 0;
        if (hipGetDevice(&dev) != hipSuccess || hipDeviceGetAttribute(&cus, hipDeviceAttributeMultiprocessorCount, dev) != hipSuccess) { g_grid = -1; return false; }
        if (hipFuncSetAttribute((const void*)mk_fwd, hipFuncAttributeMaxDynamicSharedMemorySize, LDS_BYTES) != hipSuccess) { fprintf(stderr, "kernel_launch: hipFuncSetAttribute failed\n"); g_grid = -1; return false; }
        if (hipOccupancyMaxActiveBlocksPerMultiprocessor(&per_cu, (const void*)mk_fwd, NWAVES * 64, LDS_BYTES) != hipSuccess || per_cu < 1) { fprintf(stderr, "kernel_launch: occupancy query says %d blocks per CU\n", per_cu); g_grid = -1; return false; }
        (void)hipGetLastError();
        g_grid = cus;
    }
    return g_grid > 0;
}
static void mk_launch(void* const* d_in, float* out, void* ws, int lo, int hi, int flags, int li, hipStream_t st) {
    if (!mk_setup()) return;
    Args a{};
    for (int i = 0; i < 25; ++i) a.in[i] = (const float*)d_in[i];
    a.out = out; a.ws = (unsigned char*)ws; a.ph_lo = lo; a.ph_hi = hi; a.flags = flags; a.li = li;
    hipLaunchKernelGGL(mk_fwd, dim3(g_grid), dim3(NWAVES * 64), LDS_BYTES, st, a);
}
}
extern "C" void kernel_launch(void* const* d_in, const int* in_sizes, int n_in, void* d_out, int out_size, void* d_ws, size_t ws_size, hipStream_t stream) {
    if (n_in != 25 || ws_size < (size_t)mk::WS_END || out_size != mk::T * mk::D) { fprintf(stderr, "kernel_launch: unexpected n_in %d / ws_size %zu / out_size %d\n", n_in, ws_size, out_size); return; }
    (void)hipMemsetAsync((char*)d_ws + mk::WS_CTL, 0, mk::CTL_ZERO_BYTES, stream);
    mkf::mk_launch(d_in, (float*)d_out, d_ws, 0, 9, mkf::FL_LRU | mkf::FL_ATTN, 0, stream);
}
```
